# Optimizing an MI355X kernel written in HIP

```python
import jax, jax.numpy as jnp
from jax import lax
import numpy as np

D_MODEL = 1024
BATCH = 2
SEQ = 8192
DEPTH = 2

CHUNK = 64
M_HEADS = 4
M_WIDTH = D_MODEL // 2
M_HEAD_DIM = M_WIDTH // M_HEADS
CONV_K = 4
P_GROUPS = 4
P_WIDTH = D_MODEL // 4
P_GROUP_DIM = P_WIDTH // P_GROUPS
POOL_WINDOWS = (2, 4, 8, 16)
S_HEADS = 4
S_WIDTH = D_MODEL // 4
S_HEAD_DIM = S_WIDTH // S_HEADS
SB_BLOCK = 128
N_BRANCH = 3
N_IN = 5 * M_WIDTH + 2 * M_HEADS + 2 * P_WIDTH + 4 * S_WIDTH + N_BRANCH * D_MODEL
EPS = 1e-6

kernel_name = "hybrid_mlstm_pool_stickbreak_block"


def _split_points():
    sizes = (M_WIDTH, M_WIDTH, M_WIDTH, M_HEADS, M_HEADS, M_WIDTH, M_WIDTH,
             P_WIDTH, P_WIDTH, S_WIDTH, S_WIDTH, S_WIDTH, S_WIDTH)
    pts, acc = [], 0
    for s in sizes:
        acc += s
        pts.append(acc)
    return pts


def _rmsnorm(x, g):
    xf = x.astype(jnp.float32)
    y = xf * lax.rsqrt(jnp.mean(xf * xf, axis=-1, keepdims=True) + EPS)
    return (y * g.astype(jnp.float32)).astype(x.dtype)


def _causal_conv(x, w, b):
    k_w = w.shape[0]
    s = x.shape[1]
    xp = jnp.pad(x, ((0, 0), (k_w - 1, 0), (0, 0)))
    return sum(xp[:, j:j + s] * w[j] for j in range(k_w)) + b


def _mlstm_chunkwise(q, k, v, i_pre, f_pre):
    b_, h_, s_, dh = q.shape
    nc = s_ // CHUNK
    q = q.reshape(b_, h_, nc, CHUNK, dh)
    k = k.reshape(b_, h_, nc, CHUNK, dh)
    v = v.reshape(b_, h_, nc, CHUNK, dh)
    ig = i_pre.reshape(b_, h_, nc, CHUNK)
    bcum = jnp.cumsum(jax.nn.log_sigmoid(f_pre).reshape(b_, h_, nc, CHUNK), axis=-1)
    b_end = bcum[..., -1]

    a = b_end[..., None] - bcum + ig
    a_max = jnp.max(a, axis=-1)
    wa = jnp.exp(a - a_max[..., None])
    d_c = jnp.einsum('bhcsv,bhcsk->bhcvk', v * wa[..., None], k)
    d_n = jnp.einsum('bhcs,bhcsk->bhck', wa, k)

    def step(carry, xs):
        c_st, n_st, m_st = carry
        be, am, dc, dn = xs
        m_new = jnp.maximum(be + m_st, am)
        decay = jnp.exp(be + m_st - m_new)
        inw = jnp.exp(am - m_new)
        c_new = decay[..., None, None] * c_st + inw[..., None, None] * dc
        n_new = decay[..., None] * n_st + inw[..., None] * dn
        return (c_new, n_new, m_new), (c_st, n_st, m_st)

    init = (jnp.zeros((b_, h_, dh, dh), jnp.float32),
            jnp.zeros((b_, h_, dh), jnp.float32),
            jnp.zeros((b_, h_), jnp.float32))
    xs = (jnp.moveaxis(b_end, 2, 0), jnp.moveaxis(a_max, 2, 0),
          jnp.moveaxis(d_c, 2, 0), jnp.moveaxis(d_n, 2, 0))
    _, (c_prev, n_prev, m_prev) = lax.scan(step, init, xs)
    c_prev = jnp.moveaxis(c_prev, 0, 2)
    n_prev = jnp.moveaxis(n_prev, 0, 2)
    m_prev = jnp.moveaxis(m_prev, 0, 2)

    tri = jnp.tril(jnp.ones((CHUNK, CHUNK), dtype=bool))
    log_d = jnp.where(tri, bcum[..., :, None] - bcum[..., None, :] + ig[..., None, :], -jnp.inf)
    log_inter = bcum + m_prev[..., None]
    m_t = jnp.maximum(log_inter, jnp.max(log_d, axis=-1))
    w_inter = jnp.exp(log_inter - m_t)
    w_intra = jnp.exp(log_d - m_t[..., None]) * jnp.einsum('bhctd,bhcsd->bhcts', q, k)
    num = (w_inter[..., None] * jnp.einsum('bhcvk,bhctk->bhctv', c_prev, q)
           + jnp.einsum('bhcts,bhcsv->bhctv', w_intra, v))
    den = w_inter * jnp.einsum('bhck,bhctk->bhct', n_prev, q) + jnp.sum(w_intra, axis=-1)
    h = num / jnp.maximum(jnp.abs(den), jnp.exp(-m_t))[..., None]
    return h.reshape(b_, h_, s_, dh)


def _mlstm_branch(mq, mk, mv, mi, mf, mo, mz, gate_b, conv_w, conv_b, norm_g):
    b_, s_, _ = mq.shape
    dt = mq.dtype
    qk = jax.nn.silu(_causal_conv(jnp.concatenate([mq, mk], axis=-1), conv_w, conv_b))
    q, k = jnp.split(qk, 2, axis=-1)

    def heads(t):
        return t.astype(jnp.float32).reshape(b_, s_, M_HEADS, M_HEAD_DIM).transpose(0, 2, 1, 3)

    i_pre = (mi + gate_b[:M_HEADS]).astype(jnp.float32).transpose(0, 2, 1)
    f_pre = (mf + gate_b[M_HEADS:]).astype(jnp.float32).transpose(0, 2, 1)
    h = _mlstm_chunkwise(heads(q), heads(k) * (M_HEAD_DIM ** -0.5), heads(mv), i_pre, f_pre)
    h = h.transpose(0, 2, 1, 3) * jax.nn.sigmoid(mo.astype(jnp.float32)).reshape(
        b_, s_, M_HEADS, M_HEAD_DIM)
    h = h * lax.rsqrt(jnp.mean(h * h, axis=-1, keepdims=True) + EPS)
    h = h.reshape(b_, s_, M_WIDTH) * norm_g.astype(jnp.float32)
    return (h * jax.nn.silu(mz.astype(jnp.float32))).astype(dt)


def _pool_branch(pu, pz, pool_w, pool_scale):
    b_, s_, _ = pu.shape
    dt = pu.dtype
    u = pu.astype(jnp.float32).reshape(b_, s_, P_GROUPS, P_GROUP_DIM)
    cs = jnp.concatenate([jnp.zeros((b_, 1, P_GROUPS, P_GROUP_DIM), jnp.float32),
                          jnp.cumsum(u, axis=1)], axis=1)
    t1 = jnp.arange(1, s_ + 1)[:, None]
    lo = jnp.maximum(t1 - jnp.array(POOL_WINDOWS)[None, :], 0)
    idx = jnp.broadcast_to(lo[None, :, :, None], (b_, s_, P_GROUPS, P_GROUP_DIM))
    cs_lo = jnp.take_along_axis(cs, idx, axis=1)
    count = (t1 - lo).astype(jnp.float32)[None, :, :, None]
    p = (cs[:, 1:] - cs_lo) / count - u
    p = jnp.einsum('bsgc,gcd->bsgd', p, pool_w.astype(jnp.float32))
    p = p.reshape(b_, s_, P_WIDTH) * pool_scale.astype(jnp.float32)
    return (p * jax.nn.silu(pz.astype(jnp.float32))).astype(dt)


def _stick_breaking_branch(sq, sk, sv, sz):
    b_, s_, _ = sq.shape
    dt = sq.dtype

    def heads(t):
        return t.astype(jnp.float32).reshape(b_, s_, S_HEADS, S_HEAD_DIM).transpose(0, 2, 1, 3)

    q = heads(sq) * (S_HEAD_DIM ** -0.5)
    k = heads(sk)
    v = heads(sv)
    outs = []
    for blk in range(s_ // SB_BLOCK):
        q0 = blk * SB_BLOCK
        kend = q0 + SB_BLOCK
        z = jnp.einsum('bhtd,bhsd->bhts', q[:, :, q0:kend], k[:, :, :kend])
        t_pos = q0 + jnp.arange(SB_BLOCK)
        s_pos = jnp.arange(kend)
        causal = s_pos[None, :] < t_pos[:, None]
        log_fail = jnp.where(causal, jax.nn.log_sigmoid(-z), 0.0)
        log_surv = lax.cumsum(log_fail, axis=3, reverse=True) - log_fail
        attn = jnp.where(causal, jnp.exp(jax.nn.log_sigmoid(z) + log_surv), 0.0)
        outs.append(jnp.einsum('bhts,bhsd->bhtd', attn, v[:, :, :kend]))
    o = jnp.concatenate(outs, axis=2).transpose(0, 2, 1, 3).reshape(b_, s_, S_WIDTH)
    return (o * jax.nn.silu(sz.astype(jnp.float32))).astype(dt)


def setup_inputs(seed: int = 0) -> dict:
    key = jax.random.key(seed)
    ks = jax.random.split(key, 20)
    f32 = jnp.float32
    nrm = lambda k, shape: jax.random.normal(k, shape, f32)
    i_bias = 0.1 * nrm(ks[6], (DEPTH, M_HEADS))
    f_bias = jnp.linspace(3.0, 6.0, M_HEADS, dtype=f32)[None, :] + 0.1 * nrm(ks[7], (DEPTH, M_HEADS))
    return {
        "x": nrm(ks[0], (BATCH, SEQ, D_MODEL)),
        "c": nrm(ks[1], (BATCH, D_MODEL)),
        "norm_g": 1.0 + 0.05 * nrm(ks[2], (DEPTH, D_MODEL)),
        "w_ada": nrm(ks[3], (DEPTH, D_MODEL, 3 * D_MODEL)) * (0.5 * D_MODEL ** -0.5),
        "b_ada": 0.02 * nrm(ks[4], (DEPTH, 3 * D_MODEL)),
        "w_in": nrm(ks[5], (DEPTH, D_MODEL, N_IN)) * D_MODEL ** -0.5,
        "m_gate_b": jnp.concatenate([i_bias, f_bias], axis=-1),
        "conv_w": nrm(ks[8], (DEPTH, CONV_K, 2 * M_WIDTH)) * CONV_K ** -0.5,
        "conv_b": 0.02 * nrm(ks[9], (DEPTH, 2 * M_WIDTH)),
        "m_norm_g": 1.0 + 0.05 * nrm(ks[10], (DEPTH, M_WIDTH)),
        "pool_w": nrm(ks[11], (DEPTH, P_GROUPS, P_GROUP_DIM, P_GROUP_DIM)) * P_GROUP_DIM ** -0.5,
        "pool_scale": 1.0 + 0.05 * nrm(ks[12], (DEPTH, P_WIDTH)),
        "w_br_m": nrm(ks[13], (DEPTH, M_WIDTH, D_MODEL)) * M_WIDTH ** -0.5,
        "w_br_p": nrm(ks[14], (DEPTH, P_WIDTH, D_MODEL)) * P_WIDTH ** -0.5,
        "w_br_s": nrm(ks[15], (DEPTH, S_WIDTH, D_MODEL)) * S_WIDTH ** -0.5,
        "gate_b": 0.02 * nrm(ks[16], (DEPTH, N_BRANCH * D_MODEL)),
        "w_out": nrm(ks[17], (DEPTH, D_MODEL, D_MODEL)) * D_MODEL ** -0.5,
        "final_g": 1.0 + 0.05 * nrm(ks[18], (D_MODEL,)),
    }


def reference(x, c, norm_g, w_ada, b_ada, w_in, m_gate_b, conv_w, conv_b, m_norm_g,
              pool_w, pool_scale, w_br_m, w_br_p, w_br_s, gate_b, w_out, final_g):
    b_, s_, _ = x.shape
    for l in range(DEPTH):
        mod = c @ w_ada[l] + b_ada[l]
        shift, scale, gate = jnp.split(mod, 3, axis=-1)
        h = _rmsnorm(x, norm_g[l]) * (1.0 + scale[:, None, :]) + shift[:, None, :]
        proj = h @ w_in[l]
        (mq, mk, mv, mi, mf, mo, mz, pu, pz, sq, sk, sv, sz, gpre) = jnp.split(
            proj, _split_points(), axis=-1)
        y_m = _mlstm_branch(mq, mk, mv, mi, mf, mo, mz, m_gate_b[l], conv_w[l], conv_b[l], m_norm_g[l])
        y_p = _pool_branch(pu, pz, pool_w[l], pool_scale[l])
        y_s = _stick_breaking_branch(sq, sk, sv, sz)
        g = jax.nn.sigmoid((gpre + gate_b[l]).astype(jnp.float32)).astype(x.dtype)
        g = g.reshape(b_, s_, N_BRANCH, D_MODEL)
        merged = (g[:, :, 0] * (y_m @ w_br_m[l])
                  + g[:, :, 1] * (y_p @ w_br_p[l])
                  + g[:, :, 2] * (y_s @ w_br_s[l]))
        x = x + gate[:, None, :] * (merged @ w_out[l])
    return _rmsnorm(x, final_g)
```

```cpp
#include <hip/hip_runtime.h>
#include <hip/hip_cooperative_groups.h>
#include <cstdio>
#include <cstdint>
#include <cstddef>
namespace cg = cooperative_groups;
namespace pg8 {
#define PG8_LAS __attribute__((address_space(3)))
typedef unsigned short bf16_t;
typedef short bf16x8 __attribute__((ext_vector_type(8)));
typedef float f32x4 __attribute__((ext_vector_type(4)));
typedef unsigned u32x4 __attribute__((ext_vector_type(4)));
constexpr int BM = 256, BK = 64, HALF = 128, HTB = HALF * BK * 2  , STAGE_BYTES = 8 * HTB, NXCD = 8, WGM = 8;

__host__ __device__ __forceinline__ int lds_byte(int r, int c) { const int st = (r >> 4) * 2 + (c >> 5), rr = r & 15, cc = c & 31, ob = rr * 64 + cc * 2; return st * 1024 + (ob ^ (((ob >> 9) & 1) << 5)); }
__host__ __device__ __forceinline__ void stage_rc(int b, int& R, int& C) { const int st = b / 1024, sb = b % 1024, swz = sb ^ (((sb >> 9) & 1) << 5); R = (st >> 1) * 16 + swz / 64; C = (st & 1) * 32 + (swz % 64) / 2; }
__host__ __device__ __forceinline__ int perm32(int rho) { const int n = rho >> 4, i = rho & 15; return 8 * (i >> 2) + 4 * n + (i & 3); }

struct Unit { int pm, pn; };
struct Gemm { const bf16_t* A; const bf16_t* Bt; int M, N, K, lda, ldb; };

struct StaticOrder {
    int nM, nN, nwg, G, c;
    __host__ __device__ void init(int M, int N, int G_, int c_) { nM = M / BM; nN = N / BM; nwg = nM * nN; G = G_; c = c_; }
    __host__ __device__ bool next(int i, Unit& u) const {
        const long L = (long)i * G + c; if (L >= nwg) return false;
        int wgid = (int)L; { const int q = nwg / NXCD, r = nwg % NXCD, xcd = wgid % NXCD, off = wgid / NXCD; wgid = (xcd < r ? xcd * (q + 1) : r * (q + 1) + (xcd - r) * q) + off; }
        const int nig = WGM * nN, gid = wgid / nig, fm = gid * WGM, gsz = (nM - fm) < WGM ? (nM - fm) : WGM;
        u.pm = fm + ((wgid % nig) % gsz); u.pn = (wgid % nig) / gsz; return true;
    }
    __device__ __forceinline__ void a_ready(const Unit&) const {}
    __device__ __forceinline__ void done(const Unit&) const {}
};

__device__ __forceinline__ unsigned cvt_pk_bf16(float lo, float hi) { unsigned r; asm volatile("v_cvt_pk_bf16_f32 %0, %1, %2" : "=v"(r) : "v"(lo), "v"(hi)); return r; }
template <class Epi, class Sched, class Hook, bool ALIGN_EPI = false, bool SP2 = false, bool ZERO_ACC = true>
__device__ __forceinline__ void gemm_phase(PG8_LAS unsigned char* lds, const Gemm g, const Sched& S, const Epi& E, const Hook& HK, f32x4 (&acc)[2][2][4][2]) {
    int tid_ = threadIdx.x; asm volatile("" : "+v"(tid_));
    const int tid = tid_, wid = __builtin_amdgcn_readfirstlane(tid >> 6), lane = tid & 63, wr = wid >> 2, wc = wid & 3, fr = lane & 15, fq = lane >> 4;
    const int K = g.K, nt = K / BK;
    unsigned voffA[2], voffB[2];
#pragma unroll
    for (int i = 0; i < 2; ++i) { int R, C; stage_rc(tid * 16 + i * 8192, R, C); const int Rb = Epi::PERM ? ((R & ~31) + perm32(R & 31)) : R;
        voffA[i] = (unsigned)(R * g.lda + C) * 2u; voffB[i] = (unsigned)(Rb * g.ldb + C) * 2u; }
    const size_t kstep = (size_t)(BK * 2);
    const size_t hstepA = (size_t)HALF * g.lda * 2, hstepB = (size_t)HALF * g.ldb * 2;
    const size_t tstepA = 2 * hstepA, tstepB = 2 * hstepB;
    const unsigned ldsw = (unsigned)wid * 1024u;
    const int aoff = lds_byte(wr * 64 + fr, fq * 8), boff = lds_byte(wc * 32 + fr, fq * 8);
#define PG8_SA(b, h) (((b) * 2 + (h)) * HTB)
#define PG8_SB(b, h) ((4 + (b) * 2 + (h)) * HTB)
#define PG8_STAGE(bufoff, gbase, voff) do { _Pragma("unroll") for (int _i = 0; _i < 2; ++_i) \
        __builtin_amdgcn_global_load_lds((const unsigned*)((const char*)(gbase) + (voff)[_i]), (PG8_LAS unsigned*)(lds + (bufoff) + ldsw + _i * 8192), 16, 0, 0); } while (0)
#define PG8_LDA(dst, b, h) do { _Pragma("unroll") for (int m = 0; m < 4; ++m) _Pragma("unroll") for (int k = 0; k < 2; ++k) dst[m][k] = *(const PG8_LAS bf16x8*)(lds + PG8_SA(b, h) + aoff + m * 2048 + k * 1024); } while (0)
#define PG8_LDB(dst, b, h) do { _Pragma("unroll") for (int n = 0; n < 2; ++n) _Pragma("unroll") for (int k = 0; k < 2; ++k) dst[n][k] = *(const PG8_LAS bf16x8*)(lds + PG8_SB(b, h) + boff + n * 2048 + k * 1024); } while (0)
#define PG8_MMA(ai, bj, At, Bt) do { __builtin_amdgcn_s_setprio(1); _Pragma("unroll") for (int m = 0; m < 4; ++m) _Pragma("unroll") for (int n = 0; n < 2; ++n) _Pragma("unroll") for (int k = 0; k < 2; ++k) \
        acc[ai][bj][m][n] = __builtin_amdgcn_mfma_f32_16x16x32_bf16(Bt[n][k], At[m][k], acc[ai][bj][m][n], 0, 0, 0); __builtin_amdgcn_s_setprio(0); } while (0)
#define PG8_WAIT_V(n) asm volatile("s_waitcnt vmcnt(" #n ")" ::: "memory")
#define PG8_WAIT_L(n) asm volatile("s_waitcnt lgkmcnt(" #n ")" ::: "memory")
#define PG8_BAR __builtin_amdgcn_s_barrier()
#define PG8_SCHED __builtin_amdgcn_sched_barrier(0)
    Unit cur, nxt; int ui = 0;
    if (!S.next(0, cur)) return;
    if constexpr (ZERO_ACC) {
#pragma unroll
    for (int a = 0; a < 2; ++a)
#pragma unroll
        for (int b = 0; b < 2; ++b)
#pragma unroll
            for (int m = 0; m < 4; ++m)
#pragma unroll
                for (int n = 0; n < 2; ++n) acc[a][b][m][n] = (f32x4){0.f, 0.f, 0.f, 0.f};
    }
    bf16x8 At[4][2], B0[2][2], B1[2][2];
    const char* cA = (const char*)g.A + (size_t)cur.pm * tstepA; const char* cB = (const char*)g.Bt + (size_t)cur.pn * tstepB;
    S.a_ready(cur);
    if constexpr (SP2) {
        PG8_STAGE(PG8_SB(0, 0), cB, voffB); PG8_STAGE(PG8_SB(0, 1), cB + hstepB, voffB); PG8_STAGE(PG8_SA(0, 0), cA, voffA); PG8_STAGE(PG8_SA(0, 1), cA + hstepA, voffA);
        if (wr == 1) PG8_BAR;
        PG8_WAIT_V(2); PG8_BAR;
        PG8_STAGE(PG8_SB(1, 0), cB + kstep, voffB); PG8_STAGE(PG8_SA(1, 0), cA + kstep, voffA); PG8_STAGE(PG8_SB(1, 1), cB + hstepB + kstep, voffB);
        PG8_WAIT_V(6); PG8_BAR;
    } else {
        PG8_STAGE(PG8_SB(0, 0), cB, voffB); PG8_STAGE(PG8_SA(0, 0), cA, voffA); PG8_STAGE(PG8_SB(0, 1), cB + hstepB, voffB); PG8_STAGE(PG8_SA(0, 1), cA + hstepA, voffA);
        if (wr == 1) PG8_BAR;
        PG8_WAIT_V(4); PG8_BAR;
        PG8_STAGE(PG8_SB(1, 0), cB + kstep, voffB); PG8_STAGE(PG8_SA(1, 0), cA + kstep, voffA); PG8_STAGE(PG8_SB(1, 1), cB + hstepB + kstep, voffB);
        PG8_WAIT_V(6); PG8_BAR;
    }
    for (;;) {
        const bool has_next = S.next(ui + 1, nxt);
        const char* nA = has_next ? (const char*)g.A + (size_t)nxt.pm * tstepA : cA; const char* nB = has_next ? (const char*)g.Bt + (size_t)nxt.pn * tstepB : cB;
#pragma nounroll
        for (int t = 0; t < nt; t += 2) {
            const bool last = (t == nt - 2);
            if constexpr (Hook::ON) { if (t == Hook::T1 || t == Hook::T2) HK(acc, cur, t, wr, wc, fr, fq); }
            const char* a1 = cA + (size_t)(t + 1) * kstep;
            const char* a2 = last ? nA : cA + (size_t)(t + 2) * kstep; const char* b2 = last ? nB : cB + (size_t)(t + 2) * kstep;
            const char* a3 = a2 + kstep; const char* b3 = b2 + kstep;
            if (last && has_next) S.a_ready(nxt);
            if constexpr (SP2) {
            PG8_LDB(B0, 0, 0); PG8_LDB(B1, 0, 1); PG8_SCHED; PG8_LDA(At, 0, 0); PG8_STAGE(PG8_SA(1, 1), a1 + hstepA, voffA);
            PG8_WAIT_V(8); PG8_WAIT_L(0); PG8_BAR; PG8_MMA(0, 0, At, B0); PG8_MMA(0, 1, At, B1); PG8_BAR; PG8_SCHED;
            PG8_LDA(At, 0, 1); PG8_STAGE(PG8_SB(0, 0), b2, voffB); PG8_STAGE(PG8_SB(0, 1), b2 + hstepB, voffB); PG8_STAGE(PG8_SA(0, 0), a2, voffA);
            PG8_WAIT_V(8); PG8_WAIT_L(0); PG8_BAR; PG8_MMA(1, 0, At, B0); PG8_MMA(1, 1, At, B1); PG8_BAR; PG8_SCHED;
            PG8_LDB(B0, 1, 0); PG8_LDB(B1, 1, 1); PG8_SCHED; PG8_LDA(At, 1, 0); PG8_STAGE(PG8_SA(0, 1), a2 + hstepA, voffA);
            PG8_WAIT_V(8); PG8_WAIT_L(0); PG8_BAR; PG8_MMA(0, 0, At, B0); PG8_MMA(0, 1, At, B1); PG8_BAR; PG8_SCHED;
            PG8_LDA(At, 1, 1); PG8_STAGE(PG8_SB(1, 0), b3, voffB); PG8_STAGE(PG8_SB(1, 1), b3 + hstepB, voffB); PG8_STAGE(PG8_SA(1, 0), a3, voffA);
            PG8_WAIT_V(8); PG8_WAIT_L(0); PG8_BAR; PG8_MMA(1, 0, At, B0); PG8_MMA(1, 1, At, B1); PG8_BAR; PG8_SCHED;
            } else {
            PG8_LDB(B0, 0, 0); PG8_SCHED; PG8_LDA(At, 0, 0); PG8_STAGE(PG8_SA(1, 1), a1 + hstepA, voffA);
            PG8_WAIT_L(8); PG8_BAR; PG8_WAIT_L(0); PG8_MMA(0, 0, At, B0); PG8_BAR; PG8_SCHED;
            PG8_LDB(B1, 0, 1); PG8_STAGE(PG8_SB(0, 0), b2, voffB);
            PG8_BAR; PG8_WAIT_L(0); PG8_MMA(0, 1, At, B1); PG8_BAR;
            PG8_LDA(At, 0, 1); PG8_STAGE(PG8_SA(0, 0), a2, voffA);
            PG8_BAR; PG8_WAIT_L(0); PG8_MMA(1, 0, At, B0); PG8_BAR; PG8_SCHED;
            PG8_STAGE(PG8_SB(0, 1), b2 + hstepB, voffB);
            PG8_WAIT_V(6); PG8_BAR; PG8_MMA(1, 1, At, B1); PG8_BAR;
            PG8_LDB(B0, 1, 0); PG8_SCHED; PG8_LDA(At, 1, 0); PG8_STAGE(PG8_SA(0, 1), a2 + hstepA, voffA);
            PG8_WAIT_L(8); PG8_BAR; PG8_WAIT_L(0); PG8_MMA(0, 0, At, B0); PG8_BAR; PG8_SCHED;
            PG8_LDB(B1, 1, 1); PG8_STAGE(PG8_SB(1, 0), b3, voffB);
            PG8_BAR; PG8_WAIT_L(0); PG8_MMA(0, 1, At, B1); PG8_BAR;
            PG8_LDA(At, 1, 1); PG8_STAGE(PG8_SA(1, 0), a3, voffA);
            PG8_BAR; PG8_WAIT_L(0); PG8_MMA(1, 0, At, B0); PG8_BAR; PG8_SCHED;
            PG8_STAGE(PG8_SB(1, 1), b3 + hstepB, voffB);
            PG8_WAIT_V(6); PG8_BAR; PG8_MMA(1, 1, At, B1); PG8_BAR;
            }
        }
        if constexpr (ALIGN_EPI) { if (wr == 0) PG8_BAR; }
        if constexpr (!Epi::AFTER_DRAIN) { E(acc, cur, wr, wc, fr, fq); S.done(cur); }
        if (!has_next) break;
#pragma unroll
        for (int a = 0; a < 2; ++a)
#pragma unroll
            for (int b = 0; b < 2; ++b)
#pragma unroll
                for (int m = 0; m < 4; ++m)
#pragma unroll
                    for (int n = 0; n < 2; ++n) acc[a][b][m][n] = (f32x4){0.f, 0.f, 0.f, 0.f};
        cur = nxt; cA = nA; cB = nB; ++ui;
        if constexpr (ALIGN_EPI) { if (wr == 1) PG8_BAR; }
    }
    PG8_WAIT_V(0);
    if constexpr (!ALIGN_EPI) { if (wr == 0) PG8_BAR; }
    PG8_BAR;
    if constexpr (Epi::AFTER_DRAIN) { E.fused(acc, cur, wr, wc, fr, fq, lds, wid, lane); S.done(cur); }
#undef PG8_SA
#undef PG8_SB
#undef PG8_STAGE
#undef PG8_LDA
#undef PG8_LDB
#undef PG8_MMA
#undef PG8_WAIT_V
#undef PG8_WAIT_L
#undef PG8_BAR
#undef PG8_SCHED
}
}
#define LAS __attribute__((address_space(3)))
typedef unsigned short bf16_t;
typedef short bf16x8 __attribute__((ext_vector_type(8)));
typedef float f32x4 __attribute__((ext_vector_type(4)));
typedef unsigned u32x4 __attribute__((ext_vector_type(4)));
typedef unsigned u32x2 __attribute__((ext_vector_type(2)));
using pg8::cvt_pk_bf16;

constexpr int NTOK = 16384, DM = 1024, SEQ = 8192, NIN = 7176;
constexpr int NPA = 4096;
constexpr int NG = 3072;
constexpr float EPSF = 1e-6f;
constexpr int C_MQ = 0, C_MK = 512, C_MV = 1024, C_MO = 1536, C_MZ = 2048, C_PU = 2560, C_PZ = 2816, C_SQ = 3072, C_SK = 3328, C_SV = 3584, C_SZ = 3840;
constexpr size_t MiB = 1u << 20;
constexpr size_t WS_WIN = 0, WS_WBR = 14 * MiB, WS_WOUT = 16 * MiB, WS_H = 18 * MiB, WS_Y = 50 * MiB, WS_PROJ = 82 * MiB, WS_G = 82 * MiB, WS_MERGED = 178 * MiB,
                 WS_DC = 210 * MiB, WS_SMALL = 242 * MiB;
constexpr size_t SM_MODP = 0;
constexpr size_t SM_GATEV = SM_MODP + 2 * 16 * 2 * 3072 * 4;
constexpr size_t SM_IF = SM_GATEV + 2 * 2 * 1024 * 4;
constexpr size_t SM_DN = SM_IF + 2 * (size_t)NTOK * 8 * 4;
constexpr size_t SM_BEND = SM_DN + 2 * 512 * 128 * 4;
constexpr size_t SM_AMAX = SM_BEND + 4;
constexpr size_t SM_MPREV = SM_BEND + 2 * 512 * 128;
constexpr size_t SM_CPB = (SM_MPREV + 2 * 512 * 4 + 255) & ~(size_t)255;
constexpr size_t SM_XBAR = SM_CPB + (size_t)256 * 32768;
constexpr size_t XBAR_BYTES = 32768;
constexpr size_t SM_XEX = SM_XBAR + XBAR_BYTES;
constexpr size_t SM_END = SM_XEX + (size_t)NTOK * 4 * 8;
static_assert(WS_SMALL + SM_END <= 256 * MiB, "workspace map");
__device__ __forceinline__ bf16_t* cprev_slot(unsigned char* ws, int u) { return (bf16_t*)(u < 256 ? ws + WS_WIN + (size_t)u * 32768 : ws + WS_SMALL + SM_CPB + (size_t)(u - 256) * 32768); }
constexpr int LDS_BYTES = 147456;

struct Params {
    const float *x, *c, *norm_g, *w_ada, *b_ada, *w_in, *m_gate_b, *conv_w, *conv_b, *m_norm_g, *pool_w, *pool_scale, *w_br_m, *w_br_p, *w_br_s, *gate_b, *w_out, *final_g;
    float* out; unsigned char* ws; int ph_lo, ph_hi;
};

__device__ __forceinline__ float bf2f(unsigned short h) { return __uint_as_float(((unsigned)h) << 16); }
__device__ __forceinline__ float bflo(unsigned w) { return __uint_as_float(w << 16); }
__device__ __forceinline__ float bfhi(unsigned w) { return __uint_as_float(w & 0xffff0000u); }
__device__ __forceinline__ unsigned short f2bf(float f) { return (unsigned short)(cvt_pk_bf16(f, 0.f) & 0xffffu); }
__device__ __forceinline__ float fsigmoid(float x) { return __builtin_amdgcn_rcpf(1.f + __expf(-x)); }
__device__ __forceinline__ float fsilu(float x) { return x * fsigmoid(x); }
__device__ __forceinline__ float logsig(float x) { return fminf(x, 0.f) - log1pf(__expf(-fabsf(x))); }
__device__ __forceinline__ float wave_sum(float v) {
#pragma unroll
    for (int m = 32; m >= 1; m >>= 1) v += __shfl_xor(v, m);
    return v;
}
__device__ __forceinline__ f32x4 mfma16(bf16x8 a, bf16x8 b, f32x4 c) { return __builtin_amdgcn_mfma_f32_16x16x32_bf16(a, b, c, 0, 0, 0); }
__device__ __forceinline__ bf16x8 ldfrag(const LAS unsigned char* p) { return *(const LAS bf16x8*)p; }
__device__ __forceinline__ bf16x8 ldfrag2(const LAS unsigned char* pa, const LAS unsigned char* pb) {
    const u32x2 a = *(const LAS u32x2*)pa, b = *(const LAS u32x2*)pb; const u32x4 c = {a.x, a.y, b.x, b.y}; return __builtin_bit_cast(bf16x8, c);
}

#ifndef MK_WT
#define MK_WT 0
#endif
#if MK_WT
__device__ __forceinline__ void st16(void* p, u32x4 v) { asm volatile("global_store_dwordx4 %0, %1, off sc0 sc1\n\ts_nop 1" :: "v"(p), "v"(v) : "memory"); }
__device__ __forceinline__ void st16f(void* p, f32x4 v) { asm volatile("global_store_dwordx4 %0, %1, off sc0 sc1\n\ts_nop 1" :: "v"(p), "v"(v) : "memory"); }
__device__ __forceinline__ void st8(void* p, u32x2 v) { asm volatile("global_store_dwordx2 %0, %1, off sc0 sc1\n\ts_nop 1" :: "v"(p), "v"(v) : "memory"); }
__device__ __forceinline__ void st4(void* p, unsigned v) { asm volatile("global_store_dword %0, %1, off sc0 sc1\n\ts_nop 1" :: "v"(p), "v"(v) : "memory"); }
__device__ __forceinline__ void st4f(void* p, float v) { asm volatile("global_store_dword %0, %1, off sc0 sc1\n\ts_nop 1" :: "v"(p), "v"(v) : "memory"); }
#else
__device__ __forceinline__ void st16(void* p, u32x4 v) { *(u32x4*)p = v; }
__device__ __forceinline__ void st16f(void* p, f32x4 v) { *(f32x4*)p = v; }
__device__ __forceinline__ void st8(void* p, u32x2 v) { *(u32x2*)p = v; }
__device__ __forceinline__ void st4(void* p, unsigned v) { *(unsigned*)p = v; }
__device__ __forceinline__ void st4f(void* p, float v) { *(float*)p = v; }
#endif

struct NoHook { static constexpr bool ON = false; static constexpr int T1 = -1, T2 = -1;
    __device__ __forceinline__ void operator()(f32x4 (&)[2][2][4][2], const pg8::Unit&, int, int, int, int, int) const {} };

struct EpiProj {
    static constexpr bool PERM = true, AFTER_DRAIN = false;
    bf16_t* O; int pitch; int raw;
    __device__ __forceinline__ void operator()(const f32x4 (&acc)[2][2][4][2], const pg8::Unit& u, int wr, int wc, int fr, int fq) const {
        const int pn = u.pn; const int act = raw ? 0 : ((pn == 6 || pn == 7) ? 1 : ((pn == 8 || pn == 9 || pn == 11 || pn == 15) ? 2 : (pn == 12 ? 3 : 0)));
        const int row0 = u.pm * 256 + wr * 64 + fr, col0 = pn * 256 + wc * 32 + 8 * fq;
#pragma unroll
        for (int ai = 0; ai < 2; ++ai)
#pragma unroll
            for (int m = 0; m < 4; ++m) { bf16_t* rowp = O + (size_t)(row0 + ai * 128 + m * 16) * pitch + col0;
#pragma unroll
                for (int bj = 0; bj < 2; ++bj) { float v[8];
#pragma unroll
                    for (int e = 0; e < 4; ++e) { v[e] = acc[ai][bj][m][0][e]; v[4 + e] = acc[ai][bj][m][1][e]; }
                    if (act == 1) {
#pragma unroll
                        for (int e = 0; e < 8; ++e) v[e] = fsigmoid(v[e]);
                    } else if (act == 2) {
#pragma unroll
                        for (int e = 0; e < 8; ++e) v[e] = fsilu(v[e]);
                    } else if (act == 3) {
#pragma unroll
                        for (int e = 0; e < 8; ++e) v[e] *= 0.18033688011112042f;
                    }
                    u32x4 w; w.x = cvt_pk_bf16(v[0], v[1]); w.y = cvt_pk_bf16(v[2], v[3]); w.z = cvt_pk_bf16(v[4], v[5]); w.w = cvt_pk_bf16(v[6], v[7]);
                    st16(rowp + bj * 128, w); } }
    }
};

__device__ __forceinline__ void gate_rescale(f32x4 (&acc)[2][2][4][2], const bf16_t* G, const float* gbias, int pm, int pn, int goff) {
    int tx_ = threadIdx.x; asm volatile("" : "+v"(tx_)); const int wid = tx_ >> 6, lane = tx_ & 63, wr = wid >> 2, wc = wid & 3, fr = lane & 15, fq = lane >> 4;
    const int row0 = pm * 256 + wr * 64 + fr, col0 = pn * 256 + wc * 32 + 8 * fq;
    __builtin_amdgcn_sched_barrier(0);
#pragma unroll
    for (int bj = 0; bj < 2; ++bj) {
        const f32x4 ba0 = *(const f32x4*)(gbias + goff + col0 + bj * 128), ba1 = *(const f32x4*)(gbias + goff + col0 + bj * 128 + 4);
        const f32x4 bb0 = *(const f32x4*)(gbias + goff + 1024 + col0 + bj * 128), bb1 = *(const f32x4*)(gbias + goff + 1024 + col0 + bj * 128 + 4);
#pragma unroll
        for (int ai = 0; ai < 2; ++ai)
#pragma unroll
            for (int m = 0; m < 4; ++m) { const bf16_t* rowp = G + (size_t)(row0 + ai * 128 + m * 16) * NG + goff + col0 + bj * 128;
                const u32x4 a = *(const u32x4*)rowp, b = *(const u32x4*)(rowp + 1024);
                const unsigned aw[4] = {a.x, a.y, a.z, a.w}, bw[4] = {b.x, b.y, b.z, b.w};
                f32x4 r0, r1;
#pragma unroll
                for (int e = 0; e < 2; ++e) {
                    r0[2 * e]     = (1.f + __expf(-(bflo(bw[e]) + bb0[2 * e])))         * __builtin_amdgcn_rcpf(1.f + __expf(-(bflo(aw[e]) + ba0[2 * e])));
                    r0[2 * e + 1] = (1.f + __expf(-(bfhi(bw[e]) + bb0[2 * e + 1])))     * __builtin_amdgcn_rcpf(1.f + __expf(-(bfhi(aw[e]) + ba0[2 * e + 1])));
                    r1[2 * e]     = (1.f + __expf(-(bflo(bw[2 + e]) + bb1[2 * e])))     * __builtin_amdgcn_rcpf(1.f + __expf(-(bflo(aw[2 + e]) + ba1[2 * e])));
                    r1[2 * e + 1] = (1.f + __expf(-(bfhi(bw[2 + e]) + bb1[2 * e + 1]))) * __builtin_amdgcn_rcpf(1.f + __expf(-(bfhi(aw[2 + e]) + ba1[2 * e + 1]))); }
                acc[ai][bj][m][0] *= r0; acc[ai][bj][m][1] *= r1;
                asm volatile("" : "+v"(acc[ai][bj][m][0]), "+v"(acc[ai][bj][m][1]) :: "memory");
                __builtin_amdgcn_sched_barrier(0); }
    }
    asm volatile("s_waitcnt vmcnt(0)" ::: "memory"); __builtin_amdgcn_sched_barrier(0);
}
struct EpiNone { static constexpr bool PERM = true, AFTER_DRAIN = true;
    __device__ __forceinline__ void fused(const f32x4 (&)[2][2][4][2], const pg8::Unit&, int, int, int, int, LAS unsigned char*, int, int) const {} };
struct EpiMerge {
    static constexpr bool PERM = true, AFTER_DRAIN = true;
    bf16_t* O; const bf16_t* G; const float* gbias;
    __device__ __forceinline__ void fused(const f32x4 (&acc)[2][2][4][2], const pg8::Unit& u, int wr, int wc, int fr, int fq, LAS unsigned char*, int, int) const {
        const int row0 = u.pm * 256 + wr * 64 + fr, col0 = u.pn * 256 + wc * 32 + 8 * fq;
#pragma unroll
        for (int ai = 0; ai < 2; ++ai)
#pragma unroll
            for (int m = 0; m < 4; ++m) { const size_t row = (size_t)(row0 + ai * 128 + m * 16);
#pragma unroll
                for (int bj = 0; bj < 2; ++bj) { const u32x4 g = *(const u32x4*)(G + row * NG + 2048 + col0 + bj * 128);
                    const f32x4 b0 = *(const f32x4*)(gbias + 2048 + col0 + bj * 128), b1 = *(const f32x4*)(gbias + 2048 + col0 + bj * 128 + 4);
                    const f32x4 a0 = acc[ai][bj][m][0], a1 = acc[ai][bj][m][1];
                    u32x4 w; w.x = cvt_pk_bf16(a0[0] * fsigmoid(bflo(g.x) + b0[0]), a0[1] * fsigmoid(bfhi(g.x) + b0[1])); w.y = cvt_pk_bf16(a0[2] * fsigmoid(bflo(g.y) + b0[2]), a0[3] * fsigmoid(bfhi(g.y) + b0[3]));
                    w.z = cvt_pk_bf16(a1[0] * fsigmoid(bflo(g.z) + b1[0]), a1[1] * fsigmoid(bfhi(g.z) + b1[1])); w.w = cvt_pk_bf16(a1[2] * fsigmoid(bflo(g.w) + b1[2]), a1[3] * fsigmoid(bfhi(g.w) + b1[3]));
                    st16(O + row * DM + col0 + bj * 128, w); } }
    }
};
struct EpiOut {
    static constexpr bool PERM = true, AFTER_DRAIN = true;
    const float* xin; float* xout; const float* gate;
    __device__ __forceinline__ void fused(const f32x4 (&acc)[2][2][4][2], const pg8::Unit& u, int wr, int wc, int fr, int fq, LAS unsigned char*, int, int) const {
        const int row0 = u.pm * 256 + wr * 64 + fr, col0 = u.pn * 256 + wc * 32 + 8 * fq; const float* gb = gate + ((u.pm * 256) / SEQ) * 1024;
#pragma unroll
        for (int bj = 0; bj < 2; ++bj) {
            const f32x4 g0 = *(const f32x4*)(gb + col0 + bj * 128), g1 = *(const f32x4*)(gb + col0 + bj * 128 + 4);
#pragma unroll
            for (int ai = 0; ai < 2; ++ai)
#pragma unroll
                for (int m = 0; m < 4; ++m) { const size_t off = (size_t)(row0 + ai * 128 + m * 16) * DM + col0 + bj * 128;
                    const f32x4 x0 = *(const f32x4*)(xin + off), x1 = *(const f32x4*)(xin + off + 4);
                    st16f(xout + off, x0 + g0 * acc[ai][bj][m][0]); st16f(xout + off + 4, x1 + g1 * acc[ai][bj][m][1]); }
        }
    }
};
struct EpiOutNorm {
    static constexpr bool PERM = true, AFTER_DRAIN = true;
    const float* xin; float* out; const float* gate; const float* fg; unsigned long long* xbuf; unsigned* cnt;
    __device__ __forceinline__ void fused(f32x4 (&acc)[2][2][4][2], const pg8::Unit& u, int wr, int wc, int fr, int fq, LAS unsigned char* lds, int wid, int lane) const {
        const int row0 = u.pm * 256 + wr * 64 + fr, col0 = u.pn * 256 + wc * 32 + 8 * fq; const float* gb = gate + ((u.pm * 256) / SEQ) * 1024;
        LAS float* P = (LAS float*)lds; LAS float* S = (LAS float*)(lds + 8192);
#pragma unroll
        for (int bj = 0; bj < 2; ++bj) {
            const f32x4 g0 = *(const f32x4*)(gb + col0 + bj * 128), g1 = *(const f32x4*)(gb + col0 + bj * 128 + 4);
#pragma unroll
            for (int ai = 0; ai < 2; ++ai)
#pragma unroll
                for (int m = 0; m < 4; ++m) { const size_t off = (size_t)(row0 + ai * 128 + m * 16) * DM + col0 + bj * 128;
                    acc[ai][bj][m][0] = *(const f32x4*)(xin + off) + g0 * acc[ai][bj][m][0]; acc[ai][bj][m][1] = *(const f32x4*)(xin + off + 4) + g1 * acc[ai][bj][m][1];
                    asm volatile("" : "+v"(acc[ai][bj][m][0]), "+v"(acc[ai][bj][m][1]) :: "memory"); }
        }
#pragma unroll
        for (int ai = 0; ai < 2; ++ai)
#pragma unroll
            for (int m = 0; m < 4; ++m) { float sq = 0.f;
#pragma unroll
                for (int bj = 0; bj < 2; ++bj)
#pragma unroll
                    for (int n = 0; n < 2; ++n) { const f32x4 v = acc[ai][bj][m][n]; sq += (v[0] * v[0] + v[1] * v[1]) + (v[2] * v[2] + v[3] * v[3]); }
                sq += __shfl_xor(sq, 16); sq += __shfl_xor(sq, 32);
                if (fq == 0) P[(ai * 128 + wr * 64 + m * 16 + fr) * 4 + wc] = sq; }
        __syncthreads();
        const int row = wid * 32 + (lane & 31);
        if (lane < 32) { const float t = (P[row * 4 + 0] + P[row * 4 + 1]) + (P[row * 4 + 2] + P[row * 4 + 3]);
            __hip_atomic_store(xbuf + ((size_t)(u.pm * 256 + row) * 4 + u.pn), (unsigned long long)__float_as_uint(t), __ATOMIC_RELAXED, __HIP_MEMORY_SCOPE_AGENT); }
        asm volatile("s_waitcnt vmcnt(0)" ::: "memory");
        if (lane == 0) __hip_atomic_fetch_add(cnt + 64 * u.pm, 1u, __ATOMIC_RELAXED, __HIP_MEMORY_SCOPE_AGENT);
        if (wid == 0) {
            for (unsigned spins = 0; spins < (1u << 22); ++spins) { if ((unsigned)__builtin_amdgcn_readfirstlane(__hip_atomic_load(cnt + 64 * u.pm, __ATOMIC_RELAXED, __HIP_MEMORY_SCOPE_AGENT)) >= 32u) break; __builtin_amdgcn_s_sleep(2); }
            __builtin_amdgcn_fence(__ATOMIC_ACQUIRE, "agent");
        }
        asm volatile("s_waitcnt vmcnt(0) lgkmcnt(0)" ::: "memory");
        __syncthreads();
        if (lane < 32) { const unsigned long long* slot = xbuf + (size_t)(u.pm * 256 + row) * 4; float t = 0.f;
#pragma unroll
            for (int q = 0; q < 4; ++q) t += __uint_as_float((unsigned)__hip_atomic_load(slot + q, __ATOMIC_RELAXED, __HIP_MEMORY_SCOPE_AGENT));
            S[row] = rsqrtf(t * (1.f / 1024.f) + EPSF); }
        __syncthreads();
#pragma unroll
        for (int bj = 0; bj < 2; ++bj) {
            const f32x4 f0 = *(const f32x4*)(fg + col0 + bj * 128), f1 = *(const f32x4*)(fg + col0 + bj * 128 + 4);
#pragma unroll
            for (int ai = 0; ai < 2; ++ai)
#pragma unroll
                for (int m = 0; m < 4; ++m) { const size_t off = (size_t)(row0 + ai * 128 + m * 16) * DM + col0 + bj * 128; const float r = S[ai * 128 + wr * 64 + m * 16 + fr];
                    *(f32x4*)(out + off) = acc[ai][bj][m][0] * r * f0; *(f32x4*)(out + off + 4) = acc[ai][bj][m][1] * r * f1; }
        }
    }
};
struct GateOrder { int pm, pn;
    __device__ __forceinline__ bool next(int i, pg8::Unit& u) const { if (i >= 3) return false; u.pm = pm; u.pn = pn + 4 * i; return true; }
    __device__ __forceinline__ void a_ready(const pg8::Unit&) const {}
    __device__ __forceinline__ void done(const pg8::Unit&) const {} };
struct OneUnit { int pm, pn;
    __device__ __forceinline__ bool next(int i, pg8::Unit& u) const { if (i >= 1) return false; u.pm = pm; u.pn = pn; return true; }
    __device__ __forceinline__ void a_ready(const pg8::Unit&) const {}
    __device__ __forceinline__ void done(const pg8::Unit&) const {} };

__device__ __forceinline__ int xcd_chunk_unit(int bx, int i) {
    const int x = bx & 7, q = (bx >> 3) + 32 * i, hd = q >> 4, cc = q & 15; return (x >> 2) * 256 + hd * 64 + (x & 3) * 16 + cc; }
__device__ __forceinline__ int xcd_pool_unit(int bx, int i) {
    const int x = bx & 7, q = (bx >> 3) + 32 * i; return (x * 32 + (q >> 2)) * 4 + (q & 3); }
__device__ __forceinline__ void phase_mod(const Params& p, float* MODP) {
    for (int u = blockIdx.x; u < 192; u += gridDim.x) {
        const int l = u / 96, r = u % 96, ks = r / 6, jb = r % 6; int tx_ = threadIdx.x; asm volatile("" : "+v"(tx_)); const int j = jb * 512 + tx_;
        const float* w = p.w_ada + ((size_t)l * 1024 + ks * 64) * 3072 + j; const float* c0 = p.c + ks * 64; const float* c1 = p.c + 1024 + ks * 64;
        float a0 = 0.f, a1 = 0.f;
#pragma unroll 8
        for (int k = 0; k < 64; ++k) { const float wv = w[(size_t)k * 3072]; a0 += c0[k] * wv; a1 += c1[k] * wv; }
        st4f(MODP + ((l * 16 + ks) * 2 + 0) * 3072 + j, a0); st4f(MODP + ((l * 16 + ks) * 2 + 1) * 3072 + j, a1);
    }
}

struct TItem { const float* src; int ld; bf16_t* dst; };
__device__ __forceinline__ TItem transpose_item(const Params& p, int l, int it, bf16_t* WinT, bf16_t* WbrT, bf16_t* WoutT) {
    TItem t;
    if (it < 1792) { const int nt = it >> 4, kt = it & 15, n0 = nt * 64, c0 = n0 < 1536 ? n0 : n0 + 8;
        t.src = p.w_in + (size_t)l * 1024 * NIN + (size_t)kt * 64 * NIN + c0; t.ld = NIN; t.dst = WinT + (size_t)n0 * 1024 + kt * 64;
    } else if (it < 2048) { const int j = it - 1792, nt = j >> 4, kt = j & 15, k0 = kt * 64;
        const float* src = k0 < 512 ? p.w_br_m + (size_t)l * 512 * 1024 + (size_t)k0 * 1024 : (k0 < 768 ? p.w_br_p + (size_t)l * 256 * 1024 + (size_t)(k0 - 512) * 1024 : p.w_br_s + (size_t)l * 256 * 1024 + (size_t)(k0 - 768) * 1024);
        t.src = src + nt * 64; t.ld = 1024; t.dst = WbrT + (size_t)nt * 64 * 1024 + k0;
    } else { const int j = it - 2048, nt = j >> 4, kt = j & 15;
        t.src = p.w_out + (size_t)l * 1024 * 1024 + (size_t)kt * 64 * 1024 + nt * 64; t.ld = 1024; t.dst = WoutT + (size_t)nt * 64 * 1024 + kt * 64; }
    return t;
}
__device__ __forceinline__ void phase_prep(const Params& p, int l, const float* xin, LAS unsigned char* lds, unsigned char* ws_in) {
    size_t wz_ = 0; asm volatile("" : "+s"(wz_)); unsigned char* ws = ws_in + wz_;
    int tid_ = threadIdx.x; asm volatile("" : "+v"(tid_)); const int tid = tid_, lane = tid & 63, wid = tid >> 6;
    bf16_t* WinT = (bf16_t*)(ws + WS_WIN); bf16_t* WbrT = (bf16_t*)(ws + WS_WBR); bf16_t* WoutT = (bf16_t*)(ws + WS_WOUT);
    LAS float* tl = (LAS float*)lds;
    { float tv[8]; int it = blockIdx.x;
      if (it < 2304) { const TItem t0 = transpose_item(p, l, it, WinT, WbrT, WoutT);
#pragma unroll
          for (int i = 0; i < 8; ++i) tv[i] = t0.src[(size_t)(i * 8 + (tid >> 6)) * t0.ld + (tid & 63)]; }
      for (; it < 2304; it += gridDim.x) {
          const TItem t = transpose_item(p, l, it, WinT, WbrT, WoutT);
#pragma unroll
          for (int i = 0; i < 8; ++i) tl[(i * 8 + (tid >> 6)) * 65 + (tid & 63)] = tv[i];
          __syncthreads();
          if (it + (int)gridDim.x < 2304) { const TItem tn = transpose_item(p, l, it + gridDim.x, WinT, WbrT, WoutT);
#pragma unroll
              for (int i = 0; i < 8; ++i) tv[i] = tn.src[(size_t)(i * 8 + (tid >> 6)) * tn.ld + (tid & 63)]; }
#pragma unroll
          for (int i = 0; i < 4; ++i) { const int nn = i * 16 + (tid >> 5), kk = (tid & 31) * 2; st4(t.dst + (size_t)nn * 1024 + kk, cvt_pk_bf16(tl[kk * 65 + nn], tl[(kk + 1) * 65 + nn])); }
          __syncthreads();
      } }
    const float* MODP = (const float*)(ws + WS_SMALL + SM_MODP) + (size_t)l * 16 * 2 * 3072;
    float* GATEV = (float*)(ws + WS_SMALL + SM_GATEV) + l * 2048; float* IFG = (float*)(ws + WS_SMALL + SM_IF + (size_t)l * NTOK * 32);
    bf16_t* H = (bf16_t*)(ws + WS_H);
    LAS float* A = (LAS float*)(lds + 16896); LAS float* Sh = A + 1024; LAS float* Wif = Sh + 1024;
    for (int rbi = blockIdx.x; rbi < 256; rbi += gridDim.x) {
        const int rb = (gridDim.x == 256) ? (rbi & 7) * 32 + (rbi >> 3) : rbi;
        const int b = (rb * 64) / SEQ;
        __syncthreads();
#pragma unroll
        for (int q = 0; q < 2; ++q) { const int k = tid + q * 512; float sh = p.b_ada[l * 3072 + k], sc = p.b_ada[l * 3072 + 1024 + k];
            for (int ks = 0; ks < 16; ++ks) { sh += MODP[(ks * 2 + b) * 3072 + k]; sc += MODP[(ks * 2 + b) * 3072 + 1024 + k]; }
            A[k] = p.norm_g[l * 1024 + k] * (1.f + sc); Sh[k] = sh; }
        if (rb < 4) { const int e = rb * 512 + tid, bb = e >> 10, j = e & 1023; float g = p.b_ada[l * 3072 + 2048 + j];
            for (int ks = 0; ks < 16; ++ks) g += MODP[(ks * 2 + bb) * 3072 + 2048 + j];
            st4f(GATEV + bb * 1024 + j, g); }
#pragma unroll
        for (int q = 0; q < 16; ++q) { const int e = tid + q * 512, k = e >> 3, g = e & 7; Wif[g * 1024 + k] = p.w_in[(size_t)l * 1024 * NIN + (size_t)k * NIN + 1536 + g]; }
        __syncthreads();
        f32x4 xn[4];
        { const float* xr0 = xin + (size_t)(rb * 64 + wid * 8) * DM;
#pragma unroll
          for (int j = 0; j < 4; ++j) xn[j] = *(const f32x4*)(xr0 + (j >> 1) * 512 + lane * 8 + (j & 1) * 4); }
        for (int i = 0; i < 8; ++i) {
            const int row = rb * 64 + wid * 8 + i;
            f32x4 xv[4]; float ss = 0.f;
#pragma unroll
            for (int j = 0; j < 4; ++j) { xv[j] = xn[j]; ss += xv[j][0] * xv[j][0] + xv[j][1] * xv[j][1] + xv[j][2] * xv[j][2] + xv[j][3] * xv[j][3]; }
            if (i < 7) { const float* xr1 = xin + (size_t)(row + 1) * DM;
#pragma unroll
                for (int j = 0; j < 4; ++j) xn[j] = *(const f32x4*)(xr1 + (j >> 1) * 512 + lane * 8 + (j & 1) * 4); }
            ss = wave_sum(ss); const float rstd = rsqrtf(ss * (1.f / 1024.f) + EPSF);
            float gp[8];
#pragma unroll
            for (int g = 0; g < 8; ++g) gp[g] = 0.f;
            f32x4 hv[4];
#pragma unroll
            for (int j = 0; j < 4; ++j) { const int k = (j >> 1) * 512 + lane * 8 + (j & 1) * 4; const f32x4 a = *(const LAS f32x4*)(A + k), sft = *(const LAS f32x4*)(Sh + k);
                hv[j] = xv[j] * rstd * a + sft;
#pragma unroll
                for (int g = 0; g < 8; ++g) { const f32x4 wv = *(const LAS f32x4*)(Wif + g * 1024 + k); gp[g] += hv[j][0] * wv[0] + hv[j][1] * wv[1] + hv[j][2] * wv[2] + hv[j][3] * wv[3]; } }
#pragma unroll
            for (int j = 0; j < 2; ++j) { u32x4 w; w.x = cvt_pk_bf16(hv[2 * j][0], hv[2 * j][1]); w.y = cvt_pk_bf16(hv[2 * j][2], hv[2 * j][3]); w.z = cvt_pk_bf16(hv[2 * j + 1][0], hv[2 * j + 1][1]); w.w = cvt_pk_bf16(hv[2 * j + 1][2], hv[2 * j + 1][3]);
                st16(H + (size_t)row * DM + j * 512 + lane * 8, w); }
#pragma unroll
            for (int g = 0; g < 8; ++g) gp[g] = wave_sum(gp[g]);
            float outv = gp[0];
#pragma unroll
            for (int g = 1; g < 8; ++g) outv = (lane == g) ? gp[g] : outv;
            if (lane < 8) st4f(IFG + (size_t)row * 8 + lane, outv + p.m_gate_b[l * 8 + lane]);
        }
    }
    __syncthreads();
}

constexpr int LP = 136;
constexpr int OFF_Q = 0, OFF_K = 34816, OFF_V = 69632, OFF_C = 104448, OFF_AR = 139264;
template <int MODE> __device__ __forceinline__ void mlstm_gates(const float* IFG, int tok0, int hd, float mprev, LAS float* ar, int tid) {
    if (tid < 64) { const int l = tid;
        const float i0 = IFG[(size_t)(tok0 + 2 * l) * 8 + hd], i1 = IFG[(size_t)(tok0 + 2 * l + 1) * 8 + hd];
        const float f0 = logsig(IFG[(size_t)(tok0 + 2 * l) * 8 + 4 + hd]), f1 = logsig(IFG[(size_t)(tok0 + 2 * l + 1) * 8 + 4 + hd]);
        float sc = f0 + f1;
#pragma unroll
        for (int d = 1; d < 64; d <<= 1) { const float t = __shfl_up(sc, d); if (l >= d) sc += t; }
        const float c1 = sc, c0 = sc - f1;
        ar[2 * l] = i0; ar[2 * l + 1] = i1; ar[128 + 2 * l] = c0; ar[128 + 2 * l + 1] = c1;
        if (MODE == 1) { const float bend = __shfl(c1, 63); const float a0 = bend - c0 + i0, a1 = bend - c1 + i1; float am = fmaxf(a0, a1);
#pragma unroll
            for (int m = 32; m >= 1; m >>= 1) am = fmaxf(am, __shfl_xor(am, m));
            ar[3 * 128 + 2 * l] = __expf(a0 - am); ar[3 * 128 + 2 * l + 1] = __expf(a1 - am);
            if (l == 0) { ar[7 * 128] = bend; ar[7 * 128 + 1] = am; } }
        if (MODE == 3) { const float g0 = i0 - c0, g1 = i1 - c1; float pm = fmaxf(g0, g1);
#pragma unroll
            for (int d = 1; d < 64; d <<= 1) { const float t = __shfl_up(pm, d); if (l >= d) pm = fmaxf(pm, t); }
            float pprev = __shfl_up(pm, 1); if (l == 0) pprev = -3.0e38f;
            const float pm0 = fmaxf(pprev, g0), pm1 = pm;
            const float mt0 = c0 + fmaxf(mprev, pm0), mt1 = c1 + fmaxf(mprev, pm1);
            ar[2 * 128 + 2 * l] = g0; ar[2 * 128 + 2 * l + 1] = g1;
            ar[3 * 128 + 2 * l] = __expf(c0 + mprev - mt0); ar[3 * 128 + 2 * l + 1] = __expf(c1 + mprev - mt1);
            ar[4 * 128 + 2 * l] = c0 - mt0; ar[4 * 128 + 2 * l + 1] = c1 - mt1;
            ar[5 * 128 + 2 * l] = __expf(-mt0); ar[5 * 128 + 2 * l + 1] = __expf(-mt1); }
    }
}
template <bool TR> __device__ __forceinline__ void stage_conv(const bf16_t* PROJ, int colbase, const float* cw, const float* cb, int ch0, int tok0, int pos0, float scale, LAS bf16_t* dst, int tid) {
    const int d0 = (tid & 15) * 8, s0 = (tid >> 4) * 4;
    float x[7][8];
    const bf16_t* src = PROJ + (size_t)tok0 * NPA + colbase + d0;
#pragma unroll
    for (int r = 0; r < 7; ++r) { const int sr = s0 - 3 + r; u32x4 v = {0u, 0u, 0u, 0u}; if (pos0 + sr >= 0) v = *(const u32x4*)(src + (ptrdiff_t)sr * NPA);
        x[r][0] = bflo(v.x); x[r][1] = bfhi(v.x); x[r][2] = bflo(v.y); x[r][3] = bfhi(v.y); x[r][4] = bflo(v.z); x[r][5] = bfhi(v.z); x[r][6] = bflo(v.w); x[r][7] = bfhi(v.w); }
    float o[4][8];
    { const f32x4 b0 = *(const f32x4*)(cb + ch0 + d0), b1 = *(const f32x4*)(cb + ch0 + d0 + 4);
#pragma unroll
      for (int i = 0; i < 4; ++i) { o[i][0] = b0[0]; o[i][1] = b0[1]; o[i][2] = b0[2]; o[i][3] = b0[3]; o[i][4] = b1[0]; o[i][5] = b1[1]; o[i][6] = b1[2]; o[i][7] = b1[3]; } }
#pragma unroll
    for (int j = 0; j < 4; ++j) { const f32x4 w0 = *(const f32x4*)(cw + j * 1024 + ch0 + d0), w1 = *(const f32x4*)(cw + j * 1024 + ch0 + d0 + 4);
#pragma unroll
        for (int i = 0; i < 4; ++i) { o[i][0] += w0[0] * x[i + j][0]; o[i][1] += w0[1] * x[i + j][1]; o[i][2] += w0[2] * x[i + j][2]; o[i][3] += w0[3] * x[i + j][3];
                                      o[i][4] += w1[0] * x[i + j][4]; o[i][5] += w1[1] * x[i + j][5]; o[i][6] += w1[2] * x[i + j][6]; o[i][7] += w1[3] * x[i + j][7]; } }
#pragma unroll
    for (int i = 0; i < 4; ++i)
#pragma unroll
        for (int c = 0; c < 8; ++c) o[i][c] = fsilu(o[i][c]) * scale;
    if (TR) {
#pragma unroll
        for (int c = 0; c < 8; ++c) { u32x2 w; w.x = cvt_pk_bf16(o[0][c], o[1][c]); w.y = cvt_pk_bf16(o[2][c], o[3][c]); *(LAS u32x2*)(dst + (d0 + c) * LP + s0) = w; }
    } else {
#pragma unroll
        for (int i = 0; i < 4; ++i) { u32x4 w; w.x = cvt_pk_bf16(o[i][0], o[i][1]); w.y = cvt_pk_bf16(o[i][2], o[i][3]); w.z = cvt_pk_bf16(o[i][4], o[i][5]); w.w = cvt_pk_bf16(o[i][6], o[i][7]); *(LAS u32x4*)(dst + (s0 + i) * LP + d0) = w; }
    }
}
template <bool SCALE> __device__ __forceinline__ void stage_vt(const bf16_t* PROJ, int tok0, int hd, const LAS float* wa, LAS bf16_t* dst, int tid) {
#pragma unroll
    for (int q = 0; q < 4; ++q) { const int s = tid & 127, d0 = ((tid >> 7) + 4 * q) * 8;
        const u32x4 v = *(const u32x4*)(PROJ + (size_t)(tok0 + s) * NPA + C_MV + hd * 128 + d0); const float sc = SCALE ? wa[s] : 1.f;
        const unsigned wv[4] = {v.x, v.y, v.z, v.w};
#pragma unroll
        for (int e = 0; e < 4; ++e) { const float lo = bflo(wv[e]) * sc, hi = bfhi(wv[e]) * sc;
            dst[(d0 + 2 * e) * LP + s] = SCALE ? f2bf(lo) : (bf16_t)(wv[e] & 0xffffu); dst[(d0 + 2 * e + 1) * LP + s] = SCALE ? f2bf(hi) : (bf16_t)(wv[e] >> 16); } }
}

__device__ __forceinline__ void mlstm_m1(const Params& p, int l, LAS unsigned char* lds, unsigned char* ws_in) {
    size_t wz_ = 0; asm volatile("" : "+s"(wz_)); unsigned char* ws = ws_in + wz_;
    int tid_ = threadIdx.x; asm volatile("" : "+v"(tid_)); const int tid = tid_, lane = tid & 63, wid = tid >> 6, fr = lane & 15, fq = lane >> 4;
    const bf16_t* PROJ = (const bf16_t*)(ws + WS_PROJ); const float* IFG = (const float*)(ws + WS_SMALL + SM_IF + (size_t)l * NTOK * 32);
    float* DC = (float*)(ws + WS_DC); float* DN = (float*)(ws + WS_SMALL + SM_DN + (size_t)l * 262144); float* BEND = (float*)(ws + WS_SMALL + SM_BEND + (size_t)l * 65536); float* AMAX = (float*)(ws + WS_SMALL + SM_AMAX + (size_t)l * 65536);
    LAS float* ar = (LAS float*)(lds + OFF_AR); LAS bf16_t* Vt = (LAS bf16_t*)(lds + OFF_V); LAS bf16_t* Kt = (LAS bf16_t*)(lds + OFF_K);
    for (int ui = 0, u = 0; (u = (gridDim.x == 256) ? (ui < 2 ? xcd_chunk_unit(blockIdx.x, ui) : 512) : (int)blockIdx.x + ui * (int)gridDim.x) < 512; ++ui) {
        const int b = u >> 8, hd = (u >> 6) & 3, c = u & 63, tok0 = b * SEQ + c * 128, pos0 = c * 128;
        __syncthreads();
        mlstm_gates<1>(IFG, tok0, hd, 0.f, ar, tid);
        __syncthreads();
        const float bend = ar[7 * 128], amax = ar[7 * 128 + 1];
        stage_vt<true>(PROJ, tok0, hd, ar + 3 * 128, Vt, tid);
        stage_conv<true>(PROJ, C_MK + hd * 128, p.conv_w + (size_t)l * 4096, p.conv_b + l * 1024, 512 + hd * 128, tok0, pos0, 0.08838834764831845f, Kt, tid);
        __syncthreads();
        f32x4 acc[8];
#pragma unroll
        for (int j = 0; j < 8; ++j) acc[j] = (f32x4){0.f, 0.f, 0.f, 0.f};
#pragma unroll
        for (int ks = 0; ks < 4; ++ks) { const bf16x8 a = ldfrag((const LAS unsigned char*)(Vt + (16 * wid + fr) * LP + ks * 32 + fq * 8));
#pragma unroll
            for (int j = 0; j < 8; ++j) acc[j] = mfma16(ldfrag((const LAS unsigned char*)(Kt + (16 * j + fr) * LP + ks * 32 + fq * 8)), a, acc[j]); }
        bf16_t* dcu = (bf16_t*)(DC + (size_t)u * 16384);
#pragma unroll
        for (int j = 0; j < 8; ++j) { u32x2 w; w.x = cvt_pk_bf16(acc[j][0], acc[j][1]); w.y = cvt_pk_bf16(acc[j][2], acc[j][3]); st8(dcu + (16 * wid + fr) * 128 + 16 * j + 4 * fq, w); }
        if (tid < 128) { float sn = 0.f;
#pragma unroll 4
            for (int jj = 0; jj < 16; ++jj) { const u32x4 kv = *(const LAS u32x4*)(Kt + tid * LP + jj * 8); const f32x4 w0 = *(const LAS f32x4*)(ar + 3 * 128 + jj * 8), w1 = *(const LAS f32x4*)(ar + 3 * 128 + jj * 8 + 4);
                sn += w0[0] * bflo(kv.x) + w0[1] * bfhi(kv.x) + w0[2] * bflo(kv.y) + w0[3] * bfhi(kv.y) + w1[0] * bflo(kv.z) + w1[1] * bfhi(kv.z) + w1[2] * bflo(kv.w) + w1[3] * bfhi(kv.w); }
            st4f(DN + u * 128 + tid, sn); }
        if (tid == 0) { st4f(BEND + u * 32, bend); st4f(AMAX + u * 32, amax); }
    }
    __syncthreads();
}

__device__ __forceinline__ void scan_load(float (&dcv)[64], unsigned char* ws, int idx) {
    const int bh = idx >> 14, e = idx & 16383; const bf16_t* base = (const bf16_t*)(ws + WS_DC) + (size_t)bh * 64 * 32768 + e;
#pragma unroll
    for (int c = 0; c < 64; ++c) dcv[c] = bf2f(base[(size_t)c * 32768]);
}
__device__ __forceinline__ void scan_finish(const float (&dcv)[64], int l, unsigned char* ws, int idx) {
    const float* BEND = (const float*)(ws + WS_SMALL + SM_BEND + (size_t)l * 65536); const float* AMAX = (const float*)(ws + WS_SMALL + SM_AMAX + (size_t)l * 65536);
    float* MPREV = (float*)(ws + WS_SMALL + SM_MPREV + (size_t)l * 2048);
    const int bh = idx >> 14, e = idx & 16383;
    float m = 0.f, cst = 0.f;
#pragma unroll
    for (int c = 0; c < 64; ++c) { const float be = BEND[(bh * 64 + c) * 32], am = AMAX[(bh * 64 + c) * 32]; const float mn = fmaxf(be + m, am), dec = __expf(be + m - mn), inw = __expf(am - mn);
        cprev_slot(ws, bh * 64 + c)[e] = f2bf(cst); cst = dec * cst + inw * dcv[c]; if (e == 0) st4f(MPREV + bh * 64 + c, m); m = mn; }
}
__device__ __forceinline__ void mlstm_scan(int l, unsigned char* ws_in) {
    size_t wz_ = 0; asm volatile("" : "+s"(wz_)); unsigned char* ws = ws_in + wz_;
    int tx_ = threadIdx.x; asm volatile("" : "+v"(tx_));
    for (int idx = blockIdx.x * 512 + tx_; idx < 8 * 16384; idx += gridDim.x * 512) { float dcv[64]; scan_load(dcv, ws, idx); scan_finish(dcv, l, ws, idx); }
}
__device__ __forceinline__ void mlstm_scan_n(int l, unsigned char* ws_in) {
    size_t wz_ = 0; asm volatile("" : "+s"(wz_)); unsigned char* ws = ws_in + wz_;
    float* DN = (float*)(ws + WS_SMALL + SM_DN + (size_t)l * 262144); const float* BEND = (const float*)(ws + WS_SMALL + SM_BEND + (size_t)l * 65536); const float* AMAX = (const float*)(ws + WS_SMALL + SM_AMAX + (size_t)l * 65536);
    int tx_ = threadIdx.x; asm volatile("" : "+v"(tx_));
    for (int idx = (tx_ < 64 && gridDim.x >= 16) ? (int)blockIdx.x * 64 + tx_ : (gridDim.x >= 16 ? 8 * 128 : (int)blockIdx.x * 512 + tx_); idx < 8 * 128; idx += (gridDim.x >= 16 ? 8 * 128 : gridDim.x * 512)) {
        const int bh = idx >> 7, e = idx & 127;
        float* base = DN + (size_t)bh * 64 * 128 + e;
        float dcv[64];
#pragma unroll
        for (int c = 0; c < 64; ++c) dcv[c] = base[c * 128];
        float m = 0.f, cst = 0.f;
#pragma unroll
        for (int c = 0; c < 64; ++c) { const float be = BEND[(bh * 64 + c) * 32], am = AMAX[(bh * 64 + c) * 32]; const float mn = fmaxf(be + m, am), dec = __expf(be + m - mn), inw = __expf(am - mn);
            st4f(base + c * 128, cst); cst = dec * cst + inw * dcv[c]; m = mn; }
    }
}

__device__ __forceinline__ void mlstm_m3(const Params& p, int l, LAS unsigned char* lds, unsigned char* ws_in) {
    size_t wz_ = 0; asm volatile("" : "+s"(wz_)); unsigned char* ws = ws_in + wz_;
    int tid_ = threadIdx.x; asm volatile("" : "+v"(tid_)); const int tid = tid_, lane = tid & 63, wid = tid >> 6, fr = lane & 15, fq = lane >> 4;
    const bf16_t* PROJ = (const bf16_t*)(ws + WS_PROJ); const float* IFG = (const float*)(ws + WS_SMALL + SM_IF + (size_t)l * NTOK * 32);
    const float* DC = (const float*)(ws + WS_DC); const float* DN = (const float*)(ws + WS_SMALL + SM_DN + (size_t)l * 262144); const float* MPREV = (const float*)(ws + WS_SMALL + SM_MPREV + (size_t)l * 2048);
    bf16_t* Y = (bf16_t*)(ws + WS_Y);
    LAS float* ar = (LAS float*)(lds + OFF_AR);
    LAS bf16_t* Qc = (LAS bf16_t*)(lds + OFF_Q); LAS bf16_t* Kc = (LAS bf16_t*)(lds + OFF_K); LAS bf16_t* Vt = (LAS bf16_t*)(lds + OFF_V); LAS bf16_t* Cp = (LAS bf16_t*)(lds + OFF_C);
    for (int ui = 0, u = 0; (u = (gridDim.x == 256) ? (ui < 2 ? xcd_chunk_unit(blockIdx.x, ui) : 512) : (int)blockIdx.x + ui * (int)gridDim.x) < 512; ++ui) {
        const int b = u >> 8, hd = (u >> 6) & 3, c = u & 63, tok0 = b * SEQ + c * 128, pos0 = c * 128;
        __syncthreads();
        const float mprev = MPREV[u];
        mlstm_gates<3>(IFG, tok0, hd, mprev, ar, tid);
        if (tid >= 64 && tid < 192) ar[6 * 128 + tid - 64] = DN[u * 128 + tid - 64];
        stage_conv<false>(PROJ, C_MQ + hd * 128, p.conv_w + (size_t)l * 4096, p.conv_b + l * 1024, hd * 128, tok0, pos0, 1.f, Qc, tid);
        stage_conv<false>(PROJ, C_MK + hd * 128, p.conv_w + (size_t)l * 4096, p.conv_b + l * 1024, 512 + hd * 128, tok0, pos0, 0.08838834764831845f, Kc, tid);
        stage_vt<false>(PROJ, tok0, hd, nullptr, Vt, tid);
        { const bf16_t* cpu = cprev_slot(ws, u);
#pragma unroll
          for (int q = 0; q < 4; ++q) { const int e = (q * 512 + tid) * 8, v = e >> 7, k = e & 127; *(LAS u32x4*)(Cp + v * LP + k) = *(const u32x4*)(cpu + e); } }
        __syncthreads();
        const int tl = 16 * wid + fr;
        bf16x8 qf[4];
#pragma unroll
        for (int ks = 0; ks < 4; ++ks) qf[ks] = ldfrag((const LAS unsigned char*)(Qc + tl * LP + ks * 32 + fq * 8));
        f32x4 acc[8];
#pragma unroll
        for (int vi = 0; vi < 8; ++vi) { acc[vi] = (f32x4){0.f, 0.f, 0.f, 0.f};
#pragma unroll
            for (int ks = 0; ks < 4; ++ks) acc[vi] = mfma16(ldfrag((const LAS unsigned char*)(Cp + (16 * vi + fr) * LP + ks * 32 + fq * 8)), qf[ks], acc[vi]); }
        float deni = 0.f;
#pragma unroll
        for (int kk = 0; kk < 4; ++kk) { const u32x4 qv = *(const LAS u32x4*)(Qc + tl * LP + fq * 32 + kk * 8); const f32x4 n0 = *(const LAS f32x4*)(ar + 6 * 128 + fq * 32 + kk * 8), n1 = *(const LAS f32x4*)(ar + 6 * 128 + fq * 32 + kk * 8 + 4);
            deni += n0[0] * bflo(qv.x) + n0[1] * bfhi(qv.x) + n0[2] * bflo(qv.y) + n0[3] * bfhi(qv.y) + n1[0] * bflo(qv.z) + n1[1] * bfhi(qv.z) + n1[2] * bflo(qv.w) + n1[3] * bfhi(qv.w); }
        deni += __shfl_xor(deni, 16); deni += __shfl_xor(deni, 32);
        const float wi = ar[3 * 128 + tl], et = ar[4 * 128 + tl], emt = ar[5 * 128 + tl];
#pragma unroll
        for (int vi = 0; vi < 8; ++vi) acc[vi] *= wi;
        float den = 0.f;
        for (int sp = 0; sp <= (wid >> 1); ++sp) {
            float pv[8];
#pragma unroll
            for (int h2 = 0; h2 < 2; ++h2) { const int tile = 2 * sp + h2; f32x4 sa = (f32x4){0.f, 0.f, 0.f, 0.f};
#pragma unroll
                for (int ks = 0; ks < 4; ++ks) sa = mfma16(ldfrag((const LAS unsigned char*)(Kc + (16 * tile + fr) * LP + ks * 32 + fq * 8)), qf[ks], sa);
                const f32x4 gk = *(const LAS f32x4*)(ar + 2 * 128 + 16 * tile + 4 * fq);
#pragma unroll
                for (int r = 0; r < 4; ++r) { const int sl = 16 * tile + 4 * fq + r; const float wgt = (sl <= tl) ? __expf(et + gk[r]) : 0.f; const float pp = wgt * sa[r]; den += pp; pv[h2 * 4 + r] = pp; } }
            u32x4 pw; pw.x = cvt_pk_bf16(pv[0], pv[1]); pw.y = cvt_pk_bf16(pv[2], pv[3]); pw.z = cvt_pk_bf16(pv[4], pv[5]); pw.w = cvt_pk_bf16(pv[6], pv[7]);
            const bf16x8 pf = __builtin_bit_cast(bf16x8, pw);
#pragma unroll
            for (int vi = 0; vi < 8; ++vi) { const LAS unsigned char* vr = (const LAS unsigned char*)(Vt + (16 * vi + fr) * LP + 32 * sp + 4 * fq);
                acc[vi] = mfma16(ldfrag2(vr, vr + 32), pf, acc[vi]); }
        }
        den += __shfl_xor(den, 16); den += __shfl_xor(den, 32);
        const float dtot = wi * deni + den; const float hinv = 1.f / fmaxf(fabsf(dtot), emt);
        const size_t tokr = (size_t)(tok0 + tl);
        float ssq = 0.f;
#pragma unroll
        for (int vi = 0; vi < 8; ++vi) { const u32x2 o = *(const u32x2*)(PROJ + tokr * NPA + C_MO + hd * 128 + 16 * vi + 4 * fq);
            acc[vi][0] *= hinv * bflo(o.x); acc[vi][1] *= hinv * bfhi(o.x); acc[vi][2] *= hinv * bflo(o.y); acc[vi][3] *= hinv * bfhi(o.y);
            ssq += acc[vi][0] * acc[vi][0] + acc[vi][1] * acc[vi][1] + acc[vi][2] * acc[vi][2] + acc[vi][3] * acc[vi][3]; }
        ssq += __shfl_xor(ssq, 16); ssq += __shfl_xor(ssq, 32);
        const float rinv = rsqrtf(ssq * (1.f / 128.f) + EPSF);
#pragma unroll
        for (int vi = 0; vi < 8; ++vi) { const int vc = hd * 128 + 16 * vi + 4 * fq; const u32x2 z = *(const u32x2*)(PROJ + tokr * NPA + C_MZ + vc); const f32x4 g = *(const f32x4*)(p.m_norm_g + l * 512 + vc);
            u32x2 w; w.x = cvt_pk_bf16(acc[vi][0] * rinv * g[0] * bflo(z.x), acc[vi][1] * rinv * g[1] * bfhi(z.x)); w.y = cvt_pk_bf16(acc[vi][2] * rinv * g[2] * bflo(z.y), acc[vi][3] * rinv * g[3] * bfhi(z.y));
            st8(Y + tokr * DM + vc, w); }
    }
    __syncthreads();
}

__device__ __forceinline__ void pool_phase(const Params& p, int l, LAS unsigned char* lds, unsigned char* ws_in) {
    size_t wz_ = 0; asm volatile("" : "+s"(wz_)); unsigned char* ws = ws_in + wz_;
    int tid_ = threadIdx.x; asm volatile("" : "+v"(tid_)); const int tid = tid_; const bf16_t* PROJ = (const bf16_t*)(ws + WS_PROJ); bf16_t* Y = (bf16_t*)(ws + WS_Y);
    LAS float* U = (LAS float*)lds; LAS float* Wp = (LAS float*)(lds + 20480); LAS float* Pm = (LAS float*)(lds + 36864);
    for (int pi = 0, pu = 0; (pu = (gridDim.x == 256) ? (pi < 4 ? xcd_pool_unit(blockIdx.x, pi) : 1024) : (int)blockIdx.x + pi * (int)gridDim.x) < 1024; ++pi) {
        const int tt = pu >> 2, g = pu & 3, tok0 = tt * 64, b = tok0 / SEQ, p0 = tok0 % SEQ, W = 2 << g;
        __syncthreads();
        for (int ch = tid; ch < 79 * 8; ch += 512) { const int row = ch >> 3, cc = (ch & 7) * 8, pos = p0 - 15 + row;
            u32x4 v = {0u, 0u, 0u, 0u}; if (pos >= 0) v = *(const u32x4*)(PROJ + (size_t)(b * SEQ + pos) * NPA + C_PU + g * 64 + cc);
            *(LAS f32x4*)(U + row * 64 + cc) = (f32x4){bflo(v.x), bfhi(v.x), bflo(v.y), bfhi(v.y)}; *(LAS f32x4*)(U + row * 64 + cc + 4) = (f32x4){bflo(v.z), bfhi(v.z), bflo(v.w), bfhi(v.w)}; }
#pragma unroll
        for (int q = 0; q < 8; ++q) Wp[q * 512 + tid] = p.pool_w[(size_t)l * 16384 + g * 4096 + q * 512 + tid];
        __syncthreads();
        const int t = tid >> 3, c0 = (tid & 7) * 8; const int cnt = min(W, p0 + t + 1); const float rc = 1.f / (float)cnt;
        { f32x4 s0 = (f32x4){0.f, 0.f, 0.f, 0.f}, s1 = s0;
          for (int j = 0; j < W; ++j) { s0 += *(const LAS f32x4*)(U + (15 + t - j) * 64 + c0); s1 += *(const LAS f32x4*)(U + (15 + t - j) * 64 + c0 + 4); }
          const f32x4 u0 = *(const LAS f32x4*)(U + (15 + t) * 64 + c0), u1 = *(const LAS f32x4*)(U + (15 + t) * 64 + c0 + 4);
#pragma unroll
          for (int e = 0; e < 4; ++e) { Pm[t * 65 + c0 + e] = s0[e] * rc - u0[e]; Pm[t * 65 + c0 + 4 + e] = s1[e] * rc - u1[e]; } }
        __syncthreads();
        float o[8];
#pragma unroll
        for (int e = 0; e < 8; ++e) o[e] = 0.f;
        for (int cc = 0; cc < 64; ++cc) { const float pv = Pm[t * 65 + cc]; const f32x4 w0 = *(const LAS f32x4*)(Wp + cc * 64 + c0), w1 = *(const LAS f32x4*)(Wp + cc * 64 + c0 + 4);
#pragma unroll
            for (int e = 0; e < 4; ++e) { o[e] += pv * w0[e]; o[4 + e] += pv * w1[e]; } }
        const size_t tok = (size_t)(tok0 + t); const u32x4 z = *(const u32x4*)(PROJ + tok * NPA + C_PZ + g * 64 + c0);
        const f32x4 s0 = *(const f32x4*)(p.pool_scale + l * 256 + g * 64 + c0), s1 = *(const f32x4*)(p.pool_scale + l * 256 + g * 64 + c0 + 4);
        u32x4 w; w.x = cvt_pk_bf16(o[0] * s0[0] * bflo(z.x), o[1] * s0[1] * bfhi(z.x)); w.y = cvt_pk_bf16(o[2] * s0[2] * bflo(z.y), o[3] * s0[3] * bfhi(z.y));
        w.z = cvt_pk_bf16(o[4] * s1[0] * bflo(z.z), o[5] * s1[1] * bfhi(z.z)); w.w = cvt_pk_bf16(o[6] * s1[2] * bflo(z.w), o[7] * s1[3] * bfhi(z.w));
        st16(Y + tok * DM + 512 + g * 64 + c0, w);
    }
    __syncthreads();
}

constexpr float SB_DEAD = -104.f * 1.4426950408889634f;
template <bool DIAG> __device__ __forceinline__ f32x4 sb_tile(const f32x4 z, int sbase, int tq, int fq, float& L) {
    float lf[4], ls[4];
#pragma unroll
    for (int r = 0; r < 4; ++r) { const float zz = z[r], l1p = __builtin_amdgcn_logf(1.f + __builtin_amdgcn_exp2f(-fabsf(zz)));
        const float lfv = -(fmaxf(zz, 0.f) + l1p), lsv = fminf(zz, 0.f) - l1p;
        if (DIAG) { const bool valid = (sbase + r) < tq; lf[r] = valid ? lfv : 0.f; ls[r] = valid ? lsv : -1.0e30f; } else { lf[r] = lfv; ls[r] = lsv; } }
    const float suf2 = lf[3], suf1 = suf2 + lf[2], suf0 = suf1 + lf[1], T = suf0 + lf[0];
    const float T16 = __shfl_down(T, 16), T32 = __shfl_down(T, 32), T48 = __shfl_down(T, 48);
    const float E = (fq < 3 ? T16 : 0.f) + (fq < 2 ? T32 : 0.f) + (fq < 1 ? T48 : 0.f);
    float Tt = T + __shfl_xor(T, 16); Tt += __shfl_xor(Tt, 32);
    const float base = L + E;
    f32x4 pv; pv[0] = __builtin_amdgcn_exp2f(ls[0] + base + suf0); pv[1] = __builtin_amdgcn_exp2f(ls[1] + base + suf1); pv[2] = __builtin_amdgcn_exp2f(ls[2] + base + suf2); pv[3] = __builtin_amdgcn_exp2f(ls[3] + base);
    L += Tt; return pv;
}
__device__ __forceinline__ void sb_phase(const Params& p, LAS unsigned char* lds, unsigned char* ws_in, int u_first, int u_end) {
    size_t wz_ = 0; asm volatile("" : "+s"(wz_)); unsigned char* ws = ws_in + wz_;
    int tid_ = threadIdx.x; asm volatile("" : "+v"(tid_)); const int tid = tid_, lane = tid & 63, wid = tid >> 6, fr = lane & 15, fq = lane >> 4;
    const bf16_t* PROJ = (const bf16_t*)(ws + WS_PROJ); bf16_t* Y = (bf16_t*)(ws + WS_Y);
    LAS bf16_t* Ks = (LAS bf16_t*)lds; LAS bf16_t* Vt = (LAS bf16_t*)(lds + 18432); LAS int* flags = (LAS int*)(lds + 36864);
    for (int u = u_first; u < u_end; u += gridDim.x) {
        const int b = u >> 8, hd = (u >> 6) & 3, qb = u & 63;
        const int tq = qb * 128 + 16 * wid + fr; const size_t tokq = (size_t)(b * SEQ + tq);
        bf16x8 qf[2];
#pragma unroll
        for (int ks = 0; ks < 2; ++ks) qf[ks] = *(const bf16x8*)(PROJ + tokq * NPA + C_SQ + hd * 64 + ks * 32 + fq * 8);
        f32x4 acc[4];
#pragma unroll
        for (int i = 0; i < 4; ++i) acc[i] = (f32x4){0.f, 0.f, 0.f, 0.f};
        float Lrun = 0.f;
        u32x4 kreg[2], vreg[2];
#pragma unroll
        for (int q = 0; q < 2; ++q) { const int row = tid & 127, d0 = ((tid >> 7) + 4 * q) * 8; const size_t tk = (size_t)(b * SEQ + qb * 128 + row);
            kreg[q] = *(const u32x4*)(PROJ + tk * NPA + C_SK + hd * 64 + d0); vreg[q] = *(const u32x4*)(PROJ + tk * NPA + C_SV + hd * 64 + d0); }
        for (int kb = qb; kb >= 0; --kb) {
            __syncthreads();
#pragma unroll
            for (int q = 0; q < 2; ++q) { const int row = tid & 127, d0 = ((tid >> 7) + 4 * q) * 8;
                *(LAS u32x4*)(Ks + row * 72 + d0) = kreg[q];
                const unsigned wv[4] = {vreg[q].x, vreg[q].y, vreg[q].z, vreg[q].w};
#pragma unroll
                for (int e = 0; e < 4; ++e) { Vt[(d0 + 2 * e) * LP + row] = (bf16_t)(wv[e] & 0xffffu); Vt[(d0 + 2 * e + 1) * LP + row] = (bf16_t)(wv[e] >> 16); } }
            if (kb > 0) {
#pragma unroll
                for (int q = 0; q < 2; ++q) { const int row = tid & 127, d0 = ((tid >> 7) + 4 * q) * 8; const size_t tk = (size_t)(b * SEQ + (kb - 1) * 128 + row);
                    kreg[q] = *(const u32x4*)(PROJ + tk * NPA + C_SK + hd * 64 + d0); vreg[q] = *(const u32x4*)(PROJ + tk * NPA + C_SV + hd * 64 + d0); } }
            if (tid < 8) flags[tid] = 0;
            __syncthreads();
            const bool walive = __ballot(Lrun >= SB_DEAD) != 0ull;
            if (walive) {
                const int sp_hi = (kb == qb) ? (wid >> 1) : 3;
                for (int sp = sp_hi; sp >= 0; --sp) {
                    if (__ballot(Lrun >= SB_DEAD) == 0ull) break;
                    f32x4 pvv[2];
#pragma unroll
                    for (int h2 = 1; h2 >= 0; --h2) { const int tile = 2 * sp + h2;
                        f32x4 z = (f32x4){0.f, 0.f, 0.f, 0.f};
#pragma unroll
                        for (int ks = 0; ks < 2; ++ks) z = mfma16(ldfrag((const LAS unsigned char*)(Ks + (16 * tile + fr) * 72 + ks * 32 + fq * 8)), qf[ks], z);
                        const int sbase = kb * 128 + 16 * tile + 4 * fq;
                        pvv[h2] = (kb == qb) ? sb_tile<true>(z, sbase, tq, fq, Lrun) : sb_tile<false>(z, sbase, tq, fq, Lrun); }
                    const float pv[8] = {pvv[0][0], pvv[0][1], pvv[0][2], pvv[0][3], pvv[1][0], pvv[1][1], pvv[1][2], pvv[1][3]};
                    u32x4 pw; pw.x = cvt_pk_bf16(pv[0], pv[1]); pw.y = cvt_pk_bf16(pv[2], pv[3]); pw.z = cvt_pk_bf16(pv[4], pv[5]); pw.w = cvt_pk_bf16(pv[6], pv[7]);
                    const bf16x8 pf = __builtin_bit_cast(bf16x8, pw);
#pragma unroll
                    for (int i = 0; i < 4; ++i) { const LAS unsigned char* vr = (const LAS unsigned char*)(Vt + (16 * i + fr) * LP + 32 * sp + 4 * fq);
                        acc[i] = mfma16(ldfrag2(vr, vr + 32), pf, acc[i]); }
                }
            }
            const bool still = __ballot(Lrun >= SB_DEAD) != 0ull;
            if (lane == 0 && still) flags[wid] = 1;
            __syncthreads();
            int any = 0;
#pragma unroll
            for (int i = 0; i < 8; ++i) any |= flags[i];
            if (!any) break;
        }
#pragma unroll
        for (int i = 0; i < 4; ++i) { const int dc = hd * 64 + 16 * i + 4 * fq; const u32x2 z = *(const u32x2*)(PROJ + tokq * NPA + C_SZ + dc);
            u32x2 w; w.x = cvt_pk_bf16(acc[i][0] * bflo(z.x), acc[i][1] * bfhi(z.x)); w.y = cvt_pk_bf16(acc[i][2] * bflo(z.y), acc[i][3] * bfhi(z.y));
            st8(Y + tokq * DM + 768 + dc, w); }
    }
    __syncthreads();
}

__device__ __forceinline__ void final_norm(const Params& p) {
    int tid_ = threadIdx.x; asm volatile("" : "+v"(tid_)); const int tid = tid_, lane = tid & 63, wid = tid >> 6;
    const int stride = gridDim.x * 8; int row = blockIdx.x * 8 + wid;
    f32x4 g[4];
#pragma unroll
    for (int j = 0; j < 4; ++j) g[j] = *(const f32x4*)(p.final_g + j * 256 + lane * 4);
    f32x4 xn[4];
    if (row < NTOK) {
#pragma unroll
        for (int j = 0; j < 4; ++j) xn[j] = *(const f32x4*)(p.out + (size_t)row * DM + j * 256 + lane * 4); }
    for (; row < NTOK; row += stride) {
        float* xr = p.out + (size_t)row * DM; f32x4 xv[4]; float ss = 0.f;
#pragma unroll
        for (int j = 0; j < 4; ++j) { xv[j] = xn[j]; ss += xv[j][0] * xv[j][0] + xv[j][1] * xv[j][1] + xv[j][2] * xv[j][2] + xv[j][3] * xv[j][3]; }
        if (row + stride < NTOK) {
#pragma unroll
            for (int j = 0; j < 4; ++j) xn[j] = *(const f32x4*)(p.out + (size_t)(row + stride) * DM + j * 256 + lane * 4); }
        ss = wave_sum(ss); const float rstd = rsqrtf(ss * (1.f / 1024.f) + EPSF);
#pragma unroll
        for (int j = 0; j < 4; ++j) *(f32x4*)(xr + j * 256 + lane * 4) = xv[j] * rstd * g[j];
    }
}

#define XB_TMO      128
#define XB_XCNT(j)  (256  + 64 * (j))
#define XB_XSUB(j)  (1280 + 64 * (j))
#define XB_XGEN(j)  (2304 + 64 * (j))
#define XB_TOP      3328
#define XB_TOPGEN   3392
#define XCD_BAR_WORDS 3456
#define XB_SPIN_CAP (1u << 18)

__device__ __forceinline__ unsigned xb_ld(unsigned* p)              { return __hip_atomic_load(p, __ATOMIC_RELAXED, __HIP_MEMORY_SCOPE_AGENT); }
__device__ __forceinline__ unsigned xb_add(unsigned* p, unsigned v) { return __hip_atomic_fetch_add(p, v, __ATOMIC_RELAXED, __HIP_MEMORY_SCOPE_AGENT); }
__device__ __forceinline__ unsigned xb_xcc_id() { return (unsigned)__builtin_amdgcn_s_getreg((3 << 11) | 20) & 0xFu; }
#define XB_SPIN(cond, bar) do { unsigned _sp = 0; while (cond) { __builtin_amdgcn_s_sleep(1); \
    if ((++_sp & 255u) == 0u) { if (xb_ld(&(bar)[XB_TMO])) break; if (_sp > XB_SPIN_CAP) { atomicAdd(&(bar)[XB_TMO], 1u); break; } } } } while (0)

struct XcdBarrier {
    unsigned* bar; unsigned x;
    volatile LAS unsigned* st;
};

__device__ __forceinline__ XcdBarrier xcd_barrier_post(unsigned* bar, volatile LAS unsigned* st) {
    XcdBarrier b; b.bar = bar; b.x = xb_xcc_id(); b.st = st;
    if (threadIdx.x == 0) (void)xb_add(&bar[XB_XCNT(b.x)], 1u);
    return b;
}
__device__ __forceinline__ void xcd_barrier_complete(unsigned* bar, unsigned x, unsigned& nloc, unsigned& nx) {
    const unsigned G = gridDim.x * gridDim.y * gridDim.z;
    unsigned sum, cnt, mine, sp = 0u;
    for (;;) {
        sum = 0u; cnt = 0u; mine = 0u;
#pragma unroll
        for (unsigned j = 0; j < 16; ++j) { const unsigned c = xb_ld(&bar[XB_XCNT(j)]); sum += c; cnt += (c > 0u) ? 1u : 0u; mine = (j == x) ? c : mine; }
        if (sum == G) break;
        __builtin_amdgcn_s_sleep(1);
        if ((++sp & 255u) == 0u) { if (xb_ld(&bar[XB_TMO])) break; if (sp > XB_SPIN_CAP) { atomicAdd(&bar[XB_TMO], 1u); break; } }
    }
    nloc = mine > 0u ? mine : 1u; nx = cnt > 0u ? cnt : 1u;
}

__device__ __forceinline__ void xcd_barrier(const XcdBarrier& b) {
    asm volatile("s_waitcnt vmcnt(0)" ::: "memory");
    __syncthreads();
    if (threadIdx.x == 0) {
        unsigned* bar = b.bar;
        __builtin_amdgcn_s_waitcnt(0);
        unsigned nloc = b.st[0], nx = b.st[1];
        if (nloc == 0u) { xcd_barrier_complete(bar, b.x, nloc, nx); b.st[0] = nloc; b.st[1] = nx; }
        const unsigned old = xb_add(&bar[XB_XSUB(b.x)], 1u);
        const unsigned gen = old / nloc;
        if (old + 1u == (gen + 1u) * nloc) {
            __builtin_amdgcn_fence(__ATOMIC_RELEASE, "agent");
            asm volatile("s_waitcnt vmcnt(0)" ::: "memory");
            const unsigned og = xb_add(&bar[XB_TOP], 1u);
            const unsigned tg = og / nx;
            if (og + 1u == (tg + 1u) * nx) xb_add(&bar[XB_TOPGEN], 1u);
            else XB_SPIN(xb_ld(&bar[XB_TOPGEN]) == tg, bar);
            __builtin_amdgcn_fence(__ATOMIC_ACQUIRE, "agent");
            xb_add(&bar[XB_XGEN(b.x)], 1u);
            asm volatile("s_waitcnt vmcnt(0)" ::: "memory");
        } else {
            XB_SPIN(xb_ld(&bar[XB_XGEN(b.x)]) == gen, bar);
            __builtin_amdgcn_fence(__ATOMIC_ACQUIRE, "agent");
            asm volatile("s_waitcnt vmcnt(0)" ::: "memory");
        }
    }
    __syncthreads();
}

constexpr int N_PHASES = 16;
__global__ void __launch_bounds__(512, 2) mk_fwd(Params p) {
    extern __shared__ __attribute__((aligned(16))) unsigned char lds_raw[];
    LAS unsigned char* lds = (LAS unsigned char*)lds_raw;
    cg::grid_group grid = cg::this_grid();
#define GSYNC_CG() do { asm volatile("s_waitcnt vmcnt(0) lgkmcnt(0)" ::: "memory"); __syncthreads(); \
        if (threadIdx.x < 64) { __builtin_amdgcn_fence(__ATOMIC_RELEASE, "agent"); asm volatile("s_waitcnt vmcnt(0)" ::: "memory"); } \
        grid.sync(); \
        if (threadIdx.x < 64) { __builtin_amdgcn_fence(__ATOMIC_ACQUIRE, "agent"); asm volatile("s_waitcnt vmcnt(0)" ::: "memory"); } \
        __syncthreads(); } while (0)
    const bool one_launch = (p.ph_hi - p.ph_lo == N_PHASES);
    volatile LAS unsigned* xst = (volatile LAS unsigned*)(lds + LDS_BYTES - 64);
    if (threadIdx.x == 0) { xst[0] = 0u; xst[1] = 0u; }
    __syncthreads();
    XcdBarrier xbar; xbar.bar = (unsigned*)(p.ws + WS_SMALL + SM_XBAR); xbar.x = 0; xbar.st = xst;
    if (one_launch) xbar = xcd_barrier_post((unsigned*)(p.ws + WS_SMALL + SM_XBAR), xst);
    if (one_launch) grid.sync();
#define GSYNC() do { if (one_launch) xcd_barrier(xbar); else GSYNC_CG(); } while (0)
#pragma unroll 1
    for (int ph = p.ph_lo; ph < p.ph_hi; ++ph) {
        if (ph == 0) { phase_mod(p, (float*)(p.ws + WS_SMALL + SM_MODP)); }
        else if (ph == N_PHASES - 1) { if (gridDim.x != 256) final_norm(p); }
        else {
        int l = (ph - 1) / 7, k = (ph - 1) % 7; asm volatile("" : "+s"(l), "+s"(k));
        const float* xin = (l == 0) ? p.x : p.out;
        int G = gridDim.x, bx = blockIdx.x; asm volatile("" : "+s"(G), "+s"(bx));
        size_t wz_ = 0; asm volatile("" : "+s"(wz_)); unsigned char* ws = p.ws + wz_;
        if (k == 0) { phase_prep(p, l, xin, lds, ws); }
        else if (k == 1) {
        {
            pg8::Gemm g{(const bf16_t*)(ws + WS_H), (const bf16_t*)(ws + WS_WIN), NTOK, NPA, DM, DM, DM}; pg8::StaticOrder S; S.init(NTOK, NPA, G, bx);
            EpiProj E{(bf16_t*)(ws + WS_PROJ), NPA, 0}; NoHook HK; f32x4 acc[2][2][4][2];
            pg8::gemm_phase<EpiProj, pg8::StaticOrder, NoHook, true, true>(lds, g, S, E, HK, acc);
        }
        }
        else if (k == 2) { mlstm_m1(p, l, lds, ws); pool_phase(p, l, lds, ws); }
        else if (k == 3) {
            if (G == 256) {
                int tx_ = threadIdx.x; asm volatile("" : "+v"(tx_)); const int idx = bx * 512 + tx_;
                float dcv[64]; scan_load(dcv, ws, idx);
                { const int u0 = xcd_chunk_unit(bx, 0); sb_phase(p, lds, ws, u0, u0 + 1); }
                scan_finish(dcv, l, ws, idx);
                mlstm_scan_n(l, ws);
                { const int u1 = xcd_chunk_unit(bx, 1); sb_phase(p, lds, ws, u1, u1 + 1); }
            } else { mlstm_scan(l, ws); mlstm_scan_n(l, ws); sb_phase(p, lds, ws, bx, 512); }
        }
        else if (k == 4) { mlstm_m3(p, l, lds, ws); }
        else if (k == 5) {
        {
            pg8::StaticOrder S; S.init(NTOK, DM, G, bx); pg8::Unit u; NoHook HK; f32x4 acc[2][2][4][2];
            const bf16_t* Gp = (const bf16_t*)(ws + WS_G); const bf16_t* Yp = (const bf16_t*)(ws + WS_Y); const bf16_t* Wb = (const bf16_t*)(ws + WS_WBR);
            for (int i = 0; S.next(i, u); ++i) {
                { pg8::Gemm g{(const bf16_t*)(ws + WS_H), (const bf16_t*)(ws + WS_WIN) + (size_t)NPA * 1024, NTOK, NG, DM, DM, DM}; GateOrder GO{u.pm, u.pn};
                  EpiProj E{(bf16_t*)(ws + WS_G), NG, 1};
                  pg8::gemm_phase<EpiProj, GateOrder, NoHook, true, true>(lds, g, GO, E, HK, acc); }
                __syncthreads();
                OneUnit OU{u.pm, u.pn}; EpiNone EN;
                { pg8::Gemm g{Yp, Wb, NTOK, DM, 512, DM, DM};
                  pg8::gemm_phase<EpiNone, OneUnit, NoHook, false, true, true>(lds, g, OU, EN, HK, acc); }
                gate_rescale(acc, Gp, p.gate_b + l * NG, u.pm, u.pn, 0); __syncthreads();
                { pg8::Gemm g{Yp + 512, Wb + 512, NTOK, DM, 256, DM, DM};
                  pg8::gemm_phase<EpiNone, OneUnit, NoHook, false, true, false>(lds, g, OU, EN, HK, acc); }
                gate_rescale(acc, Gp, p.gate_b + l * NG, u.pm, u.pn, 1024); __syncthreads();
                { pg8::Gemm g{Yp + 768, Wb + 768, NTOK, DM, 256, DM, DM}; EpiMerge E{(bf16_t*)(ws + WS_MERGED), Gp, p.gate_b + l * NG};
                  pg8::gemm_phase<EpiMerge, OneUnit, NoHook, false, true, false>(lds, g, OU, E, HK, acc); }
                __syncthreads();
            }
        }
        }
        else {
        {
            pg8::Gemm g{(const bf16_t*)(ws + WS_MERGED), (const bf16_t*)(ws + WS_WOUT), NTOK, DM, DM, DM, DM}; pg8::StaticOrder S; S.init(NTOK, DM, G, bx); pg8::Unit u;
            NoHook HK; f32x4 acc[2][2][4][2];
            if (l == 1 && G == 256) {
                EpiOutNorm E{xin, p.out, (const float*)(ws + WS_SMALL + SM_GATEV) + l * 2048, p.final_g, (unsigned long long*)(ws + WS_SMALL + SM_XEX), (unsigned*)(ws + WS_SMALL + SM_XBAR + 16384)};
                for (int i = 0; S.next(i, u); ++i) { OneUnit OU{u.pm, u.pn};
                    pg8::gemm_phase<EpiOutNorm, OneUnit, NoHook, false, true>(lds, g, OU, E, HK, acc); __syncthreads(); }
            } else {
                EpiOut E{xin, p.out, (const float*)(ws + WS_SMALL + SM_GATEV) + l * 2048};
                for (int i = 0; S.next(i, u); ++i) { OneUnit OU{u.pm, u.pn};
                    pg8::gemm_phase<EpiOut, OneUnit, NoHook, false, true>(lds, g, OU, E, HK, acc); __syncthreads(); }
            }
        }
        }
        }
        if (ph + 1 < p.ph_hi && !(gridDim.x == 256 && ph == N_PHASES - 2)) GSYNC();
    }
}

extern "C" void kernel_launch(void* const* d_in, const int* in_sizes, int n_in, void* d_out, int out_size, void* d_ws, size_t ws_size, hipStream_t stream) {
    static int grid_blocks = 0;
    if (grid_blocks == 0) {
        int dev = 0, cus = 0, per_cu = 0;
        if (n_in != 18 || out_size != NTOK * DM || ws_size < WS_SMALL + SM_END) { fprintf(stderr, "kernel_launch: unexpected shapes (n_in %d out %d ws %zu)\n", n_in, out_size, ws_size); grid_blocks = -1; return; }
        hipGetDevice(&dev); hipDeviceGetAttribute(&cus, hipDeviceAttributeMultiprocessorCount, dev);
        if (hipFuncSetAttribute((const void*)mk_fwd, hipFuncAttributeMaxDynamicSharedMemorySize, LDS_BYTES) != hipSuccess) { fprintf(stderr, "kernel_launch: hipFuncSetAttribute failed\n"); }
        if (hipOccupancyMaxActiveBlocksPerMultiprocessor(&per_cu, (const void*)mk_fwd, 512, LDS_BYTES) != hipSuccess || per_cu < 1) { fprintf(stderr, "kernel_launch: occupancy query gave %d\n", per_cu); per_cu = 1; }
        (void)hipGetLastError();
        grid_blocks = cus * per_cu;
    }
    if (grid_blocks < 0) return;
    Params p{};
    const float** f = (const float**)&p;
    for (int i = 0; i < 18; ++i) f[i] = (const float*)d_in[i];
    p.out = (float*)d_out; p.ws = (unsigned char*)d_ws;
#ifndef MK_PHASES_PER_LAUNCH
#define MK_PHASES_PER_LAUNCH N_PHASES
#endif
    (void)hipMemsetAsync((unsigned char*)d_ws + WS_SMALL + SM_XBAR, 0, XBAR_BYTES, stream);
    for (int lo = 0; lo < N_PHASES; lo += MK_PHASES_PER_LAUNCH) {
        p.ph_lo = lo; p.ph_hi = lo + MK_PHASES_PER_LAUNCH < N_PHASES ? lo + MK_PHASES_PER_LAUNCH : N_PHASES;
        void* args[] = {&p};
        hipError_t e = hipLaunchCooperativeKernel((const void*)mk_fwd, dim3(grid_blocks), dim3(512), args, LDS_BYTES, stream);
        if (e != hipSuccess) { fprintf(stderr, "cooperative launch failed: %s (grid %d)\n", hipGetErrorString(e), grid_blocks); break; }
    }
}
```

```cpp
#include <hip/hip_runtime.h>
#include <hip/hip_cooperative_groups.h>
#include <cstdio>
#include <cstdint>
#include <cstddef>
namespace cg = cooperative_groups;
namespace pg8 {
#define PG8_LAS __attribute__((address_space(3)))
typedef unsigned short bf16_t;
typedef short bf16x8 __attribute__((ext_vector_type(8)));
typedef float f32x4 __attribute__((ext_vector_type(4)));
typedef unsigned u32x4 __attribute__((ext_vector_type(4)));
constexpr int BM = 256, BK = 64, HALF = 128, HTB = HALF * BK * 2  , STAGE_BYTES = 8 * HTB, NXCD = 8, WGM = 8;

__host__ __device__ __forceinline__ int lds_byte(int r, int c) { const int st = (r >> 4) * 2 + (c >> 5), rr = r & 15, cc = c & 31, ob = rr * 64 + cc * 2; return st * 1024 + (ob ^ (((ob >> 9) & 1) << 5)); }
__host__ __device__ __forceinline__ void stage_rc(int b, int& R, int& C) { const int st = b / 1024, sb = b % 1024, swz = sb ^ (((sb >> 9) & 1) << 5); R = (st >> 1) * 16 + swz / 64; C = (st & 1) * 32 + (swz % 64) / 2; }
__host__ __device__ __forceinline__ int perm32(int rho) { const int n = rho >> 4, i = rho & 15; return 8 * (i >> 2) + 4 * n + (i & 3); }

struct Unit { int pm, pn; };
struct Gemm { const bf16_t* A; const bf16_t* Bt; int M, N, K, lda, ldb; };

struct StaticOrder {
    int nM, nN, nwg, G, c;
    __host__ __device__ void init(int M, int N, int G_, int c_) { nM = M / BM; nN = N / BM; nwg = nM * nN; G = G_; c = c_; }
    __host__ __device__ bool next(int i, Unit& u) const {
        const long L = (long)i * G + c; if (L >= nwg) return false;
        int wgid = (int)L; { const int q = nwg / NXCD, r = nwg % NXCD, xcd = wgid % NXCD, off = wgid / NXCD; wgid = (xcd < r ? xcd * (q + 1) : r * (q + 1) + (xcd - r) * q) + off; }
        const int nig = WGM * nN, gid = wgid / nig, fm = gid * WGM, gsz = (nM - fm) < WGM ? (nM - fm) : WGM;
        u.pm = fm + ((wgid % nig) % gsz); u.pn = (wgid % nig) / gsz; return true;
    }
    __device__ __forceinline__ void a_ready(const Unit&) const {}
    __device__ __forceinline__ void done(const Unit&) const {}
};

__device__ __forceinline__ unsigned cvt_pk_bf16(float lo, float hi) { unsigned r; asm volatile("v_cvt_pk_bf16_f32 %0, %1, %2" : "=v"(r) : "v"(lo), "v"(hi)); return r; }
template <class Epi, class Sched, class Hook, bool ALIGN_EPI = false, bool SP2 = false, bool ZERO_ACC = true>
__device__ __forceinline__ void gemm_phase(PG8_LAS unsigned char* lds, const Gemm g, const Sched& S, const Epi& E, const Hook& HK, f32x4 (&acc)[2][2][4][2]) {
    int tid_ = threadIdx.x; asm volatile("" : "+v"(tid_));
    const int tid = tid_, wid = __builtin_amdgcn_readfirstlane(tid >> 6), lane = tid & 63, wr = wid >> 2, wc = wid & 3, fr = lane & 15, fq = lane >> 4;
    const int K = g.K, nt = K / BK;
    unsigned voffA[2], voffB[2];
#pragma unroll
    for (int i = 0; i < 2; ++i) { int R, C; stage_rc(tid * 16 + i * 8192, R, C); const int Rb = Epi::PERM ? ((R & ~31) + perm32(R & 31)) : R;
        voffA[i] = (unsigned)(R * g.lda + C) * 2u; voffB[i] = (unsigned)(Rb * g.ldb + C) * 2u; }
    const size_t kstep = (size_t)(BK * 2);
    const size_t hstepA = (size_t)HALF * g.lda * 2, hstepB = (size_t)HALF * g.ldb * 2;
    const size_t tstepA = 2 * hstepA, tstepB = 2 * hstepB;
    const unsigned ldsw = (unsigned)wid * 1024u;
    const int aoff = lds_byte(wr * 64 + fr, fq * 8), boff = lds_byte(wc * 32 + fr, fq * 8);
#define PG8_SA(b, h) (((b) * 2 + (h)) * HTB)
#define PG8_SB(b, h) ((4 + (b) * 2 + (h)) * HTB)
#define PG8_STAGE(bufoff, gbase, voff) do { _Pragma("unroll") for (int _i = 0; _i < 2; ++_i) \
        __builtin_amdgcn_global_load_lds((const unsigned*)((const char*)(gbase) + (voff)[_i]), (PG8_LAS unsigned*)(lds + (bufoff) + ldsw + _i * 8192), 16, 0, 0); } while (0)
#define PG8_LDA(dst, b, h) do { _Pragma("unroll") for (int m = 0; m < 4; ++m) _Pragma("unroll") for (int k = 0; k < 2; ++k) dst[m][k] = *(const PG8_LAS bf16x8*)(lds + PG8_SA(b, h) + aoff + m * 2048 + k * 1024); } while (0)
#define PG8_LDB(dst, b, h) do { _Pragma("unroll") for (int n = 0; n < 2; ++n) _Pragma("unroll") for (int k = 0; k < 2; ++k) dst[n][k] = *(const PG8_LAS bf16x8*)(lds + PG8_SB(b, h) + boff + n * 2048 + k * 1024); } while (0)
#define PG8_MMA(ai, bj, At, Bt) do { __builtin_amdgcn_s_setprio(1); _Pragma("unroll") for (int m = 0; m < 4; ++m) _Pragma("unroll") for (int n = 0; n < 2; ++n) _Pragma("unroll") for (int k = 0; k < 2; ++k) \
        acc[ai][bj][m][n] = __builtin_amdgcn_mfma_f32_16x16x32_bf16(Bt[n][k], At[m][k], acc[ai][bj][m][n], 0, 0, 0); __builtin_amdgcn_s_setprio(0); } while (0)
#define PG8_WAIT_V(n) asm volatile("s_waitcnt vmcnt(" #n ")" ::: "memory")
#define PG8_WAIT_L(n) asm volatile("s_waitcnt lgkmcnt(" #n ")" ::: "memory")
#define PG8_BAR __builtin_amdgcn_s_barrier()
#define PG8_SCHED __builtin_amdgcn_sched_barrier(0)
    Unit cur, nxt; int ui = 0;
    if (!S.next(0, cur)) return;
    if constexpr (ZERO_ACC) {
#pragma unroll
    for (int a = 0; a < 2; ++a)
#pragma unroll
        for (int b = 0; b < 2; ++b)
#pragma unroll
            for (int m = 0; m < 4; ++m)
#pragma unroll
                for (int n = 0; n < 2; ++n) acc[a][b][m][n] = (f32x4){0.f, 0.f, 0.f, 0.f};
    }
    bf16x8 At[4][2], B0[2][2], B1[2][2];
    const char* cA = (const char*)g.A + (size_t)cur.pm * tstepA; const char* cB = (const char*)g.Bt + (size_t)cur.pn * tstepB;
    S.a_ready(cur);
    if constexpr (SP2) {
        PG8_STAGE(PG8_SB(0, 0), cB, voffB); PG8_STAGE(PG8_SB(0, 1), cB + hstepB, voffB); PG8_STAGE(PG8_SA(0, 0), cA, voffA); PG8_STAGE(PG8_SA(0, 1), cA + hstepA, voffA);
        if (wr == 1) PG8_BAR;
        PG8_WAIT_V(2); PG8_BAR;
        PG8_STAGE(PG8_SB(1, 0), cB + kstep, voffB); PG8_STAGE(PG8_SA(1, 0), cA + kstep, voffA); PG8_STAGE(PG8_SB(1, 1), cB + hstepB + kstep, voffB);
        PG8_WAIT_V(6); PG8_BAR;
    } else {
        PG8_STAGE(PG8_SB(0, 0), cB, voffB); PG8_STAGE(PG8_SA(0, 0), cA, voffA); PG8_STAGE(PG8_SB(0, 1), cB + hstepB, voffB); PG8_STAGE(PG8_SA(0, 1), cA + hstepA, voffA);
        if (wr == 1) PG8_BAR;
        PG8_WAIT_V(4); PG8_BAR;
        PG8_STAGE(PG8_SB(1, 0), cB + kstep, voffB); PG8_STAGE(PG8_SA(1, 0), cA + kstep, voffA); PG8_STAGE(PG8_SB(1, 1), cB + hstepB + kstep, voffB);
        PG8_WAIT_V(6); PG8_BAR;
    }
    for (;;) {
        const bool has_next = S.next(ui + 1, nxt);
        const char* nA = has_next ? (const char*)g.A + (size_t)nxt.pm * tstepA : cA; const char* nB = has_next ? (const char*)g.Bt + (size_t)nxt.pn * tstepB : cB;
#pragma nounroll
        for (int t = 0; t < nt; t += 2) {
            const bool last = (t == nt - 2);
            if constexpr (Hook::ON) { if (t == Hook::T1 || t == Hook::T2) HK(acc, cur, t, wr, wc, fr, fq); }
            const char* a1 = cA + (size_t)(t + 1) * kstep;
            const char* a2 = last ? nA : cA + (size_t)(t + 2) * kstep; const char* b2 = last ? nB : cB + (size_t)(t + 2) * kstep;
            const char* a3 = a2 + kstep; const char* b3 = b2 + kstep;
            if (last && has_next) S.a_ready(nxt);
            if constexpr (SP2) {
            PG8_LDB(B0, 0, 0); PG8_LDB(B1, 0, 1); PG8_SCHED; PG8_LDA(At, 0, 0); PG8_STAGE(PG8_SA(1, 1), a1 + hstepA, voffA);
            PG8_WAIT_V(8); PG8_WAIT_L(0); PG8_BAR; PG8_MMA(0, 0, At, B0); PG8_MMA(0, 1, At, B1); PG8_BAR; PG8_SCHED;
            PG8_LDA(At, 0, 1); PG8_STAGE(PG8_SB(0, 0), b2, voffB); PG8_STAGE(PG8_SB(0, 1), b2 + hstepB, voffB); PG8_STAGE(PG8_SA(0, 0), a2, voffA);
            PG8_WAIT_V(8); PG8_WAIT_L(0); PG8_BAR; PG8_MMA(1, 0, At, B0); PG8_MMA(1, 1, At, B1); PG8_BAR; PG8_SCHED;
            PG8_LDB(B0, 1, 0); PG8_LDB(B1, 1, 1); PG8_SCHED; PG8_LDA(At, 1, 0); PG8_STAGE(PG8_SA(0, 1), a2 + hstepA, voffA);
            PG8_WAIT_V(8); PG8_WAIT_L(0); PG8_BAR; PG8_MMA(0, 0, At, B0); PG8_MMA(0, 1, At, B1); PG8_BAR; PG8_SCHED;
            PG8_LDA(At, 1, 1); PG8_STAGE(PG8_SB(1, 0), b3, voffB); PG8_STAGE(PG8_SB(1, 1), b3 + hstepB, voffB); PG8_STAGE(PG8_SA(1, 0), a3, voffA);
            PG8_WAIT_V(8); PG8_WAIT_L(0); PG8_BAR; PG8_MMA(1, 0, At, B0); PG8_MMA(1, 1, At, B1); PG8_BAR; PG8_SCHED;
            } else {
            PG8_LDB(B0, 0, 0); PG8_SCHED; PG8_LDA(At, 0, 0); PG8_STAGE(PG8_SA(1, 1), a1 + hstepA, voffA);
            PG8_WAIT_L(8); PG8_BAR; PG8_WAIT_L(0); PG8_MMA(0, 0, At, B0); PG8_BAR; PG8_SCHED;
            PG8_LDB(B1, 0, 1); PG8_STAGE(PG8_SB(0, 0), b2, voffB);
            PG8_BAR; PG8_WAIT_L(0); PG8_MMA(0, 1, At, B1); PG8_BAR;
            PG8_LDA(At, 0, 1); PG8_STAGE(PG8_SA(0, 0), a2, voffA);
            PG8_BAR; PG8_WAIT_L(0); PG8_MMA(1, 0, At, B0); PG8_BAR; PG8_SCHED;
            PG8_STAGE(PG8_SB(0, 1), b2 + hstepB, voffB);
            PG8_WAIT_V(6); PG8_BAR; PG8_MMA(1, 1, At, B1); PG8_BAR;
            PG8_LDB(B0, 1, 0); PG8_SCHED; PG8_LDA(At, 1, 0); PG8_STAGE(PG8_SA(0, 1), a2 + hstepA, voffA);
            PG8_WAIT_L(8); PG8_BAR; PG8_WAIT_L(0); PG8_MMA(0, 0, At, B0); PG8_BAR; PG8_SCHED;
            PG8_LDB(B1, 1, 1); PG8_STAGE(PG8_SB(1, 0), b3, voffB);
            PG8_BAR; PG8_WAIT_L(0); PG8_MMA(0, 1, At, B1); PG8_BAR;
            PG8_LDA(At, 1, 1); PG8_STAGE(PG8_SA(1, 0), a3, voffA);
            PG8_BAR; PG8_WAIT_L(0); PG8_MMA(1, 0, At, B0); PG8_BAR; PG8_SCHED;
            PG8_STAGE(PG8_SB(1, 1), b3 + hstepB, voffB);
            PG8_WAIT_V(6); PG8_BAR; PG8_MMA(1, 1, At, B1); PG8_BAR;
            }
        }
        if constexpr (ALIGN_EPI) { if (wr == 0) PG8_BAR; }
        if constexpr (!Epi::AFTER_DRAIN) { E(acc, cur, wr, wc, fr, fq); S.done(cur); }
        if (!has_next) break;
#pragma unroll
        for (int a = 0; a < 2; ++a)
#pragma unroll
            for (int b = 0; b < 2; ++b)
#pragma unroll
                for (int m = 0; m < 4; ++m)
#pragma unroll
                    for (int n = 0; n < 2; ++n) acc[a][b][m][n] = (f32x4){0.f, 0.f, 0.f, 0.f};
        cur = nxt; cA = nA; cB = nB; ++ui;
        if constexpr (ALIGN_EPI) { if (wr == 1) PG8_BAR; }
    }
    PG8_WAIT_V(0);
    if constexpr (!ALIGN_EPI) { if (wr == 0) PG8_BAR; }
    PG8_BAR;
    if constexpr (Epi::AFTER_DRAIN) { E.fused(acc, cur, wr, wc, fr, fq, lds, wid, lane); S.done(cur); }
#undef PG8_SA
#undef PG8_SB
#undef PG8_STAGE
#undef PG8_LDA
#undef PG8_LDB
#undef PG8_MMA
#undef PG8_WAIT_V
#undef PG8_WAIT_L
#undef PG8_BAR
#undef PG8_SCHED
}
}
#define LAS __attribute__((address_space(3)))
typedef unsigned short bf16_t;
typedef short bf16x8 __attribute__((ext_vector_type(8)));
typedef float f32x4 __attribute__((ext_vector_type(4)));
typedef unsigned u32x4 __attribute__((ext_vector_type(4)));
typedef unsigned u32x2 __attribute__((ext_vector_type(2)));
using pg8::cvt_pk_bf16;

constexpr int NTOK = 16384, DM = 1024, SEQ = 8192, NIN = 7176;
constexpr int NPA = 4096;
constexpr int NG = 3072;
constexpr float EPSF = 1e-6f;
constexpr int C_MQ = 0, C_MK = 512, C_MV = 1024, C_MO = 1536, C_MZ = 2048, C_PU = 2560, C_PZ = 2816, C_SQ = 3072, C_SK = 3328, C_SV = 3584, C_SZ = 3840;
constexpr size_t MiB = 1u << 20;
constexpr size_t WS_WIN = 0, WS_WBR = 14 * MiB, WS_WOUT = 16 * MiB, WS_H = 18 * MiB, WS_Y = 50 * MiB, WS_PROJ = 82 * MiB, WS_G = 82 * MiB, WS_MERGED = 178 * MiB,
                 WS_DC = 210 * MiB, WS_SMALL = 242 * MiB;
constexpr size_t SM_MODP = 0;
constexpr size_t SM_GATEV = SM_MODP + 2 * 16 * 2 * 3072 * 4;
constexpr size_t SM_IF = SM_GATEV + 2 * 2 * 1024 * 4;
constexpr size_t SM_DN = SM_IF + 2 * (size_t)NTOK * 8 * 4;
constexpr size_t SM_BEND = SM_DN + 2 * 512 * 128 * 4;
constexpr size_t SM_AMAX = SM_BEND + 4;
constexpr size_t SM_MPREV = SM_BEND + 2 * 512 * 128;
constexpr size_t SM_CPB = (SM_MPREV + 2 * 512 * 4 + 255) & ~(size_t)255;
constexpr size_t SM_XBAR = SM_CPB + (size_t)256 * 32768;
constexpr size_t XBAR_BYTES = 32768;
constexpr size_t SM_XEX = SM_XBAR + XBAR_BYTES;
constexpr size_t SM_END = SM_XEX + (size_t)NTOK * 4 * 8;
static_assert(WS_SMALL + SM_END <= 256 * MiB, "workspace map");
__device__ __forceinline__ bf16_t* cprev_slot(unsigned char* ws, int u) { return (bf16_t*)(u < 256 ? ws + WS_WIN + (size_t)u * 32768 : ws + WS_SMALL + SM_CPB + (size_t)(u - 256) * 32768); }
constexpr int LDS_BYTES = 147456;

struct Params {
    const float *x, *c, *norm_g, *w_ada, *b_ada, *w_in, *m_gate_b, *conv_w, *conv_b, *m_norm_g, *pool_w, *pool_scale, *w_br_m, *w_br_p, *w_br_s, *gate_b, *w_out, *final_g;
    float* out; unsigned char* ws; int ph_lo, ph_hi;
};

__device__ __forceinline__ float bf2f(unsigned short h) { return __uint_as_float(((unsigned)h) << 16); }
__device__ __forceinline__ float bflo(unsigned w) { return __uint_as_float(w << 16); }
__device__ __forceinline__ float bfhi(unsigned w) { return __uint_as_float(w & 0xffff0000u); }
__device__ __forceinline__ unsigned short f2bf(float f) { return (unsigned short)(cvt_pk_bf16(f, 0.f) & 0xffffu); }
__device__ __forceinline__ float fsigmoid(float x) { return __builtin_amdgcn_rcpf(1.f + __expf(-x)); }
__device__ __forceinline__ float fsilu(float x) { return x * fsigmoid(x); }
__device__ __forceinline__ float logsig(float x) { return fminf(x, 0.f) - log1pf(__expf(-fabsf(x))); }
__device__ __forceinline__ float wave_sum(float v) {
#pragma unroll
    for (int m = 32; m >= 1; m >>= 1) v += __shfl_xor(v, m);
    return v;
}
__device__ __forceinline__ f32x4 mfma16(bf16x8 a, bf16x8 b, f32x4 c) { return __builtin_amdgcn_mfma_f32_16x16x32_bf16(a, b, c, 0, 0, 0); }
__device__ __forceinline__ bf16x8 ldfrag(const LAS unsigned char* p) { return *(const LAS bf16x8*)p; }
__device__ __forceinline__ bf16x8 ldfrag2(const LAS unsigned char* pa, const LAS unsigned char* pb) {
    const u32x2 a = *(const LAS u32x2*)pa, b = *(const LAS u32x2*)pb; const u32x4 c = {a.x, a.y, b.x, b.y}; return __builtin_bit_cast(bf16x8, c);
}

#ifndef MK_WT
#define MK_WT 0
#endif
#if MK_WT
__device__ __forceinline__ void st16(void* p, u32x4 v) { asm volatile("global_store_dwordx4 %0, %1, off sc0 sc1\n\ts_nop 1" :: "v"(p), "v"(v) : "memory"); }
__device__ __forceinline__ void st16f(void* p, f32x4 v) { asm volatile("global_store_dwordx4 %0, %1, off sc0 sc1\n\ts_nop 1" :: "v"(p), "v"(v) : "memory"); }
__device__ __forceinline__ void st8(void* p, u32x2 v) { asm volatile("global_store_dwordx2 %0, %1, off sc0 sc1\n\ts_nop 1" :: "v"(p), "v"(v) : "memory"); }
__device__ __forceinline__ void st4(void* p, unsigned v) { asm volatile("global_store_dword %0, %1, off sc0 sc1\n\ts_nop 1" :: "v"(p), "v"(v) : "memory"); }
__device__ __forceinline__ void st4f(void* p, float v) { asm volatile("global_store_dword %0, %1, off sc0 sc1\n\ts_nop 1" :: "v"(p), "v"(v) : "memory"); }
#else
__device__ __forceinline__ void st16(void* p, u32x4 v) { *(u32x4*)p = v; }
__device__ __forceinline__ void st16f(void* p, f32x4 v) { *(f32x4*)p = v; }
__device__ __forceinline__ void st8(void* p, u32x2 v) { *(u32x2*)p = v; }
__device__ __forceinline__ void st4(void* p, unsigned v) { *(unsigned*)p = v; }
__device__ __forceinline__ void st4f(void* p, float v) { *(float*)p = v; }
#endif

struct NoHook { static constexpr bool ON = false; static constexpr int T1 = -1, T2 = -1;
    __device__ __forceinline__ void operator()(f32x4 (&)[2][2][4][2], const pg8::Unit&, int, int, int, int, int) const {} };

struct EpiProj {
    static constexpr bool PERM = true, AFTER_DRAIN = false;
    bf16_t* O; int pitch; int raw;
    __device__ __forceinline__ void operator()(const f32x4 (&acc)[2][2][4][2], const pg8::Unit& u, int wr, int wc, int fr, int fq) const {
        const int pn = u.pn; const int act = raw ? 0 : ((pn == 6 || pn == 7) ? 1 : ((pn == 8 || pn == 9 || pn == 11 || pn == 15) ? 2 : (pn == 12 ? 3 : 0)));
        const int row0 = u.pm * 256 + wr * 64 + fr, col0 = pn * 256 + wc * 32 + 8 * fq;
#pragma unroll
        for (int ai = 0; ai < 2; ++ai)
#pragma unroll
            for (int m = 0; m < 4; ++m) { bf16_t* rowp = O + (size_t)(row0 + ai * 128 + m * 16) * pitch + col0;
#pragma unroll
                for (int bj = 0; bj < 2; ++bj) { float v[8];
#pragma unroll
                    for (int e = 0; e < 4; ++e) { v[e] = acc[ai][bj][m][0][e]; v[4 + e] = acc[ai][bj][m][1][e]; }
                    if (act == 1) {
#pragma unroll
                        for (int e = 0; e < 8; ++e) v[e] = fsigmoid(v[e]);
                    } else if (act == 2) {
#pragma unroll
                        for (int e = 0; e < 8; ++e) v[e] = fsilu(v[e]);
                    } else if (act == 3) {
#pragma unroll
                        for (int e = 0; e < 8; ++e) v[e] *= 0.18033688011112042f;
                    }
                    u32x4 w; w.x = cvt_pk_bf16(v[0], v[1]); w.y = cvt_pk_bf16(v[2], v[3]); w.z = cvt_pk_bf16(v[4], v[5]); w.w = cvt_pk_bf16(v[6], v[7]);
                    st16(rowp + bj * 128, w); } }
    }
};

__device__ __forceinline__ void gate_rescale(f32x4 (&acc)[2][2][4][2], const bf16_t* G, const float* gbias, int pm, int pn, int goff) {
    int tx_ = threadIdx.x; asm volatile("" : "+v"(tx_)); const int wid = tx_ >> 6, lane = tx_ & 63, wr = wid >> 2, wc = wid & 3, fr = lane & 15, fq = lane >> 4;
    const int row0 = pm * 256 + wr * 64 + fr, col0 = pn * 256 + wc * 32 + 8 * fq;
    __builtin_amdgcn_sched_barrier(0);
#pragma unroll
    for (int bj = 0; bj < 2; ++bj) {
        const f32x4 ba0 = *(const f32x4*)(gbias + goff + col0 + bj * 128), ba1 = *(const f32x4*)(gbias + goff + col0 + bj * 128 + 4);
        const f32x4 bb0 = *(const f32x4*)(gbias + goff + 1024 + col0 + bj * 128), bb1 = *(const f32x4*)(gbias + goff + 1024 + col0 + bj * 128 + 4);
#pragma unroll
        for (int ai = 0; ai < 2; ++ai)
#pragma unroll
            for (int m = 0; m < 4; ++m) { const bf16_t* rowp = G + (size_t)(row0 + ai * 128 + m * 16) * NG + goff + col0 + bj * 128;
                const u32x4 a = *(const u32x4*)rowp, b = *(const u32x4*)(rowp + 1024);
                const unsigned aw[4] = {a.x, a.y, a.z, a.w}, bw[4] = {b.x, b.y, b.z, b.w};
                f32x4 r0, r1;
#pragma unroll
                for (int e = 0; e < 2; ++e) {
                    r0[2 * e]     = (1.f + __expf(-(bflo(bw[e]) + bb0[2 * e])))         * __builtin_amdgcn_rcpf(1.f + __expf(-(bflo(aw[e]) + ba0[2 * e])));
                    r0[2 * e + 1] = (1.f + __expf(-(bfhi(bw[e]) + bb0[2 * e + 1])))     * __builtin_amdgcn_rcpf(1.f + __expf(-(bfhi(aw[e]) + ba0[2 * e + 1])));
                    r1[2 * e]     = (1.f + __expf(-(bflo(bw[2 + e]) + bb1[2 * e])))     * __builtin_amdgcn_rcpf(1.f + __expf(-(bflo(aw[2 + e]) + ba1[2 * e])));
                    r1[2 * e + 1] = (1.f + __expf(-(bfhi(bw[2 + e]) + bb1[2 * e + 1]))) * __builtin_amdgcn_rcpf(1.f + __expf(-(bfhi(aw[2 + e]) + ba1[2 * e + 1]))); }
                acc[ai][bj][m][0] *= r0; acc[ai][bj][m][1] *= r1;
                asm volatile("" : "+v"(acc[ai][bj][m][0]), "+v"(acc[ai][bj][m][1]) :: "memory");
                __builtin_amdgcn_sched_barrier(0); }
    }
    asm volatile("s_waitcnt vmcnt(0)" ::: "memory"); __builtin_amdgcn_sched_barrier(0);
}
struct EpiNone { static constexpr bool PERM = true, AFTER_DRAIN = true;
    __device__ __forceinline__ void fused(const f32x4 (&)[2][2][4][2], const pg8::Unit&, int, int, int, int, LAS unsigned char*, int, int) const {} };
struct EpiMerge {
    static constexpr bool PERM = true, AFTER_DRAIN = true;
    bf16_t* O; const bf16_t* G; const float* gbias;
    __device__ __forceinline__ void fused(const f32x4 (&acc)[2][2][4][2], const pg8::Unit& u, int wr, int wc, int fr, int fq, LAS unsigned char*, int, int) const {
        const int row0 = u.pm * 256 + wr * 64 + fr, col0 = u.pn * 256 + wc * 32 + 8 * fq;
#pragma unroll
        for (int ai = 0; ai < 2; ++ai)
#pragma unroll
            for (int m = 0; m < 4; ++m) { const size_t row = (size_t)(row0 + ai * 128 + m * 16);
#pragma unroll
                for (int bj = 0; bj < 2; ++bj) { const u32x4 g = *(const u32x4*)(G + row * NG + 2048 + col0 + bj * 128);
                    const f32x4 b0 = *(const f32x4*)(gbias + 2048 + col0 + bj * 128), b1 = *(const f32x4*)(gbias + 2048 + col0 + bj * 128 + 4);
                    const f32x4 a0 = acc[ai][bj][m][0], a1 = acc[ai][bj][m][1];
                    u32x4 w; w.x = cvt_pk_bf16(a0[0] * fsigmoid(bflo(g.x) + b0[0]), a0[1] * fsigmoid(bfhi(g.x) + b0[1])); w.y = cvt_pk_bf16(a0[2] * fsigmoid(bflo(g.y) + b0[2]), a0[3] * fsigmoid(bfhi(g.y) + b0[3]));
                    w.z = cvt_pk_bf16(a1[0] * fsigmoid(bflo(g.z) + b1[0]), a1[1] * fsigmoid(bfhi(g.z) + b1[1])); w.w = cvt_pk_bf16(a1[2] * fsigmoid(bflo(g.w) + b1[2]), a1[3] * fsigmoid(bfhi(g.w) + b1[3]));
                    st16(O + row * DM + col0 + bj * 128, w); } }
    }
};
struct EpiOut {
    static constexpr bool PERM = true, AFTER_DRAIN = true;
    const float* xin; float* xout; const float* gate;
    __device__ __forceinline__ void fused(const f32x4 (&acc)[2][2][4][2], const pg8::Unit& u, int wr, int wc, int fr, int fq, LAS unsigned char*, int, int) const {
        const int row0 = u.pm * 256 + wr * 64 + fr, col0 = u.pn * 256 + wc * 32 + 8 * fq; const float* gb = gate + ((u.pm * 256) / SEQ) * 1024;
#pragma unroll
        for (int bj = 0; bj < 2; ++bj) {
            const f32x4 g0 = *(const f32x4*)(gb + col0 + bj * 128), g1 = *(const f32x4*)(gb + col0 + bj * 128 + 4);
#pragma unroll
            for (int ai = 0; ai < 2; ++ai)
#pragma unroll
                for (int m = 0; m < 4; ++m) { const size_t off = (size_t)(row0 + ai * 128 + m * 16) * DM + col0 + bj * 128;
                    const f32x4 x0 = *(const f32x4*)(xin + off), x1 = *(const f32x4*)(xin + off + 4);
                    st16f(xout + off, x0 + g0 * acc[ai][bj][m][0]); st16f(xout + off + 4, x1 + g1 * acc[ai][bj][m][1]); }
        }
    }
};
struct EpiOutNorm {
    static constexpr bool PERM = true, AFTER_DRAIN = true;
    const float* xin; float* out; const float* gate; const float* fg; unsigned long long* xbuf; unsigned* cnt;
    __device__ __forceinline__ void fused(f32x4 (&acc)[2][2][4][2], const pg8::Unit& u, int wr, int wc, int fr, int fq, LAS unsigned char* lds, int wid, int lane) const {
        const int row0 = u.pm * 256 + wr * 64 + fr, col0 = u.pn * 256 + wc * 32 + 8 * fq; const float* gb = gate + ((u.pm * 256) / SEQ) * 1024;
        LAS float* P = (LAS float*)lds; LAS float* S = (LAS float*)(lds + 8192);
#pragma unroll
        for (int bj = 0; bj < 2; ++bj) {
            const f32x4 g0 = *(const f32x4*)(gb + col0 + bj * 128), g1 = *(const f32x4*)(gb + col0 + bj * 128 + 4);
#pragma unroll
            for (int ai = 0; ai < 2; ++ai)
#pragma unroll
                for (int m = 0; m < 4; ++m) { const size_t off = (size_t)(row0 + ai * 128 + m * 16) * DM + col0 + bj * 128;
                    acc[ai][bj][m][0] = *(const f32x4*)(xin + off) + g0 * acc[ai][bj][m][0]; acc[ai][bj][m][1] = *(const f32x4*)(xin + off + 4) + g1 * acc[ai][bj][m][1];
                    asm volatile("" : "+v"(acc[ai][bj][m][0]), "+v"(acc[ai][bj][m][1]) :: "memory"); }
        }
#pragma unroll
        for (int ai = 0; ai < 2; ++ai)
#pragma unroll
            for (int m = 0; m < 4; ++m) { float sq = 0.f;
#pragma unroll
                for (int bj = 0; bj < 2; ++bj)
#pragma unroll
                    for (int n = 0; n < 2; ++n) { const f32x4 v = acc[ai][bj][m][n]; sq += (v[0] * v[0] + v[1] * v[1]) + (v[2] * v[2] + v[3] * v[3]); }
                sq += __shfl_xor(sq, 16); sq += __shfl_xor(sq, 32);
                if (fq == 0) P[(ai * 128 + wr * 64 + m * 16 + fr) * 4 + wc] = sq; }
        __syncthreads();
        const int row = wid * 32 + (lane & 31);
        if (lane < 32) { const float t = (P[row * 4 + 0] + P[row * 4 + 1]) + (P[row * 4 + 2] + P[row * 4 + 3]);
            __hip_atomic_store(xbuf + ((size_t)(u.pm * 256 + row) * 4 + u.pn), (unsigned long long)__float_as_uint(t), __ATOMIC_RELAXED, __HIP_MEMORY_SCOPE_AGENT); }
        asm volatile("s_waitcnt vmcnt(0)" ::: "memory");
        if (lane == 0) __hip_atomic_fetch_add(cnt + 64 * u.pm, 1u, __ATOMIC_RELAXED, __HIP_MEMORY_SCOPE_AGENT);
        if (wid == 0) {
            for (unsigned spins = 0; spins < (1u << 22); ++spins) { if ((unsigned)__builtin_amdgcn_readfirstlane(__hip_atomic_load(cnt + 64 * u.pm, __ATOMIC_RELAXED, __HIP_MEMORY_SCOPE_AGENT)) >= 32u) break; __builtin_amdgcn_s_sleep(2); }
            __builtin_amdgcn_fence(__ATOMIC_ACQUIRE, "agent");
        }
        asm volatile("s_waitcnt vmcnt(0) lgkmcnt(0)" ::: "memory");
        __syncthreads();
        if (lane < 32) { const unsigned long long* slot = xbuf + (size_t)(u.pm * 256 + row) * 4; float t = 0.f;
#pragma unroll
            for (int q = 0; q < 4; ++q) t += __uint_as_float((unsigned)__hip_atomic_load(slot + q, __ATOMIC_RELAXED, __HIP_MEMORY_SCOPE_AGENT));
            S[row] = rsqrtf(t * (1.f / 1024.f) + EPSF); }
        __syncthreads();
#pragma unroll
        for (int bj = 0; bj < 2; ++bj) {
            const f32x4 f0 = *(const f32x4*)(fg + col0 + bj * 128), f1 = *(const f32x4*)(fg + col0 + bj * 128 + 4);
#pragma unroll
            for (int ai = 0; ai < 2; ++ai)
#pragma unroll
                for (int m = 0; m < 4; ++m) { const size_t off = (size_t)(row0 + ai * 128 + m * 16) * DM + col0 + bj * 128; const float r = S[ai * 128 + wr * 64 + m * 16 + fr];
                    *(f32x4*)(out + off) = acc[ai][bj][m][0] * r * f0; *(f32x4*)(out + off + 4) = acc[ai][bj][m][1] * r * f1; }
        }
    }
};
struct GateOrder { int pm, pn;
    __device__ __forceinline__ bool next(int i, pg8::Unit& u) const { if (i >= 3) return false; u.pm = pm; u.pn = pn + 4 * i; return true; }
    __device__ __forceinline__ void a_ready(const pg8::Unit&) const {}
    __device__ __forceinline__ void done(const pg8::Unit&) const {} };
struct OneUnit { int pm, pn;
    __device__ __forceinline__ bool next(int i, pg8::Unit& u) const { if (i >= 1) return false; u.pm = pm; u.pn = pn; return true; }
    __device__ __forceinline__ void a_ready(const pg8::Unit&) const {}
    __device__ __forceinline__ void done(const pg8::Unit&) const {} };

__device__ __forceinline__ void phase_mod(const Params& p, float* MODP) {
    for (int u = blockIdx.x; u < 192; u += gridDim.x) {
        const int l = u / 96, r = u % 96, ks = r / 6, jb = r % 6; int tx_ = threadIdx.x; asm volatile("" : "+v"(tx_)); const int j = jb * 512 + tx_;
        const float* w = p.w_ada + ((size_t)l * 1024 + ks * 64) * 3072 + j; const float* c0 = p.c + ks * 64; const float* c1 = p.c + 1024 + ks * 64;
        float a0 = 0.f, a1 = 0.f; float wv[64];
#pragma unroll
        for (int k = 0; k < 64; ++k) wv[k] = w[(size_t)k * 3072];
#pragma unroll
        for (int k = 0; k < 64; ++k) { a0 += c0[k] * wv[k]; a1 += c1[k] * wv[k]; }
        st4f(MODP + ((l * 16 + ks) * 2 + 0) * 3072 + j, a0); st4f(MODP + ((l * 16 + ks) * 2 + 1) * 3072 + j, a1);
    }
}

struct TItem { const float* src; int ld; bf16_t* dst; };
__device__ __forceinline__ TItem transpose_item(const Params& p, int l, int it, bf16_t* WinT, bf16_t* WbrT, bf16_t* WoutT) {
    TItem t;
    if (it < 1792) { const int nt = it >> 4, kt = it & 15, n0 = nt * 64, c0 = n0 < 1536 ? n0 : n0 + 8;
        t.src = p.w_in + (size_t)l * 1024 * NIN + (size_t)kt * 64 * NIN + c0; t.ld = NIN; t.dst = WinT + (size_t)n0 * 1024 + kt * 64;
    } else if (it < 2048) { const int j = it - 1792, nt = j >> 4, kt = j & 15, k0 = kt * 64;
        const float* src = k0 < 512 ? p.w_br_m + (size_t)l * 512 * 1024 + (size_t)k0 * 1024 : (k0 < 768 ? p.w_br_p + (size_t)l * 256 * 1024 + (size_t)(k0 - 512) * 1024 : p.w_br_s + (size_t)l * 256 * 1024 + (size_t)(k0 - 768) * 1024);
        t.src = src + nt * 64; t.ld = 1024; t.dst = WbrT + (size_t)nt * 64 * 1024 + k0;
    } else { const int j = it - 2048, nt = j >> 4, kt = j & 15;
        t.src = p.w_out + (size_t)l * 1024 * 1024 + (size_t)kt * 64 * 1024 + nt * 64; t.ld = 1024; t.dst = WoutT + (size_t)nt * 64 * 1024 + kt * 64; }
    return t;
}
__device__ __forceinline__ void phase_prep(const Params& p, int l, const float* xin, LAS unsigned char* lds, unsigned char* ws_in) {
    size_t wz_ = 0; asm volatile("" : "+s"(wz_)); unsigned char* ws = ws_in + wz_;
    int tid_ = threadIdx.x; asm volatile("" : "+v"(tid_)); const int tid = tid_, lane = tid & 63, wid = tid >> 6;
    bf16_t* WinT = (bf16_t*)(ws + WS_WIN); bf16_t* WbrT = (bf16_t*)(ws + WS_WBR); bf16_t* WoutT = (bf16_t*)(ws + WS_WOUT);
    LAS float* tl = (LAS float*)lds;
    { float tv[8]; int it = blockIdx.x;
      if (it < 2304) { const TItem t0 = transpose_item(p, l, it, WinT, WbrT, WoutT);
#pragma unroll
          for (int i = 0; i < 8; ++i) tv[i] = t0.src[(size_t)(i * 8 + (tid >> 6)) * t0.ld + (tid & 63)]; }
      for (; it < 2304; it += gridDim.x) {
          const TItem t = transpose_item(p, l, it, WinT, WbrT, WoutT);
#pragma unroll
          for (int i = 0; i < 8; ++i) tl[(i * 8 + (tid >> 6)) * 65 + (tid & 63)] = tv[i];
          __syncthreads();
          if (it + (int)gridDim.x < 2304) { const TItem tn = transpose_item(p, l, it + gridDim.x, WinT, WbrT, WoutT);
#pragma unroll
              for (int i = 0; i < 8; ++i) tv[i] = tn.src[(size_t)(i * 8 + (tid >> 6)) * tn.ld + (tid & 63)]; }
#pragma unroll
          for (int i = 0; i < 4; ++i) { const int nn = i * 16 + (tid >> 5), kk = (tid & 31) * 2; st4(t.dst + (size_t)nn * 1024 + kk, cvt_pk_bf16(tl[kk * 65 + nn], tl[(kk + 1) * 65 + nn])); }
          __syncthreads();
      } }
    const float* MODP = (const float*)(ws + WS_SMALL + SM_MODP) + (size_t)l * 16 * 2 * 3072;
    float* GATEV = (float*)(ws + WS_SMALL + SM_GATEV) + l * 2048; float* IFG = (float*)(ws + WS_SMALL + SM_IF + (size_t)l * NTOK * 32);
    bf16_t* H = (bf16_t*)(ws + WS_H);
    LAS float* A = (LAS float*)(lds + 16896); LAS float* Sh = A + 1024; LAS float* Wif = Sh + 1024;
    for (int rb = blockIdx.x; rb < 256; rb += gridDim.x) {
        const int b = (rb * 64) / SEQ;
        __syncthreads();
#pragma unroll
        for (int q = 0; q < 2; ++q) { const int k = tid + q * 512; float sh = p.b_ada[l * 3072 + k], sc = p.b_ada[l * 3072 + 1024 + k];
            for (int ks = 0; ks < 16; ++ks) { sh += MODP[(ks * 2 + b) * 3072 + k]; sc += MODP[(ks * 2 + b) * 3072 + 1024 + k]; }
            A[k] = p.norm_g[l * 1024 + k] * (1.f + sc); Sh[k] = sh; }
        if (rb < 4) { const int e = rb * 512 + tid, bb = e >> 10, j = e & 1023; float g = p.b_ada[l * 3072 + 2048 + j];
            for (int ks = 0; ks < 16; ++ks) g += MODP[(ks * 2 + bb) * 3072 + 2048 + j];
            st4f(GATEV + bb * 1024 + j, g); }
#pragma unroll
        for (int q = 0; q < 16; ++q) { const int e = tid + q * 512, k = e >> 3, g = e & 7; Wif[g * 1024 + k] = p.w_in[(size_t)l * 1024 * NIN + (size_t)k * NIN + 1536 + g]; }
        __syncthreads();
        f32x4 xn[4];
        { const float* xr0 = xin + (size_t)(rb * 64 + wid * 8) * DM;
#pragma unroll
          for (int j = 0; j < 4; ++j) xn[j] = *(const f32x4*)(xr0 + (j >> 1) * 512 + lane * 8 + (j & 1) * 4); }
        for (int i = 0; i < 8; ++i) {
            const int row = rb * 64 + wid * 8 + i;
            f32x4 xv[4]; float ss = 0.f;
#pragma unroll
            for (int j = 0; j < 4; ++j) { xv[j] = xn[j]; ss += xv[j][0] * xv[j][0] + xv[j][1] * xv[j][1] + xv[j][2] * xv[j][2] + xv[j][3] * xv[j][3]; }
            if (i < 7) { const float* xr1 = xin + (size_t)(row + 1) * DM;
#pragma unroll
                for (int j = 0; j < 4; ++j) xn[j] = *(const f32x4*)(xr1 + (j >> 1) * 512 + lane * 8 + (j & 1) * 4); }
            ss = wave_sum(ss); const float rstd = rsqrtf(ss * (1.f / 1024.f) + EPSF);
            float gp[8];
#pragma unroll
            for (int g = 0; g < 8; ++g) gp[g] = 0.f;
            f32x4 hv[4];
#pragma unroll
            for (int j = 0; j < 4; ++j) { const int k = (j >> 1) * 512 + lane * 8 + (j & 1) * 4; const f32x4 a = *(const LAS f32x4*)(A + k), sft = *(const LAS f32x4*)(Sh + k);
                hv[j] = xv[j] * rstd * a + sft;
#pragma unroll
                for (int g = 0; g < 8; ++g) { const f32x4 wv = *(const LAS f32x4*)(Wif + g * 1024 + k); gp[g] += hv[j][0] * wv[0] + hv[j][1] * wv[1] + hv[j][2] * wv[2] + hv[j][3] * wv[3]; } }
#pragma unroll
            for (int j = 0; j < 2; ++j) { u32x4 w; w.x = cvt_pk_bf16(hv[2 * j][0], hv[2 * j][1]); w.y = cvt_pk_bf16(hv[2 * j][2], hv[2 * j][3]); w.z = cvt_pk_bf16(hv[2 * j + 1][0], hv[2 * j + 1][1]); w.w = cvt_pk_bf16(hv[2 * j + 1][2], hv[2 * j + 1][3]);
                st16(H + (size_t)row * DM + j * 512 + lane * 8, w); }
#pragma unroll
            for (int g = 0; g < 8; ++g) gp[g] = wave_sum(gp[g]);
            float outv = gp[0];
#pragma unroll
            for (int g = 1; g < 8; ++g) outv = (lane == g) ? gp[g] : outv;
            if (lane < 8) st4f(IFG + (size_t)row * 8 + lane, outv + p.m_gate_b[l * 8 + lane]);
        }
    }
    __syncthreads();
}

constexpr int LP = 136;
constexpr int OFF_Q = 0, OFF_K = 34816, OFF_V = 69632, OFF_C = 104448, OFF_AR = 139264;
template <int MODE> __device__ __forceinline__ void mlstm_gates(const float* IFG, int tok0, int hd, float mprev, LAS float* ar, int tid) {
    if (tid < 64) { const int l = tid;
        const float i0 = IFG[(size_t)(tok0 + 2 * l) * 8 + hd], i1 = IFG[(size_t)(tok0 + 2 * l + 1) * 8 + hd];
        const float f0 = logsig(IFG[(size_t)(tok0 + 2 * l) * 8 + 4 + hd]), f1 = logsig(IFG[(size_t)(tok0 + 2 * l + 1) * 8 + 4 + hd]);
        float sc = f0 + f1;
#pragma unroll
        for (int d = 1; d < 64; d <<= 1) { const float t = __shfl_up(sc, d); if (l >= d) sc += t; }
        const float c1 = sc, c0 = sc - f1;
        ar[2 * l] = i0; ar[2 * l + 1] = i1; ar[128 + 2 * l] = c0; ar[128 + 2 * l + 1] = c1;
        if (MODE == 1) { const float bend = __shfl(c1, 63); const float a0 = bend - c0 + i0, a1 = bend - c1 + i1; float am = fmaxf(a0, a1);
#pragma unroll
            for (int m = 32; m >= 1; m >>= 1) am = fmaxf(am, __shfl_xor(am, m));
            ar[3 * 128 + 2 * l] = __expf(a0 - am); ar[3 * 128 + 2 * l + 1] = __expf(a1 - am);
            if (l == 0) { ar[7 * 128] = bend; ar[7 * 128 + 1] = am; } }
        if (MODE == 3) { const float g0 = i0 - c0, g1 = i1 - c1; float pm = fmaxf(g0, g1);
#pragma unroll
            for (int d = 1; d < 64; d <<= 1) { const float t = __shfl_up(pm, d); if (l >= d) pm = fmaxf(pm, t); }
            float pprev = __shfl_up(pm, 1); if (l == 0) pprev = -3.0e38f;
            const float pm0 = fmaxf(pprev, g0), pm1 = pm;
            const float mt0 = c0 + fmaxf(mprev, pm0), mt1 = c1 + fmaxf(mprev, pm1);
            ar[2 * 128 + 2 * l] = g0; ar[2 * 128 + 2 * l + 1] = g1;
            ar[3 * 128 + 2 * l] = __expf(c0 + mprev - mt0); ar[3 * 128 + 2 * l + 1] = __expf(c1 + mprev - mt1);
            ar[4 * 128 + 2 * l] = c0 - mt0; ar[4 * 128 + 2 * l + 1] = c1 - mt1;
            ar[5 * 128 + 2 * l] = __expf(-mt0); ar[5 * 128 + 2 * l + 1] = __expf(-mt1); }
    }
}
template <bool TR> __device__ __forceinline__ void stage_conv(const bf16_t* PROJ, int colbase, const float* cw, const float* cb, int ch0, int tok0, int pos0, float scale, LAS bf16_t* dst, int tid) {
    const int d0 = (tid & 15) * 8, s0 = (tid >> 4) * 4;
    float x[7][8];
    const bf16_t* src = PROJ + (size_t)tok0 * NPA + colbase + d0;
#pragma unroll
    for (int r = 0; r < 7; ++r) { const int sr = s0 - 3 + r; u32x4 v = {0u, 0u, 0u, 0u}; if (pos0 + sr >= 0) v = *(const u32x4*)(src + (ptrdiff_t)sr * NPA);
        x[r][0] = bflo(v.x); x[r][1] = bfhi(v.x); x[r][2] = bflo(v.y); x[r][3] = bfhi(v.y); x[r][4] = bflo(v.z); x[r][5] = bfhi(v.z); x[r][6] = bflo(v.w); x[r][7] = bfhi(v.w); }
    float o[4][8];
    { const f32x4 b0 = *(const f32x4*)(cb + ch0 + d0), b1 = *(const f32x4*)(cb + ch0 + d0 + 4);
#pragma unroll
      for (int i = 0; i < 4; ++i) { o[i][0] = b0[0]; o[i][1] = b0[1]; o[i][2] = b0[2]; o[i][3] = b0[3]; o[i][4] = b1[0]; o[i][5] = b1[1]; o[i][6] = b1[2]; o[i][7] = b1[3]; } }
#pragma unroll
    for (int j = 0; j < 4; ++j) { const f32x4 w0 = *(const f32x4*)(cw + j * 1024 + ch0 + d0), w1 = *(const f32x4*)(cw + j * 1024 + ch0 + d0 + 4);
#pragma unroll
        for (int i = 0; i < 4; ++i) { o[i][0] += w0[0] * x[i + j][0]; o[i][1] += w0[1] * x[i + j][1]; o[i][2] += w0[2] * x[i + j][2]; o[i][3] += w0[3] * x[i + j][3];
                                      o[i][4] += w1[0] * x[i + j][4]; o[i][5] += w1[1] * x[i + j][5]; o[i][6] += w1[2] * x[i + j][6]; o[i][7] += w1[3] * x[i + j][7]; } }
#pragma unroll
    for (int i = 0; i < 4; ++i)
#pragma unroll
        for (int c = 0; c < 8; ++c) o[i][c] = fsilu(o[i][c]) * scale;
    if (TR) {
#pragma unroll
        for (int c = 0; c < 8; ++c) { u32x2 w; w.x = cvt_pk_bf16(o[0][c], o[1][c]); w.y = cvt_pk_bf16(o[2][c], o[3][c]); *(LAS u32x2*)(dst + (d0 + c) * LP + s0) = w; }
    } else {
#pragma unroll
        for (int i = 0; i < 4; ++i) { u32x4 w; w.x = cvt_pk_bf16(o[i][0], o[i][1]); w.y = cvt_pk_bf16(o[i][2], o[i][3]); w.z = cvt_pk_bf16(o[i][4], o[i][5]); w.w = cvt_pk_bf16(o[i][6], o[i][7]); *(LAS u32x4*)(dst + (s0 + i) * LP + d0) = w; }
    }
}
template <bool SCALE> __device__ __forceinline__ void stage_vt(const bf16_t* PROJ, int tok0, int hd, const LAS float* wa, LAS bf16_t* dst, int tid) {
#pragma unroll
    for (int q = 0; q < 4; ++q) { const int s = tid & 127, d0 = ((tid >> 7) + 4 * q) * 8;
        const u32x4 v = *(const u32x4*)(PROJ + (size_t)(tok0 + s) * NPA + C_MV + hd * 128 + d0); const float sc = SCALE ? wa[s] : 1.f;
        const unsigned wv[4] = {v.x, v.y, v.z, v.w};
#pragma unroll
        for (int e = 0; e < 4; ++e) { const float lo = bflo(wv[e]) * sc, hi = bfhi(wv[e]) * sc;
            dst[(d0 + 2 * e) * LP + s] = SCALE ? f2bf(lo) : (bf16_t)(wv[e] & 0xffffu); dst[(d0 + 2 * e + 1) * LP + s] = SCALE ? f2bf(hi) : (bf16_t)(wv[e] >> 16); } }
}

__device__ __forceinline__ void mlstm_m1(const Params& p, int l, LAS unsigned char* lds, unsigned char* ws_in) {
    size_t wz_ = 0; asm volatile("" : "+s"(wz_)); unsigned char* ws = ws_in + wz_;
    int tid_ = threadIdx.x; asm volatile("" : "+v"(tid_)); const int tid = tid_, lane = tid & 63, wid = tid >> 6, fr = lane & 15, fq = lane >> 4;
    const bf16_t* PROJ = (const bf16_t*)(ws + WS_PROJ); const float* IFG = (const float*)(ws + WS_SMALL + SM_IF + (size_t)l * NTOK * 32);
    float* DC = (float*)(ws + WS_DC); float* DN = (float*)(ws + WS_SMALL + SM_DN + (size_t)l * 262144); float* BEND = (float*)(ws + WS_SMALL + SM_BEND + (size_t)l * 65536); float* AMAX = (float*)(ws + WS_SMALL + SM_AMAX + (size_t)l * 65536);
    LAS float* ar = (LAS float*)(lds + OFF_AR); LAS bf16_t* Vt = (LAS bf16_t*)(lds + OFF_V); LAS bf16_t* Kt = (LAS bf16_t*)(lds + OFF_K);
    for (int u = blockIdx.x; u < 512; u += gridDim.x) {
        const int b = u >> 8, hd = (u >> 6) & 3, c = u & 63, tok0 = b * SEQ + c * 128, pos0 = c * 128;
        __syncthreads();
        mlstm_gates<1>(IFG, tok0, hd, 0.f, ar, tid);
        __syncthreads();
        const float bend = ar[7 * 128], amax = ar[7 * 128 + 1];
        stage_vt<true>(PROJ, tok0, hd, ar + 3 * 128, Vt, tid);
        stage_conv<true>(PROJ, C_MK + hd * 128, p.conv_w + (size_t)l * 4096, p.conv_b + l * 1024, 512 + hd * 128, tok0, pos0, 0.08838834764831845f, Kt, tid);
        __syncthreads();
        f32x4 acc[8];
#pragma unroll
        for (int j = 0; j < 8; ++j) acc[j] = (f32x4){0.f, 0.f, 0.f, 0.f};
#pragma unroll
        for (int ks = 0; ks < 4; ++ks) { const bf16x8 a = ldfrag((const LAS unsigned char*)(Vt + (16 * wid + fr) * LP + ks * 32 + fq * 8));
#pragma unroll
            for (int j = 0; j < 8; ++j) acc[j] = mfma16(ldfrag((const LAS unsigned char*)(Kt + (16 * j + fr) * LP + ks * 32 + fq * 8)), a, acc[j]); }
        bf16_t* dcu = (bf16_t*)(DC + (size_t)u * 16384);
#pragma unroll
        for (int j = 0; j < 8; ++j) { u32x2 w; w.x = cvt_pk_bf16(acc[j][0], acc[j][1]); w.y = cvt_pk_bf16(acc[j][2], acc[j][3]); st8(dcu + (16 * wid + fr) * 128 + 16 * j + 4 * fq, w); }
        if (tid < 128) { float sn = 0.f;
#pragma unroll 4
            for (int jj = 0; jj < 16; ++jj) { const u32x4 kv = *(const LAS u32x4*)(Kt + tid * LP + jj * 8); const f32x4 w0 = *(const LAS f32x4*)(ar + 3 * 128 + jj * 8), w1 = *(const LAS f32x4*)(ar + 3 * 128 + jj * 8 + 4);
                sn += w0[0] * bflo(kv.x) + w0[1] * bfhi(kv.x) + w0[2] * bflo(kv.y) + w0[3] * bfhi(kv.y) + w1[0] * bflo(kv.z) + w1[1] * bfhi(kv.z) + w1[2] * bflo(kv.w) + w1[3] * bfhi(kv.w); }
            st4f(DN + u * 128 + tid, sn); }
        if (tid == 0) { st4f(BEND + u * 32, bend); st4f(AMAX + u * 32, amax); }
    }
    __syncthreads();
}

__device__ __forceinline__ void scan_load(float (&dcv)[64], unsigned char* ws, int idx) {
    const int bh = idx >> 14, e = idx & 16383; const bf16_t* base = (const bf16_t*)(ws + WS_DC) + (size_t)bh * 64 * 32768 + e;
#pragma unroll
    for (int c = 0; c < 64; ++c) dcv[c] = bf2f(base[(size_t)c * 32768]);
}
__device__ __forceinline__ void scan_finish(const float (&dcv)[64], int l, unsigned char* ws, int idx) {
    const float* BEND = (const float*)(ws + WS_SMALL + SM_BEND + (size_t)l * 65536); const float* AMAX = (const float*)(ws + WS_SMALL + SM_AMAX + (size_t)l * 65536);
    float* MPREV = (float*)(ws + WS_SMALL + SM_MPREV + (size_t)l * 2048);
    const int bh = idx >> 14, e = idx & 16383;
    float m = 0.f, cst = 0.f;
#pragma unroll
    for (int c = 0; c < 64; ++c) { const float be = BEND[(bh * 64 + c) * 32], am = AMAX[(bh * 64 + c) * 32]; const float mn = fmaxf(be + m, am), dec = __expf(be + m - mn), inw = __expf(am - mn);
        cprev_slot(ws, bh * 64 + c)[e] = f2bf(cst); cst = dec * cst + inw * dcv[c]; if (e == 0) st4f(MPREV + bh * 64 + c, m); m = mn; }
}
__device__ __forceinline__ void mlstm_scan(int l, unsigned char* ws_in) {
    size_t wz_ = 0; asm volatile("" : "+s"(wz_)); unsigned char* ws = ws_in + wz_;
    int tx_ = threadIdx.x; asm volatile("" : "+v"(tx_));
    for (int idx = blockIdx.x * 512 + tx_; idx < 8 * 16384; idx += gridDim.x * 512) { float dcv[64]; scan_load(dcv, ws, idx); scan_finish(dcv, l, ws, idx); }
}
__device__ __forceinline__ void mlstm_scan_n(int l, unsigned char* ws_in) {
    size_t wz_ = 0; asm volatile("" : "+s"(wz_)); unsigned char* ws = ws_in + wz_;
    float* DN = (float*)(ws + WS_SMALL + SM_DN + (size_t)l * 262144); const float* BEND = (const float*)(ws + WS_SMALL + SM_BEND + (size_t)l * 65536); const float* AMAX = (const float*)(ws + WS_SMALL + SM_AMAX + (size_t)l * 65536);
    int tx_ = threadIdx.x; asm volatile("" : "+v"(tx_));
    for (int idx = (tx_ < 64 && gridDim.x >= 16) ? (int)blockIdx.x * 64 + tx_ : (gridDim.x >= 16 ? 8 * 128 : (int)blockIdx.x * 512 + tx_); idx < 8 * 128; idx += (gridDim.x >= 16 ? 8 * 128 : gridDim.x * 512)) {
        const int bh = idx >> 7, e = idx & 127;
        float* base = DN + (size_t)bh * 64 * 128 + e;
        float dcv[64];
#pragma unroll
        for (int c = 0; c < 64; ++c) dcv[c] = base[c * 128];
        float m = 0.f, cst = 0.f;
#pragma unroll
        for (int c = 0; c < 64; ++c) { const float be = BEND[(bh * 64 + c) * 32], am = AMAX[(bh * 64 + c) * 32]; const float mn = fmaxf(be + m, am), dec = __expf(be + m - mn), inw = __expf(am - mn);
            st4f(base + c * 128, cst); cst = dec * cst + inw * dcv[c]; m = mn; }
    }
}

__device__ __forceinline__ void mlstm_m3(const Params& p, int l, LAS unsigned char* lds, unsigned char* ws_in) {
    size_t wz_ = 0; asm volatile("" : "+s"(wz_)); unsigned char* ws = ws_in + wz_;
    int tid_ = threadIdx.x; asm volatile("" : "+v"(tid_)); const int tid = tid_, lane = tid & 63, wid = tid >> 6, fr = lane & 15, fq = lane >> 4;
    const bf16_t* PROJ = (const bf16_t*)(ws + WS_PROJ); const float* IFG = (const float*)(ws + WS_SMALL + SM_IF + (size_t)l * NTOK * 32);
    const float* DC = (const float*)(ws + WS_DC); const float* DN = (const float*)(ws + WS_SMALL + SM_DN + (size_t)l * 262144); const float* MPREV = (const float*)(ws + WS_SMALL + SM_MPREV + (size_t)l * 2048);
    bf16_t* Y = (bf16_t*)(ws + WS_Y);
    LAS float* ar = (LAS float*)(lds + OFF_AR);
    LAS bf16_t* Qc = (LAS bf16_t*)(lds + OFF_Q); LAS bf16_t* Kc = (LAS bf16_t*)(lds + OFF_K); LAS bf16_t* Vt = (LAS bf16_t*)(lds + OFF_V); LAS bf16_t* Cp = (LAS bf16_t*)(lds + OFF_C);
    for (int u = blockIdx.x; u < 512; u += gridDim.x) {
        const int b = u >> 8, hd = (u >> 6) & 3, c = u & 63, tok0 = b * SEQ + c * 128, pos0 = c * 128;
        __syncthreads();
        const float mprev = MPREV[u];
        mlstm_gates<3>(IFG, tok0, hd, mprev, ar, tid);
        if (tid >= 64 && tid < 192) ar[6 * 128 + tid - 64] = DN[u * 128 + tid - 64];
        stage_conv<false>(PROJ, C_MQ + hd * 128, p.conv_w + (size_t)l * 4096, p.conv_b + l * 1024, hd * 128, tok0, pos0, 1.f, Qc, tid);
        stage_conv<false>(PROJ, C_MK + hd * 128, p.conv_w + (size_t)l * 4096, p.conv_b + l * 1024, 512 + hd * 128, tok0, pos0, 0.08838834764831845f, Kc, tid);
        stage_vt<false>(PROJ, tok0, hd, nullptr, Vt, tid);
        { const bf16_t* cpu = cprev_slot(ws, u);
#pragma unroll
          for (int q = 0; q < 4; ++q) { const int e = (q * 512 + tid) * 8, v = e >> 7, k = e & 127; *(LAS u32x4*)(Cp + v * LP + k) = *(const u32x4*)(cpu + e); } }
        __syncthreads();
        const int tl = 16 * wid + fr;
        bf16x8 qf[4];
#pragma unroll
        for (int ks = 0; ks < 4; ++ks) qf[ks] = ldfrag((const LAS unsigned char*)(Qc + tl * LP + ks * 32 + fq * 8));
        f32x4 acc[8];
#pragma unroll
        for (int vi = 0; vi < 8; ++vi) { acc[vi] = (f32x4){0.f, 0.f, 0.f, 0.f};
#pragma unroll
            for (int ks = 0; ks < 4; ++ks) acc[vi] = mfma16(ldfrag((const LAS unsigned char*)(Cp + (16 * vi + fr) * LP + ks * 32 + fq * 8)), qf[ks], acc[vi]); }
        float deni = 0.f;
#pragma unroll
        for (int kk = 0; kk < 4; ++kk) { const u32x4 qv = *(const LAS u32x4*)(Qc + tl * LP + fq * 32 + kk * 8); const f32x4 n0 = *(const LAS f32x4*)(ar + 6 * 128 + fq * 32 + kk * 8), n1 = *(const LAS f32x4*)(ar + 6 * 128 + fq * 32 + kk * 8 + 4);
            deni += n0[0] * bflo(qv.x) + n0[1] * bfhi(qv.x) + n0[2] * bflo(qv.y) + n0[3] * bfhi(qv.y) + n1[0] * bflo(qv.z) + n1[1] * bfhi(qv.z) + n1[2] * bflo(qv.w) + n1[3] * bfhi(qv.w); }
        deni += __shfl_xor(deni, 16); deni += __shfl_xor(deni, 32);
        const float wi = ar[3 * 128 + tl], et = ar[4 * 128 + tl], emt = ar[5 * 128 + tl];
#pragma unroll
        for (int vi = 0; vi < 8; ++vi) acc[vi] *= wi;
        float den = 0.f;
        for (int sp = 0; sp <= (wid >> 1); ++sp) {
            float pv[8];
#pragma unroll
            for (int h2 = 0; h2 < 2; ++h2) { const int tile = 2 * sp + h2; f32x4 sa = (f32x4){0.f, 0.f, 0.f, 0.f};
#pragma unroll
                for (int ks = 0; ks < 4; ++ks) sa = mfma16(ldfrag((const LAS unsigned char*)(Kc + (16 * tile + fr) * LP + ks * 32 + fq * 8)), qf[ks], sa);
                const f32x4 gk = *(const LAS f32x4*)(ar + 2 * 128 + 16 * tile + 4 * fq);
#pragma unroll
                for (int r = 0; r < 4; ++r) { const int sl = 16 * tile + 4 * fq + r; const float wgt = (sl <= tl) ? __expf(et + gk[r]) : 0.f; const float pp = wgt * sa[r]; den += pp; pv[h2 * 4 + r] = pp; } }
            u32x4 pw; pw.x = cvt_pk_bf16(pv[0], pv[1]); pw.y = cvt_pk_bf16(pv[2], pv[3]); pw.z = cvt_pk_bf16(pv[4], pv[5]); pw.w = cvt_pk_bf16(pv[6], pv[7]);
            const bf16x8 pf = __builtin_bit_cast(bf16x8, pw);
#pragma unroll
            for (int vi = 0; vi < 8; ++vi) { const LAS unsigned char* vr = (const LAS unsigned char*)(Vt + (16 * vi + fr) * LP + 32 * sp + 4 * fq);
                acc[vi] = mfma16(ldfrag2(vr, vr + 32), pf, acc[vi]); }
        }
        den += __shfl_xor(den, 16); den += __shfl_xor(den, 32);
        const float dtot = wi * deni + den; const float hinv = 1.f / fmaxf(fabsf(dtot), emt);
        const size_t tokr = (size_t)(tok0 + tl);
        float ssq = 0.f;
#pragma unroll
        for (int vi = 0; vi < 8; ++vi) { const u32x2 o = *(const u32x2*)(PROJ + tokr * NPA + C_MO + hd * 128 + 16 * vi + 4 * fq);
            acc[vi][0] *= hinv * bflo(o.x); acc[vi][1] *= hinv * bfhi(o.x); acc[vi][2] *= hinv * bflo(o.y); acc[vi][3] *= hinv * bfhi(o.y);
            ssq += acc[vi][0] * acc[vi][0] + acc[vi][1] * acc[vi][1] + acc[vi][2] * acc[vi][2] + acc[vi][3] * acc[vi][3]; }
        ssq += __shfl_xor(ssq, 16); ssq += __shfl_xor(ssq, 32);
        const float rinv = rsqrtf(ssq * (1.f / 128.f) + EPSF);
#pragma unroll
        for (int vi = 0; vi < 8; ++vi) { const int vc = hd * 128 + 16 * vi + 4 * fq; const u32x2 z = *(const u32x2*)(PROJ + tokr * NPA + C_MZ + vc); const f32x4 g = *(const f32x4*)(p.m_norm_g + l * 512 + vc);
            u32x2 w; w.x = cvt_pk_bf16(acc[vi][0] * rinv * g[0] * bflo(z.x), acc[vi][1] * rinv * g[1] * bfhi(z.x)); w.y = cvt_pk_bf16(acc[vi][2] * rinv * g[2] * bflo(z.y), acc[vi][3] * rinv * g[3] * bfhi(z.y));
            st8(Y + tokr * DM + vc, w); }
    }
    __syncthreads();
}

__device__ __forceinline__ void pool_phase(const Params& p, int l, LAS unsigned char* lds, unsigned char* ws_in) {
    size_t wz_ = 0; asm volatile("" : "+s"(wz_)); unsigned char* ws = ws_in + wz_;
    int tid_ = threadIdx.x; asm volatile("" : "+v"(tid_)); const int tid = tid_; const bf16_t* PROJ = (const bf16_t*)(ws + WS_PROJ); bf16_t* Y = (bf16_t*)(ws + WS_Y);
    LAS float* U = (LAS float*)lds; LAS float* Wp = (LAS float*)(lds + 20480); LAS float* Pm = (LAS float*)(lds + 36864);
    for (int pu = blockIdx.x; pu < 1024; pu += gridDim.x) {
        const int tt = pu >> 2, g = pu & 3, tok0 = tt * 64, b = tok0 / SEQ, p0 = tok0 % SEQ, W = 2 << g;
        __syncthreads();
        for (int ch = tid; ch < 79 * 8; ch += 512) { const int row = ch >> 3, cc = (ch & 7) * 8, pos = p0 - 15 + row;
            u32x4 v = {0u, 0u, 0u, 0u}; if (pos >= 0) v = *(const u32x4*)(PROJ + (size_t)(b * SEQ + pos) * NPA + C_PU + g * 64 + cc);
            *(LAS f32x4*)(U + row * 64 + cc) = (f32x4){bflo(v.x), bfhi(v.x), bflo(v.y), bfhi(v.y)}; *(LAS f32x4*)(U + row * 64 + cc + 4) = (f32x4){bflo(v.z), bfhi(v.z), bflo(v.w), bfhi(v.w)}; }
#pragma unroll
        for (int q = 0; q < 8; ++q) Wp[q * 512 + tid] = p.pool_w[(size_t)l * 16384 + g * 4096 + q * 512 + tid];
        __syncthreads();
        const int t = tid >> 3, c0 = (tid & 7) * 8; const int cnt = min(W, p0 + t + 1); const float rc = 1.f / (float)cnt;
        { f32x4 s0 = (f32x4){0.f, 0.f, 0.f, 0.f}, s1 = s0;
          for (int j = 0; j < W; ++j) { s0 += *(const LAS f32x4*)(U + (15 + t - j) * 64 + c0); s1 += *(const LAS f32x4*)(U + (15 + t - j) * 64 + c0 + 4); }
          const f32x4 u0 = *(const LAS f32x4*)(U + (15 + t) * 64 + c0), u1 = *(const LAS f32x4*)(U + (15 + t) * 64 + c0 + 4);
#pragma unroll
          for (int e = 0; e < 4; ++e) { Pm[t * 65 + c0 + e] = s0[e] * rc - u0[e]; Pm[t * 65 + c0 + 4 + e] = s1[e] * rc - u1[e]; } }
        __syncthreads();
        float o[8];
#pragma unroll
        for (int e = 0; e < 8; ++e) o[e] = 0.f;
        for (int cc = 0; cc < 64; ++cc) { const float pv = Pm[t * 65 + cc]; const f32x4 w0 = *(const LAS f32x4*)(Wp + cc * 64 + c0), w1 = *(const LAS f32x4*)(Wp + cc * 64 + c0 + 4);
#pragma unroll
            for (int e = 0; e < 4; ++e) { o[e] += pv * w0[e]; o[4 + e] += pv * w1[e]; } }
        const size_t tok = (size_t)(tok0 + t); const u32x4 z = *(const u32x4*)(PROJ + tok * NPA + C_PZ + g * 64 + c0);
        const f32x4 s0 = *(const f32x4*)(p.pool_scale + l * 256 + g * 64 + c0), s1 = *(const f32x4*)(p.pool_scale + l * 256 + g * 64 + c0 + 4);
        u32x4 w; w.x = cvt_pk_bf16(o[0] * s0[0] * bflo(z.x), o[1] * s0[1] * bfhi(z.x)); w.y = cvt_pk_bf16(o[2] * s0[2] * bflo(z.y), o[3] * s0[3] * bfhi(z.y));
        w.z = cvt_pk_bf16(o[4] * s1[0] * bflo(z.z), o[5] * s1[1] * bfhi(z.z)); w.w = cvt_pk_bf16(o[6] * s1[2] * bflo(z.w), o[7] * s1[3] * bfhi(z.w));
        st16(Y + tok * DM + 512 + g * 64 + c0, w);
    }
    __syncthreads();
}

constexpr float SB_DEAD = -104.f * 1.4426950408889634f;
template <bool DIAG> __device__ __forceinline__ f32x4 sb_tile(const f32x4 z, int sbase, int tq, int fq, float& L) {
    float lf[4], ls[4];
#pragma unroll
    for (int r = 0; r < 4; ++r) { const float zz = z[r], l1p = __builtin_amdgcn_logf(1.f + __builtin_amdgcn_exp2f(-fabsf(zz)));
        const float lfv = -(fmaxf(zz, 0.f) + l1p), lsv = fminf(zz, 0.f) - l1p;
        if (DIAG) { const bool valid = (sbase + r) < tq; lf[r] = valid ? lfv : 0.f; ls[r] = valid ? lsv : -1.0e30f; } else { lf[r] = lfv; ls[r] = lsv; } }
    const float suf2 = lf[3], suf1 = suf2 + lf[2], suf0 = suf1 + lf[1], T = suf0 + lf[0];
    const float T16 = __shfl_down(T, 16), T32 = __shfl_down(T, 32), T48 = __shfl_down(T, 48);
    const float E = (fq < 3 ? T16 : 0.f) + (fq < 2 ? T32 : 0.f) + (fq < 1 ? T48 : 0.f);
    float Tt = T + __shfl_xor(T, 16); Tt += __shfl_xor(Tt, 32);
    const float base = L + E;
    f32x4 pv; pv[0] = __builtin_amdgcn_exp2f(ls[0] + base + suf0); pv[1] = __builtin_amdgcn_exp2f(ls[1] + base + suf1); pv[2] = __builtin_amdgcn_exp2f(ls[2] + base + suf2); pv[3] = __builtin_amdgcn_exp2f(ls[3] + base);
    L += Tt; return pv;
}
__device__ __forceinline__ void sb_phase(const Params& p, LAS unsigned char* lds, unsigned char* ws_in, int u_first, int u_end) {
    size_t wz_ = 0; asm volatile("" : "+s"(wz_)); unsigned char* ws = ws_in + wz_;
    int tid_ = threadIdx.x; asm volatile("" : "+v"(tid_)); const int tid = tid_, lane = tid & 63, wid = tid >> 6, fr = lane & 15, fq = lane >> 4;
    const bf16_t* PROJ = (const bf16_t*)(ws + WS_PROJ); bf16_t* Y = (bf16_t*)(ws + WS_Y);
    LAS bf16_t* Ks = (LAS bf16_t*)lds; LAS bf16_t* Vt = (LAS bf16_t*)(lds + 18432); LAS int* flags = (LAS int*)(lds + 36864);
    for (int u = u_first; u < u_end; u += gridDim.x) {
        const int b = u >> 8, hd = (u >> 6) & 3, qb = u & 63;
        const int tq = qb * 128 + 16 * wid + fr; const size_t tokq = (size_t)(b * SEQ + tq);
        bf16x8 qf[2];
#pragma unroll
        for (int ks = 0; ks < 2; ++ks) qf[ks] = *(const bf16x8*)(PROJ + tokq * NPA + C_SQ + hd * 64 + ks * 32 + fq * 8);
        f32x4 acc[4];
#pragma unroll
        for (int i = 0; i < 4; ++i) acc[i] = (f32x4){0.f, 0.f, 0.f, 0.f};
        float Lrun = 0.f;
        u32x4 kreg[2], vreg[2];
#pragma unroll
        for (int q = 0; q < 2; ++q) { const int row = tid & 127, d0 = ((tid >> 7) + 4 * q) * 8; const size_t tk = (size_t)(b * SEQ + qb * 128 + row);
            kreg[q] = *(const u32x4*)(PROJ + tk * NPA + C_SK + hd * 64 + d0); vreg[q] = *(const u32x4*)(PROJ + tk * NPA + C_SV + hd * 64 + d0); }
        for (int kb = qb; kb >= 0; --kb) {
            __syncthreads();
#pragma unroll
            for (int q = 0; q < 2; ++q) { const int row = tid & 127, d0 = ((tid >> 7) + 4 * q) * 8;
                *(LAS u32x4*)(Ks + row * 72 + d0) = kreg[q];
                const unsigned wv[4] = {vreg[q].x, vreg[q].y, vreg[q].z, vreg[q].w};
#pragma unroll
                for (int e = 0; e < 4; ++e) { Vt[(d0 + 2 * e) * LP + row] = (bf16_t)(wv[e] & 0xffffu); Vt[(d0 + 2 * e + 1) * LP + row] = (bf16_t)(wv[e] >> 16); } }
            if (kb > 0) {
#pragma unroll
                for (int q = 0; q < 2; ++q) { const int row = tid & 127, d0 = ((tid >> 7) + 4 * q) * 8; const size_t tk = (size_t)(b * SEQ + (kb - 1) * 128 + row);
                    kreg[q] = *(const u32x4*)(PROJ + tk * NPA + C_SK + hd * 64 + d0); vreg[q] = *(const u32x4*)(PROJ + tk * NPA + C_SV + hd * 64 + d0); } }
            if (tid < 8) flags[tid] = 0;
            __syncthreads();
            const bool walive = __ballot(Lrun >= SB_DEAD) != 0ull;
            if (walive) {
                const int sp_hi = (kb == qb) ? (wid >> 1) : 3;
                for (int sp = sp_hi; sp >= 0; --sp) {
                    if (__ballot(Lrun >= SB_DEAD) == 0ull) break;
                    f32x4 pvv[2];
#pragma unroll
                    for (int h2 = 1; h2 >= 0; --h2) { const int tile = 2 * sp + h2;
                        f32x4 z = (f32x4){0.f, 0.f, 0.f, 0.f};
#pragma unroll
                        for (int ks = 0; ks < 2; ++ks) z = mfma16(ldfrag((const LAS unsigned char*)(Ks + (16 * tile + fr) * 72 + ks * 32 + fq * 8)), qf[ks], z);
                        const int sbase = kb * 128 + 16 * tile + 4 * fq;
                        pvv[h2] = (kb == qb) ? sb_tile<true>(z, sbase, tq, fq, Lrun) : sb_tile<false>(z, sbase, tq, fq, Lrun); }
                    const float pv[8] = {pvv[0][0], pvv[0][1], pvv[0][2], pvv[0][3], pvv[1][0], pvv[1][1], pvv[1][2], pvv[1][3]};
                    u32x4 pw; pw.x = cvt_pk_bf16(pv[0], pv[1]); pw.y = cvt_pk_bf16(pv[2], pv[3]); pw.z = cvt_pk_bf16(pv[4], pv[5]); pw.w = cvt_pk_bf16(pv[6], pv[7]);
                    const bf16x8 pf = __builtin_bit_cast(bf16x8, pw);
#pragma unroll
                    for (int i = 0; i < 4; ++i) { const LAS unsigned char* vr = (const LAS unsigned char*)(Vt + (16 * i + fr) * LP + 32 * sp + 4 * fq);
                        acc[i] = mfma16(ldfrag2(vr, vr + 32), pf, acc[i]); }
                }
            }
            const bool still = __ballot(Lrun >= SB_DEAD) != 0ull;
            if (lane == 0 && still) flags[wid] = 1;
            __syncthreads();
            int any = 0;
#pragma unroll
            for (int i = 0; i < 8; ++i) any |= flags[i];
            if (!any) break;
        }
#pragma unroll
        for (int i = 0; i < 4; ++i) { const int dc = hd * 64 + 16 * i + 4 * fq; const u32x2 z = *(const u32x2*)(PROJ + tokq * NPA + C_SZ + dc);
            u32x2 w; w.x = cvt_pk_bf16(acc[i][0] * bflo(z.x), acc[i][1] * bfhi(z.x)); w.y = cvt_pk_bf16(acc[i][2] * bflo(z.y), acc[i][3] * bfhi(z.y));
            st8(Y + tokq * DM + 768 + dc, w); }
    }
    __syncthreads();
}

__device__ __forceinline__ void final_norm(const Params& p) {
    int tid_ = threadIdx.x; asm volatile("" : "+v"(tid_)); const int tid = tid_, lane = tid & 63, wid = tid >> 6;
    const int stride = gridDim.x * 8; int row = blockIdx.x * 8 + wid;
    f32x4 g[4];
#pragma unroll
    for (int j = 0; j < 4; ++j) g[j] = *(const f32x4*)(p.final_g + j * 256 + lane * 4);
    f32x4 xn[4];
    if (row < NTOK) {
#pragma unroll
        for (int j = 0; j < 4; ++j) xn[j] = *(const f32x4*)(p.out + (size_t)row * DM + j * 256 + lane * 4); }
    for (; row < NTOK; row += stride) {
        float* xr = p.out + (size_t)row * DM; f32x4 xv[4]; float ss = 0.f;
#pragma unroll
        for (int j = 0; j < 4; ++j) { xv[j] = xn[j]; ss += xv[j][0] * xv[j][0] + xv[j][1] * xv[j][1] + xv[j][2] * xv[j][2] + xv[j][3] * xv[j][3]; }
        if (row + stride < NTOK) {
#pragma unroll
            for (int j = 0; j < 4; ++j) xn[j] = *(const f32x4*)(p.out + (size_t)(row + stride) * DM + j * 256 + lane * 4); }
        ss = wave_sum(ss); const float rstd = rsqrtf(ss * (1.f / 1024.f) + EPSF);
#pragma unroll
        for (int j = 0; j < 4; ++j) *(f32x4*)(xr + j * 256 + lane * 4) = xv[j] * rstd * g[j];
    }
}

#define XB_TMO      128
#define XB_XCNT(j)  (256  + 64 * (j))
#define XB_XSUB(j)  (1280 + 64 * (j))
#define XB_XGEN(j)  (2304 + 64 * (j))
#define XB_TOP      3328
#define XB_TOPGEN   3392
#define XCD_BAR_WORDS 3456
#define XB_SPIN_CAP (1u << 18)

__device__ __forceinline__ unsigned xb_ld(unsigned* p)              { return __hip_atomic_load(p, __ATOMIC_RELAXED, __HIP_MEMORY_SCOPE_AGENT); }
__device__ __forceinline__ unsigned xb_add(unsigned* p, unsigned v) { return __hip_atomic_fetch_add(p, v, __ATOMIC_RELAXED, __HIP_MEMORY_SCOPE_AGENT); }
__device__ __forceinline__ unsigned xb_xcc_id() { return (unsigned)__builtin_amdgcn_s_getreg((3 << 11) | 20) & 0xFu; }
#define XB_SPIN(cond, bar) do { unsigned _sp = 0; while (cond) { __builtin_amdgcn_s_sleep(1); \
    if ((++_sp & 255u) == 0u) { if (xb_ld(&(bar)[XB_TMO])) break; if (_sp > XB_SPIN_CAP) { atomicAdd(&(bar)[XB_TMO], 1u); break; } } } } while (0)

struct XcdBarrier {
    unsigned* bar; unsigned x;
    volatile LAS unsigned* st;
};

__device__ __forceinline__ XcdBarrier xcd_barrier_post(unsigned* bar, volatile LAS unsigned* st) {
    XcdBarrier b; b.bar = bar; b.x = xb_xcc_id(); b.st = st;
    if (threadIdx.x == 0) (void)xb_add(&bar[XB_XCNT(b.x)], 1u);
    return b;
}
__device__ __forceinline__ void xcd_barrier_complete(unsigned* bar, unsigned x, unsigned& nloc, unsigned& nx) {
    const unsigned G = gridDim.x * gridDim.y * gridDim.z;
    unsigned sum, cnt, mine, sp = 0u;
    for (;;) {
        sum = 0u; cnt = 0u; mine = 0u;
#pragma unroll
        for (unsigned j = 0; j < 16; ++j) { const unsigned c = xb_ld(&bar[XB_XCNT(j)]); sum += c; cnt += (c > 0u) ? 1u : 0u; mine = (j == x) ? c : mine; }
        if (sum == G) break;
        __builtin_amdgcn_s_sleep(1);
        if ((++sp & 255u) == 0u) { if (xb_ld(&bar[XB_TMO])) break; if (sp > XB_SPIN_CAP) { atomicAdd(&bar[XB_TMO], 1u); break; } }
    }
    nloc = mine > 0u ? mine : 1u; nx = cnt > 0u ? cnt : 1u;
}

__device__ __forceinline__ void xcd_barrier(const XcdBarrier& b) {
    asm volatile("s_waitcnt vmcnt(0)" ::: "memory");
    __syncthreads();
    if (threadIdx.x == 0) {
        unsigned* bar = b.bar;
        __builtin_amdgcn_s_waitcnt(0);
        unsigned nloc = b.st[0], nx = b.st[1];
        if (nloc == 0u) { xcd_barrier_complete(bar, b.x, nloc, nx); b.st[0] = nloc; b.st[1] = nx; }
        const unsigned old = xb_add(&bar[XB_XSUB(b.x)], 1u);
        const unsigned gen = old / nloc;
        if (old + 1u == (gen + 1u) * nloc) {
            __builtin_amdgcn_fence(__ATOMIC_RELEASE, "agent");
            asm volatile("s_waitcnt vmcnt(0)" ::: "memory");
            const unsigned og = xb_add(&bar[XB_TOP], 1u);
            const unsigned tg = og / nx;
            if (og + 1u == (tg + 1u) * nx) xb_add(&bar[XB_TOPGEN], 1u);
            else XB_SPIN(xb_ld(&bar[XB_TOPGEN]) == tg, bar);
            __builtin_amdgcn_fence(__ATOMIC_ACQUIRE, "agent");
            xb_add(&bar[XB_XGEN(b.x)], 1u);
            asm volatile("s_waitcnt vmcnt(0)" ::: "memory");
        } else {
            XB_SPIN(xb_ld(&bar[XB_XGEN(b.x)]) == gen, bar);
            __builtin_amdgcn_fence(__ATOMIC_ACQUIRE, "agent");
            asm volatile("s_waitcnt vmcnt(0)" ::: "memory");
        }
    }
    __syncthreads();
}

constexpr int N_PHASES = 16;
__global__ void __launch_bounds__(512, 2) mk_fwd(Params p) {
    extern __shared__ __attribute__((aligned(16))) unsigned char lds_raw[];
    LAS unsigned char* lds = (LAS unsigned char*)lds_raw;
    cg::grid_group grid = cg::this_grid();
#define GSYNC_CG() do { asm volatile("s_waitcnt vmcnt(0) lgkmcnt(0)" ::: "memory"); __syncthreads(); \
        if (threadIdx.x < 64) { __builtin_amdgcn_fence(__ATOMIC_RELEASE, "agent"); asm volatile("s_waitcnt vmcnt(0)" ::: "memory"); } \
        grid.sync(); \
        if (threadIdx.x < 64) { __builtin_amdgcn_fence(__ATOMIC_ACQUIRE, "agent"); asm volatile("s_waitcnt vmcnt(0)" ::: "memory"); } \
        __syncthreads(); } while (0)
    const bool one_launch = (p.ph_hi - p.ph_lo == N_PHASES);
    volatile LAS unsigned* xst = (volatile LAS unsigned*)(lds + LDS_BYTES - 64);
    if (threadIdx.x == 0) { xst[0] = 0u; xst[1] = 0u; }
    __syncthreads();
    XcdBarrier xbar; xbar.bar = (unsigned*)(p.ws + WS_SMALL + SM_XBAR); xbar.x = 0; xbar.st = xst;
    if (one_launch) xbar = xcd_barrier_post((unsigned*)(p.ws + WS_SMALL + SM_XBAR), xst);
    if (one_launch) grid.sync();
#define GSYNC() do { if (one_launch) xcd_barrier(xbar); else GSYNC_CG(); } while (0)
#pragma unroll 1
    for (int ph = p.ph_lo; ph < p.ph_hi; ++ph) {
        if (ph == 0) { phase_mod(p, (float*)(p.ws + WS_SMALL + SM_MODP)); }
        else if (ph == N_PHASES - 1) { if (gridDim.x != 256) final_norm(p); }
        else {
        int l = (ph - 1) / 7, k = (ph - 1) % 7; asm volatile("" : "+s"(l), "+s"(k));
        const float* xin = (l == 0) ? p.x : p.out;
        int G = gridDim.x, bx = blockIdx.x; asm volatile("" : "+s"(G), "+s"(bx));
        size_t wz_ = 0; asm volatile("" : "+s"(wz_)); unsigned char* ws = p.ws + wz_;
        if (k == 0) { phase_prep(p, l, xin, lds, ws); }
        else if (k == 1) {
        {
            pg8::Gemm g{(const bf16_t*)(ws + WS_H), (const bf16_t*)(ws + WS_WIN), NTOK, NPA, DM, DM, DM}; pg8::StaticOrder S; S.init(NTOK, NPA, G, bx);
            EpiProj E{(bf16_t*)(ws + WS_PROJ), NPA, 0}; NoHook HK; f32x4 acc[2][2][4][2];
            pg8::gemm_phase<EpiProj, pg8::StaticOrder, NoHook, true, true>(lds, g, S, E, HK, acc);
        }
        }
        else if (k == 2) { mlstm_m1(p, l, lds, ws); pool_phase(p, l, lds, ws); }
        else if (k == 3) {
            if (G == 256) {
                int tx_ = threadIdx.x; asm volatile("" : "+v"(tx_)); const int idx = bx * 512 + tx_;
                float dcv[64]; scan_load(dcv, ws, idx);
                sb_phase(p, lds, ws, bx, 256);
                scan_finish(dcv, l, ws, idx);
                mlstm_scan_n(l, ws);
                sb_phase(p, lds, ws, 256 + bx, 512);
            } else { mlstm_scan(l, ws); mlstm_scan_n(l, ws); sb_phase(p, lds, ws, bx, 512); }
        }
        else if (k == 4) { mlstm_m3(p, l, lds, ws); }
        else if (k == 5) {
        {
            pg8::StaticOrder S; S.init(NTOK, DM, G, bx); pg8::Unit u; NoHook HK; f32x4 acc[2][2][4][2];
            const bf16_t* Gp = (const bf16_t*)(ws + WS_G); const bf16_t* Yp = (const bf16_t*)(ws + WS_Y); const bf16_t* Wb = (const bf16_t*)(ws + WS_WBR);
            for (int i = 0; S.next(i, u); ++i) {
                { pg8::Gemm g{(const bf16_t*)(ws + WS_H), (const bf16_t*)(ws + WS_WIN) + (size_t)NPA * 1024, NTOK, NG, DM, DM, DM}; GateOrder GO{u.pm, u.pn};
                  EpiProj E{(bf16_t*)(ws + WS_G), NG, 1};
                  pg8::gemm_phase<EpiProj, GateOrder, NoHook, true, true>(lds, g, GO, E, HK, acc); }
                __syncthreads();
                OneUnit OU{u.pm, u.pn}; EpiNone EN;
                { pg8::Gemm g{Yp, Wb, NTOK, DM, 512, DM, DM};
                  pg8::gemm_phase<EpiNone, OneUnit, NoHook, false, true, true>(lds, g, OU, EN, HK, acc); }
                gate_rescale(acc, Gp, p.gate_b + l * NG, u.pm, u.pn, 0); __syncthreads();
                { pg8::Gemm g{Yp + 512, Wb + 512, NTOK, DM, 256, DM, DM};
                  pg8::gemm_phase<EpiNone, OneUnit, NoHook, false, true, false>(lds, g, OU, EN, HK, acc); }
                gate_rescale(acc, Gp, p.gate_b + l * NG, u.pm, u.pn, 1024); __syncthreads();
                { pg8::Gemm g{Yp + 768, Wb + 768, NTOK, DM, 256, DM, DM}; EpiMerge E{(bf16_t*)(ws + WS_MERGED), Gp, p.gate_b + l * NG};
                  pg8::gemm_phase<EpiMerge, OneUnit, NoHook, false, true, false>(lds, g, OU, E, HK, acc); }
                __syncthreads();
            }
        }
        }
        else {
        {
            pg8::Gemm g{(const bf16_t*)(ws + WS_MERGED), (const bf16_t*)(ws + WS_WOUT), NTOK, DM, DM, DM, DM}; pg8::StaticOrder S; S.init(NTOK, DM, G, bx); pg8::Unit u;
            NoHook HK; f32x4 acc[2][2][4][2];
            if (l == 1 && G == 256) {
                EpiOutNorm E{xin, p.out, (const float*)(ws + WS_SMALL + SM_GATEV) + l * 2048, p.final_g, (unsigned long long*)(ws + WS_SMALL + SM_XEX), (unsigned*)(ws + WS_SMALL + SM_XBAR + 16384)};
                for (int i = 0; S.next(i, u); ++i) { OneUnit OU{u.pm, u.pn};
                    pg8::gemm_phase<EpiOutNorm, OneUnit, NoHook, false, true>(lds, g, OU, E, HK, acc); __syncthreads(); }
            } else {
                EpiOut E{xin, p.out, (const float*)(ws + WS_SMALL + SM_GATEV) + l * 2048};
                for (int i = 0; S.next(i, u); ++i) { OneUnit OU{u.pm, u.pn};
                    pg8::gemm_phase<EpiOut, OneUnit, NoHook, false, true>(lds, g, OU, E, HK, acc); __syncthreads(); }
            }
        }
        }
        }
        if (ph + 1 < p.ph_hi && !(gridDim.x == 256 && ph == N_PHASES - 2)) GSYNC();
    }
}

extern "C" void kernel_launch(void* const* d_in, const int* in_sizes, int n_in, void* d_out, int out_size, void* d_ws, size_t ws_size, hipStream_t stream) {
    static int grid_blocks = 0;
    if (grid_blocks == 0) {
        int dev = 0, cus = 0, per_cu = 0;
        if (n_in != 18 || out_size != NTOK * DM || ws_size < WS_SMALL + SM_END) { fprintf(stderr, "kernel_launch: unexpected shapes (n_in %d out %d ws %zu)\n", n_in, out_size, ws_size); grid_blocks = -1; return; }
        hipGetDevice(&dev); hipDeviceGetAttribute(&cus, hipDeviceAttributeMultiprocessorCount, dev);
        if (hipFuncSetAttribute((const void*)mk_fwd, hipFuncAttributeMaxDynamicSharedMemorySize, LDS_BYTES) != hipSuccess) { fprintf(stderr, "kernel_launch: hipFuncSetAttribute failed\n"); }
        if (hipOccupancyMaxActiveBlocksPerMultiprocessor(&per_cu, (const void*)mk_fwd, 512, LDS_BYTES) != hipSuccess || per_cu < 1) { fprintf(stderr, "kernel_launch: occupancy query gave %d\n", per_cu); per_cu = 1; }
        (void)hipGetLastError();
        grid_blocks = cus * per_cu;
    }
    if (grid_blocks < 0) return;
    Params p{};
    const float** f = (const float**)&p;
    for (int i = 0; i < 18; ++i) f[i] = (const float*)d_in[i];
    p.out = (float*)d_out; p.ws = (unsigned char*)d_ws;
#ifndef MK_PHASES_PER_LAUNCH
#define MK_PHASES_PER_LAUNCH N_PHASES
#endif
    (void)hipMemsetAsync((unsigned char*)d_ws + WS_SMALL + SM_XBAR, 0, XBAR_BYTES, stream);
    for (int lo = 0; lo < N_PHASES; lo += MK_PHASES_PER_LAUNCH) {
        p.ph_lo = lo; p.ph_hi = lo + MK_PHASES_PER_LAUNCH < N_PHASES ? lo + MK_PHASES_PER_LAUNCH : N_PHASES;
        void* args[] = {&p};
        hipError_t e = hipLaunchCooperativeKernel((const void*)mk_fwd, dim3(grid_blocks), dim3(512), args, LDS_BYTES, stream);
        if (e != hipSuccess) { fprintf(stderr, "cooperative launch failed: %s (grid %d)\n", hipGetErrorString(e), grid_blocks); break; }
    }
}
```

```cpp
#include <hip/hip_runtime.h>
#include <hip/hip_cooperative_groups.h>
#include <cstdio>
#include <cstdint>
#include <cstddef>
namespace cg = cooperative_groups;
namespace pg8 {
#define PG8_LAS __attribute__((address_space(3)))
typedef unsigned short bf16_t;
typedef short bf16x8 __attribute__((ext_vector_type(8)));
typedef float f32x4 __attribute__((ext_vector_type(4)));
typedef unsigned u32x4 __attribute__((ext_vector_type(4)));
constexpr int BM = 256, BK = 64, HALF = 128, HTB = HALF * BK * 2  , STAGE_BYTES = 8 * HTB, NXCD = 8, WGM = 8;

__host__ __device__ __forceinline__ int lds_byte(int r, int c) { const int st = (r >> 4) * 2 + (c >> 5), rr = r & 15, cc = c & 31, ob = rr * 64 + cc * 2; return st * 1024 + (ob ^ (((ob >> 9) & 1) << 5)); }
__host__ __device__ __forceinline__ void stage_rc(int b, int& R, int& C) { const int st = b / 1024, sb = b % 1024, swz = sb ^ (((sb >> 9) & 1) << 5); R = (st >> 1) * 16 + swz / 64; C = (st & 1) * 32 + (swz % 64) / 2; }
__host__ __device__ __forceinline__ int perm32(int rho) { const int n = rho >> 4, i = rho & 15; return 8 * (i >> 2) + 4 * n + (i & 3); }

struct Unit { int pm, pn; };
struct Gemm { const bf16_t* A; const bf16_t* Bt; int M, N, K, lda, ldb; };

struct StaticOrder {
    int nM, nN, nwg, G, c;
    __host__ __device__ void init(int M, int N, int G_, int c_) { nM = M / BM; nN = N / BM; nwg = nM * nN; G = G_; c = c_; }
    __host__ __device__ bool next(int i, Unit& u) const {
        const long L = (long)i * G + c; if (L >= nwg) return false;
        int wgid = (int)L; { const int q = nwg / NXCD, r = nwg % NXCD, xcd = wgid % NXCD, off = wgid / NXCD; wgid = (xcd < r ? xcd * (q + 1) : r * (q + 1) + (xcd - r) * q) + off; }
        const int nig = WGM * nN, gid = wgid / nig, fm = gid * WGM, gsz = (nM - fm) < WGM ? (nM - fm) : WGM;
        u.pm = fm + ((wgid % nig) % gsz); u.pn = (wgid % nig) / gsz; return true;
    }
    __device__ __forceinline__ void a_ready(const Unit&) const {}
    __device__ __forceinline__ void done(const Unit&) const {}
};

__device__ __forceinline__ unsigned cvt_pk_bf16(float lo, float hi) { unsigned r; asm volatile("v_cvt_pk_bf16_f32 %0, %1, %2" : "=v"(r) : "v"(lo), "v"(hi)); return r; }
template <class Epi, class Sched, class Hook, bool ALIGN_EPI = false, bool SP2 = false, bool ZERO_ACC = true>
__device__ __forceinline__ void gemm_phase(PG8_LAS unsigned char* lds, const Gemm g, const Sched& S, const Epi& E, const Hook& HK, f32x4 (&acc)[2][2][4][2]) {
    int tid_ = threadIdx.x; asm volatile("" : "+v"(tid_));
    const int tid = tid_, wid = __builtin_amdgcn_readfirstlane(tid >> 6), lane = tid & 63, wr = wid >> 2, wc = wid & 3, fr = lane & 15, fq = lane >> 4;
    const int K = g.K, nt = K / BK;
    unsigned voffA[2], voffB[2];
#pragma unroll
    for (int i = 0; i < 2; ++i) { int R, C; stage_rc(tid * 16 + i * 8192, R, C); const int Rb = Epi::PERM ? ((R & ~31) + perm32(R & 31)) : R;
        voffA[i] = (unsigned)(R * g.lda + C) * 2u; voffB[i] = (unsigned)(Rb * g.ldb + C) * 2u; }
    const size_t kstep = (size_t)(BK * 2);
    const size_t hstepA = (size_t)HALF * g.lda * 2, hstepB = (size_t)HALF * g.ldb * 2;
    const size_t tstepA = 2 * hstepA, tstepB = 2 * hstepB;
    const unsigned ldsw = (unsigned)wid * 1024u;
    const int aoff = lds_byte(wr * 64 + fr, fq * 8), boff = lds_byte(wc * 32 + fr, fq * 8);
#define PG8_SA(b, h) (((b) * 2 + (h)) * HTB)
#define PG8_SB(b, h) ((4 + (b) * 2 + (h)) * HTB)
#define PG8_STAGE(bufoff, gbase, voff) do { _Pragma("unroll") for (int _i = 0; _i < 2; ++_i) \
        __builtin_amdgcn_global_load_lds((const unsigned*)((const char*)(gbase) + (voff)[_i]), (PG8_LAS unsigned*)(lds + (bufoff) + ldsw + _i * 8192), 16, 0, 0); } while (0)
#define PG8_LDA(dst, b, h) do { _Pragma("unroll") for (int m = 0; m < 4; ++m) _Pragma("unroll") for (int k = 0; k < 2; ++k) dst[m][k] = *(const PG8_LAS bf16x8*)(lds + PG8_SA(b, h) + aoff + m * 2048 + k * 1024); } while (0)
#define PG8_LDB(dst, b, h) do { _Pragma("unroll") for (int n = 0; n < 2; ++n) _Pragma("unroll") for (int k = 0; k < 2; ++k) dst[n][k] = *(const PG8_LAS bf16x8*)(lds + PG8_SB(b, h) + boff + n * 2048 + k * 1024); } while (0)
#define PG8_MMA(ai, bj, At, Bt) do { __builtin_amdgcn_s_setprio(1); _Pragma("unroll") for (int m = 0; m < 4; ++m) _Pragma("unroll") for (int n = 0; n < 2; ++n) _Pragma("unroll") for (int k = 0; k < 2; ++k) \
        acc[ai][bj][m][n] = __builtin_amdgcn_mfma_f32_16x16x32_bf16(Bt[n][k], At[m][k], acc[ai][bj][m][n], 0, 0, 0); __builtin_amdgcn_s_setprio(0); } while (0)
#define PG8_WAIT_V(n) asm volatile("s_waitcnt vmcnt(" #n ")" ::: "memory")
#define PG8_WAIT_L(n) asm volatile("s_waitcnt lgkmcnt(" #n ")" ::: "memory")
#define PG8_BAR __builtin_amdgcn_s_barrier()
#define PG8_SCHED __builtin_amdgcn_sched_barrier(0)
    Unit cur, nxt; int ui = 0;
    if (!S.next(0, cur)) return;
    if constexpr (ZERO_ACC) {
#pragma unroll
    for (int a = 0; a < 2; ++a)
#pragma unroll
        for (int b = 0; b < 2; ++b)
#pragma unroll
            for (int m = 0; m < 4; ++m)
#pragma unroll
                for (int n = 0; n < 2; ++n) acc[a][b][m][n] = (f32x4){0.f, 0.f, 0.f, 0.f};
    }
    bf16x8 At[4][2], B0[2][2], B1[2][2];
    const char* cA = (const char*)g.A + (size_t)cur.pm * tstepA; const char* cB = (const char*)g.Bt + (size_t)cur.pn * tstepB;
    S.a_ready(cur);
    if constexpr (SP2) {
        PG8_STAGE(PG8_SB(0, 0), cB, voffB); PG8_STAGE(PG8_SB(0, 1), cB + hstepB, voffB); PG8_STAGE(PG8_SA(0, 0), cA, voffA); PG8_STAGE(PG8_SA(0, 1), cA + hstepA, voffA);
        if (wr == 1) PG8_BAR;
        PG8_WAIT_V(2); PG8_BAR;
        PG8_STAGE(PG8_SB(1, 0), cB + kstep, voffB); PG8_STAGE(PG8_SA(1, 0), cA + kstep, voffA); PG8_STAGE(PG8_SB(1, 1), cB + hstepB + kstep, voffB);
        PG8_WAIT_V(6); PG8_BAR;
    } else {
        PG8_STAGE(PG8_SB(0, 0), cB, voffB); PG8_STAGE(PG8_SA(0, 0), cA, voffA); PG8_STAGE(PG8_SB(0, 1), cB + hstepB, voffB); PG8_STAGE(PG8_SA(0, 1), cA + hstepA, voffA);
        if (wr == 1) PG8_BAR;
        PG8_WAIT_V(4); PG8_BAR;
        PG8_STAGE(PG8_SB(1, 0), cB + kstep, voffB); PG8_STAGE(PG8_SA(1, 0), cA + kstep, voffA); PG8_STAGE(PG8_SB(1, 1), cB + hstepB + kstep, voffB);
        PG8_WAIT_V(6); PG8_BAR;
    }
    for (;;) {
        const bool has_next = S.next(ui + 1, nxt);
        const char* nA = has_next ? (const char*)g.A + (size_t)nxt.pm * tstepA : cA; const char* nB = has_next ? (const char*)g.Bt + (size_t)nxt.pn * tstepB : cB;
#pragma nounroll
        for (int t = 0; t < nt; t += 2) {
            const bool last = (t == nt - 2);
            if constexpr (Hook::ON) { if (t == Hook::T1 || t == Hook::T2) HK(acc, cur, t, wr, wc, fr, fq); }
            const char* a1 = cA + (size_t)(t + 1) * kstep;
            const char* a2 = last ? nA : cA + (size_t)(t + 2) * kstep; const char* b2 = last ? nB : cB + (size_t)(t + 2) * kstep;
            const char* a3 = a2 + kstep; const char* b3 = b2 + kstep;
            if (last && has_next) S.a_ready(nxt);
            if constexpr (SP2) {
            PG8_LDB(B0, 0, 0); PG8_LDB(B1, 0, 1); PG8_SCHED; PG8_LDA(At, 0, 0); PG8_STAGE(PG8_SA(1, 1), a1 + hstepA, voffA);
            PG8_WAIT_V(8); PG8_WAIT_L(0); PG8_BAR; PG8_MMA(0, 0, At, B0); PG8_MMA(0, 1, At, B1); PG8_BAR; PG8_SCHED;
            PG8_LDA(At, 0, 1); PG8_STAGE(PG8_SB(0, 0), b2, voffB); PG8_STAGE(PG8_SB(0, 1), b2 + hstepB, voffB); PG8_STAGE(PG8_SA(0, 0), a2, voffA);
            PG8_WAIT_V(8); PG8_WAIT_L(0); PG8_BAR; PG8_MMA(1, 0, At, B0); PG8_MMA(1, 1, At, B1); PG8_BAR; PG8_SCHED;
            PG8_LDB(B0, 1, 0); PG8_LDB(B1, 1, 1); PG8_SCHED; PG8_LDA(At, 1, 0); PG8_STAGE(PG8_SA(0, 1), a2 + hstepA, voffA);
            PG8_WAIT_V(8); PG8_WAIT_L(0); PG8_BAR; PG8_MMA(0, 0, At, B0); PG8_MMA(0, 1, At, B1); PG8_BAR; PG8_SCHED;
            PG8_LDA(At, 1, 1); PG8_STAGE(PG8_SB(1, 0), b3, voffB); PG8_STAGE(PG8_SB(1, 1), b3 + hstepB, voffB); PG8_STAGE(PG8_SA(1, 0), a3, voffA);
            PG8_WAIT_V(8); PG8_WAIT_L(0); PG8_BAR; PG8_MMA(1, 0, At, B0); PG8_MMA(1, 1, At, B1); PG8_BAR; PG8_SCHED;
            } else {
            PG8_LDB(B0, 0, 0); PG8_SCHED; PG8_LDA(At, 0, 0); PG8_STAGE(PG8_SA(1, 1), a1 + hstepA, voffA);
            PG8_WAIT_L(8); PG8_BAR; PG8_WAIT_L(0); PG8_MMA(0, 0, At, B0); PG8_BAR; PG8_SCHED;
            PG8_LDB(B1, 0, 1); PG8_STAGE(PG8_SB(0, 0), b2, voffB);
            PG8_BAR; PG8_WAIT_L(0); PG8_MMA(0, 1, At, B1); PG8_BAR;
            PG8_LDA(At, 0, 1); PG8_STAGE(PG8_SA(0, 0), a2, voffA);
            PG8_BAR; PG8_WAIT_L(0); PG8_MMA(1, 0, At, B0); PG8_BAR; PG8_SCHED;
            PG8_STAGE(PG8_SB(0, 1), b2 + hstepB, voffB);
            PG8_WAIT_V(6); PG8_BAR; PG8_MMA(1, 1, At, B1); PG8_BAR;
            PG8_LDB(B0, 1, 0); PG8_SCHED; PG8_LDA(At, 1, 0); PG8_STAGE(PG8_SA(0, 1), a2 + hstepA, voffA);
            PG8_WAIT_L(8); PG8_BAR; PG8_WAIT_L(0); PG8_MMA(0, 0, At, B0); PG8_BAR; PG8_SCHED;
            PG8_LDB(B1, 1, 1); PG8_STAGE(PG8_SB(1, 0), b3, voffB);
            PG8_BAR; PG8_WAIT_L(0); PG8_MMA(0, 1, At, B1); PG8_BAR;
            PG8_LDA(At, 1, 1); PG8_STAGE(PG8_SA(1, 0), a3, voffA);
            PG8_BAR; PG8_WAIT_L(0); PG8_MMA(1, 0, At, B0); PG8_BAR; PG8_SCHED;
            PG8_STAGE(PG8_SB(1, 1), b3 + hstepB, voffB);
            PG8_WAIT_V(6); PG8_BAR; PG8_MMA(1, 1, At, B1); PG8_BAR;
            }
        }
        if constexpr (ALIGN_EPI) { if (wr == 0) PG8_BAR; }
        if constexpr (!Epi::AFTER_DRAIN) { E(acc, cur, wr, wc, fr, fq); S.done(cur); }
        if (!has_next) break;
#pragma unroll
        for (int a = 0; a < 2; ++a)
#pragma unroll
            for (int b = 0; b < 2; ++b)
#pragma unroll
                for (int m = 0; m < 4; ++m)
#pragma unroll
                    for (int n = 0; n < 2; ++n) acc[a][b][m][n] = (f32x4){0.f, 0.f, 0.f, 0.f};
        cur = nxt; cA = nA; cB = nB; ++ui;
        if constexpr (ALIGN_EPI) { if (wr == 1) PG8_BAR; }
    }
    PG8_WAIT_V(0);
    if constexpr (!ALIGN_EPI) { if (wr == 0) PG8_BAR; }
    PG8_BAR;
    if constexpr (Epi::AFTER_DRAIN) { E.fused(acc, cur, wr, wc, fr, fq, lds, wid, lane); S.done(cur); }
#undef PG8_SA
#undef PG8_SB
#undef PG8_STAGE
#undef PG8_LDA
#undef PG8_LDB
#undef PG8_MMA
#undef PG8_WAIT_V
#undef PG8_WAIT_L
#undef PG8_BAR
#undef PG8_SCHED
}
}
#define LAS __attribute__((address_space(3)))
typedef unsigned short bf16_t;
typedef short bf16x8 __attribute__((ext_vector_type(8)));
typedef float f32x4 __attribute__((ext_vector_type(4)));
typedef unsigned u32x4 __attribute__((ext_vector_type(4)));
typedef unsigned u32x2 __attribute__((ext_vector_type(2)));
using pg8::cvt_pk_bf16;

constexpr int NTOK = 16384, DM = 1024, SEQ = 8192, NIN = 7176;
constexpr int NPA = 4096;
constexpr int NG = 3072;
constexpr float EPSF = 1e-6f;
constexpr int C_MQ = 0, C_MK = 512, C_MV = 1024, C_MO = 1536, C_MZ = 2048, C_PU = 2560, C_PZ = 2816, C_SQ = 3072, C_SK = 3328, C_SV = 3584, C_SZ = 3840;
constexpr size_t MiB = 1u << 20;
constexpr size_t WS_WIN = 0, WS_WBR = 14 * MiB, WS_WOUT = 16 * MiB, WS_H = 18 * MiB, WS_Y = 50 * MiB, WS_PROJ = 82 * MiB, WS_G = 82 * MiB, WS_MERGED = 178 * MiB,
                 WS_DC = 210 * MiB, WS_SMALL = 242 * MiB;
constexpr size_t SM_MODP = 0;
constexpr size_t SM_GATEV = SM_MODP + 2 * 16 * 2 * 3072 * 4;
constexpr size_t SM_IF = SM_GATEV + 2 * 2 * 1024 * 4;
constexpr size_t SM_DN = SM_IF + 2 * (size_t)NTOK * 8 * 4;
constexpr size_t SM_BEND = SM_DN + 2 * 512 * 128 * 4;
constexpr size_t SM_AMAX = SM_BEND + 4;
constexpr size_t SM_MPREV = SM_BEND + 2 * 512 * 128;
constexpr size_t SM_CPB = (SM_MPREV + 2 * 512 * 4 + 255) & ~(size_t)255;
constexpr size_t SM_XBAR = SM_CPB + (size_t)256 * 32768;
constexpr size_t XBAR_BYTES = 32768;
constexpr size_t SM_XEX = SM_XBAR + XBAR_BYTES;
constexpr size_t SM_END = SM_XEX + (size_t)NTOK * 4 * 8;
static_assert(WS_SMALL + SM_END <= 256 * MiB, "workspace map");
__device__ __forceinline__ bf16_t* cprev_slot(unsigned char* ws, int u) { return (bf16_t*)(u < 256 ? ws + WS_WIN + (size_t)u * 32768 : ws + WS_SMALL + SM_CPB + (size_t)(u - 256) * 32768); }
constexpr int LDS_BYTES = 147456;

struct Params {
    const float *x, *c, *norm_g, *w_ada, *b_ada, *w_in, *m_gate_b, *conv_w, *conv_b, *m_norm_g, *pool_w, *pool_scale, *w_br_m, *w_br_p, *w_br_s, *gate_b, *w_out, *final_g;
    float* out; unsigned char* ws; int ph_lo, ph_hi;
};

__device__ __forceinline__ float bf2f(unsigned short h) { return __uint_as_float(((unsigned)h) << 16); }
__device__ __forceinline__ float bflo(unsigned w) { return __uint_as_float(w << 16); }
__device__ __forceinline__ float bfhi(unsigned w) { return __uint_as_float(w & 0xffff0000u); }
__device__ __forceinline__ unsigned short f2bf(float f) { return (unsigned short)(cvt_pk_bf16(f, 0.f) & 0xffffu); }
__device__ __forceinline__ float fsigmoid(float x) { return __builtin_amdgcn_rcpf(1.f + __expf(-x)); }
__device__ __forceinline__ float fsilu(float x) { return x * fsigmoid(x); }
__device__ __forceinline__ float logsig(float x) { return fminf(x, 0.f) - log1pf(__expf(-fabsf(x))); }
__device__ __forceinline__ float wave_sum(float v) {
#pragma unroll
    for (int m = 32; m >= 1; m >>= 1) v += __shfl_xor(v, m);
    return v;
}
__device__ __forceinline__ f32x4 mfma16(bf16x8 a, bf16x8 b, f32x4 c) { return __builtin_amdgcn_mfma_f32_16x16x32_bf16(a, b, c, 0, 0, 0); }
__device__ __forceinline__ bf16x8 ldfrag(const LAS unsigned char* p) { return *(const LAS bf16x8*)p; }
__device__ __forceinline__ bf16x8 ldfrag2(const LAS unsigned char* pa, const LAS unsigned char* pb) {
    const u32x2 a = *(const LAS u32x2*)pa, b = *(const LAS u32x2*)pb; const u32x4 c = {a.x, a.y, b.x, b.y}; return __builtin_bit_cast(bf16x8, c);
}

#ifndef MK_WT
#define MK_WT 0
#endif
#if MK_WT
__device__ __forceinline__ void st16(void* p, u32x4 v) { asm volatile("global_store_dwordx4 %0, %1, off sc0 sc1\n\ts_nop 1" :: "v"(p), "v"(v) : "memory"); }
__device__ __forceinline__ void st16f(void* p, f32x4 v) { asm volatile("global_store_dwordx4 %0, %1, off sc0 sc1\n\ts_nop 1" :: "v"(p), "v"(v) : "memory"); }
__device__ __forceinline__ void st8(void* p, u32x2 v) { asm volatile("global_store_dwordx2 %0, %1, off sc0 sc1\n\ts_nop 1" :: "v"(p), "v"(v) : "memory"); }
__device__ __forceinline__ void st4(void* p, unsigned v) { asm volatile("global_store_dword %0, %1, off sc0 sc1\n\ts_nop 1" :: "v"(p), "v"(v) : "memory"); }
__device__ __forceinline__ void st4f(void* p, float v) { asm volatile("global_store_dword %0, %1, off sc0 sc1\n\ts_nop 1" :: "v"(p), "v"(v) : "memory"); }
#else
__device__ __forceinline__ void st16(void* p, u32x4 v) { *(u32x4*)p = v; }
__device__ __forceinline__ void st16f(void* p, f32x4 v) { *(f32x4*)p = v; }
__device__ __forceinline__ void st8(void* p, u32x2 v) { *(u32x2*)p = v; }
__device__ __forceinline__ void st4(void* p, unsigned v) { *(unsigned*)p = v; }
__device__ __forceinline__ void st4f(void* p, float v) { *(float*)p = v; }
#endif

struct NoHook { static constexpr bool ON = false; static constexpr int T1 = -1, T2 = -1;
    __device__ __forceinline__ void operator()(f32x4 (&)[2][2][4][2], const pg8::Unit&, int, int, int, int, int) const {} };

struct EpiProj {
    static constexpr bool PERM = true, AFTER_DRAIN = false;
    bf16_t* O; int pitch; int raw;
    __device__ __forceinline__ void operator()(const f32x4 (&acc)[2][2][4][2], const pg8::Unit& u, int wr, int wc, int fr, int fq) const {
        const int pn = u.pn; const int act = raw ? 0 : ((pn == 6 || pn == 7) ? 1 : ((pn == 8 || pn == 9 || pn == 11 || pn == 15) ? 2 : (pn == 12 ? 3 : 0)));
        const int row0 = u.pm * 256 + wr * 64 + fr, col0 = pn * 256 + wc * 32 + 8 * fq;
#pragma unroll
        for (int ai = 0; ai < 2; ++ai)
#pragma unroll
            for (int m = 0; m < 4; ++m) { bf16_t* rowp = O + (size_t)(row0 + ai * 128 + m * 16) * pitch + col0;
#pragma unroll
                for (int bj = 0; bj < 2; ++bj) { float v[8];
#pragma unroll
                    for (int e = 0; e < 4; ++e) { v[e] = acc[ai][bj][m][0][e]; v[4 + e] = acc[ai][bj][m][1][e]; }
                    if (act == 1) {
#pragma unroll
                        for (int e = 0; e < 8; ++e) v[e] = fsigmoid(v[e]);
                    } else if (act == 2) {
#pragma unroll
                        for (int e = 0; e < 8; ++e) v[e] = fsilu(v[e]);
                    } else if (act == 3) {
#pragma unroll
                        for (int e = 0; e < 8; ++e) v[e] *= 0.18033688011112042f;
                    }
                    u32x4 w; w.x = cvt_pk_bf16(v[0], v[1]); w.y = cvt_pk_bf16(v[2], v[3]); w.z = cvt_pk_bf16(v[4], v[5]); w.w = cvt_pk_bf16(v[6], v[7]);
                    st16(rowp + bj * 128, w); } }
    }
};

__device__ __forceinline__ void gate_rescale(f32x4 (&acc)[2][2][4][2], const bf16_t* G, const float* gbias, int pm, int pn, int goff) {
    int tx_ = threadIdx.x; asm volatile("" : "+v"(tx_)); const int wid = tx_ >> 6, lane = tx_ & 63, wr = wid >> 2, wc = wid & 3, fr = lane & 15, fq = lane >> 4;
    const int row0 = pm * 256 + wr * 64 + fr, col0 = pn * 256 + wc * 32 + 8 * fq;
    __builtin_amdgcn_sched_barrier(0);
#pragma unroll
    for (int bj = 0; bj < 2; ++bj) {
        const f32x4 ba0 = *(const f32x4*)(gbias + goff + col0 + bj * 128), ba1 = *(const f32x4*)(gbias + goff + col0 + bj * 128 + 4);
        const f32x4 bb0 = *(const f32x4*)(gbias + goff + 1024 + col0 + bj * 128), bb1 = *(const f32x4*)(gbias + goff + 1024 + col0 + bj * 128 + 4);
#pragma unroll
        for (int ai = 0; ai < 2; ++ai)
#pragma unroll
            for (int m = 0; m < 4; ++m) { const bf16_t* rowp = G + (size_t)(row0 + ai * 128 + m * 16) * NG + goff + col0 + bj * 128;
                const u32x4 a = *(const u32x4*)rowp, b = *(const u32x4*)(rowp + 1024);
                const unsigned aw[4] = {a.x, a.y, a.z, a.w}, bw[4] = {b.x, b.y, b.z, b.w};
                f32x4 r0, r1;
#pragma unroll
                for (int e = 0; e < 2; ++e) {
                    r0[2 * e]     = (1.f + __expf(-(bflo(bw[e]) + bb0[2 * e])))         * __builtin_amdgcn_rcpf(1.f + __expf(-(bflo(aw[e]) + ba0[2 * e])));
                    r0[2 * e + 1] = (1.f + __expf(-(bfhi(bw[e]) + bb0[2 * e + 1])))     * __builtin_amdgcn_rcpf(1.f + __expf(-(bfhi(aw[e]) + ba0[2 * e + 1])));
                    r1[2 * e]     = (1.f + __expf(-(bflo(bw[2 + e]) + bb1[2 * e])))     * __builtin_amdgcn_rcpf(1.f + __expf(-(bflo(aw[2 + e]) + ba1[2 * e])));
                    r1[2 * e + 1] = (1.f + __expf(-(bfhi(bw[2 + e]) + bb1[2 * e + 1]))) * __builtin_amdgcn_rcpf(1.f + __expf(-(bfhi(aw[2 + e]) + ba1[2 * e + 1]))); }
                acc[ai][bj][m][0] *= r0; acc[ai][bj][m][1] *= r1;
                asm volatile("" : "+v"(acc[ai][bj][m][0]), "+v"(acc[ai][bj][m][1]) :: "memory");
                __builtin_amdgcn_sched_barrier(0); }
    }
    asm volatile("s_waitcnt vmcnt(0)" ::: "memory"); __builtin_amdgcn_sched_barrier(0);
}
struct EpiNone { static constexpr bool PERM = true, AFTER_DRAIN = true;
    __device__ __forceinline__ void fused(const f32x4 (&)[2][2][4][2], const pg8::Unit&, int, int, int, int, LAS unsigned char*, int, int) const {} };
struct EpiMerge {
    static constexpr bool PERM = true, AFTER_DRAIN = true;
    bf16_t* O; const bf16_t* G; const float* gbias;
    __device__ __forceinline__ void fused(const f32x4 (&acc)[2][2][4][2], const pg8::Unit& u, int wr, int wc, int fr, int fq, LAS unsigned char*, int, int) const {
        const int row0 = u.pm * 256 + wr * 64 + fr, col0 = u.pn * 256 + wc * 32 + 8 * fq;
#pragma unroll
        for (int ai = 0; ai < 2; ++ai)
#pragma unroll
            for (int m = 0; m < 4; ++m) { const size_t row = (size_t)(row0 + ai * 128 + m * 16);
#pragma unroll
                for (int bj = 0; bj < 2; ++bj) { const u32x4 g = *(const u32x4*)(G + row * NG + 2048 + col0 + bj * 128);
                    const f32x4 b0 = *(const f32x4*)(gbias + 2048 + col0 + bj * 128), b1 = *(const f32x4*)(gbias + 2048 + col0 + bj * 128 + 4);
                    const f32x4 a0 = acc[ai][bj][m][0], a1 = acc[ai][bj][m][1];
                    u32x4 w; w.x = cvt_pk_bf16(a0[0] * fsigmoid(bflo(g.x) + b0[0]), a0[1] * fsigmoid(bfhi(g.x) + b0[1])); w.y = cvt_pk_bf16(a0[2] * fsigmoid(bflo(g.y) + b0[2]), a0[3] * fsigmoid(bfhi(g.y) + b0[3]));
                    w.z = cvt_pk_bf16(a1[0] * fsigmoid(bflo(g.z) + b1[0]), a1[1] * fsigmoid(bfhi(g.z) + b1[1])); w.w = cvt_pk_bf16(a1[2] * fsigmoid(bflo(g.w) + b1[2]), a1[3] * fsigmoid(bfhi(g.w) + b1[3]));
                    st16(O + row * DM + col0 + bj * 128, w); } }
    }
};
struct EpiOut {
    static constexpr bool PERM = true, AFTER_DRAIN = true;
    const float* xin; float* xout; const float* gate;
    __device__ __forceinline__ void fused(const f32x4 (&acc)[2][2][4][2], const pg8::Unit& u, int wr, int wc, int fr, int fq, LAS unsigned char*, int, int) const {
        const int row0 = u.pm * 256 + wr * 64 + fr, col0 = u.pn * 256 + wc * 32 + 8 * fq; const float* gb = gate + ((u.pm * 256) / SEQ) * 1024;
#pragma unroll
        for (int bj = 0; bj < 2; ++bj) {
            const f32x4 g0 = *(const f32x4*)(gb + col0 + bj * 128), g1 = *(const f32x4*)(gb + col0 + bj * 128 + 4);
#pragma unroll
            for (int ai = 0; ai < 2; ++ai)
#pragma unroll
                for (int m = 0; m < 4; ++m) { const size_t off = (size_t)(row0 + ai * 128 + m * 16) * DM + col0 + bj * 128;
                    const f32x4 x0 = *(const f32x4*)(xin + off), x1 = *(const f32x4*)(xin + off + 4);
                    st16f(xout + off, x0 + g0 * acc[ai][bj][m][0]); st16f(xout + off + 4, x1 + g1 * acc[ai][bj][m][1]); }
        }
    }
};
struct EpiOutNorm {
    static constexpr bool PERM = true, AFTER_DRAIN = true;
    const float* xin; float* out; const float* gate; const float* fg; unsigned long long* xbuf; unsigned* cnt;
    __device__ __forceinline__ void fused(f32x4 (&acc)[2][2][4][2], const pg8::Unit& u, int wr, int wc, int fr, int fq, LAS unsigned char* lds, int wid, int lane) const {
        const int row0 = u.pm * 256 + wr * 64 + fr, col0 = u.pn * 256 + wc * 32 + 8 * fq; const float* gb = gate + ((u.pm * 256) / SEQ) * 1024;
        LAS float* P = (LAS float*)lds; LAS float* S = (LAS float*)(lds + 8192);
#pragma unroll
        for (int bj = 0; bj < 2; ++bj) {
            const f32x4 g0 = *(const f32x4*)(gb + col0 + bj * 128), g1 = *(const f32x4*)(gb + col0 + bj * 128 + 4);
#pragma unroll
            for (int ai = 0; ai < 2; ++ai)
#pragma unroll
                for (int m = 0; m < 4; ++m) { const size_t off = (size_t)(row0 + ai * 128 + m * 16) * DM + col0 + bj * 128;
                    acc[ai][bj][m][0] = *(const f32x4*)(xin + off) + g0 * acc[ai][bj][m][0]; acc[ai][bj][m][1] = *(const f32x4*)(xin + off + 4) + g1 * acc[ai][bj][m][1];
                    asm volatile("" : "+v"(acc[ai][bj][m][0]), "+v"(acc[ai][bj][m][1]) :: "memory"); }
        }
#pragma unroll
        for (int ai = 0; ai < 2; ++ai)
#pragma unroll
            for (int m = 0; m < 4; ++m) { float sq = 0.f;
#pragma unroll
                for (int bj = 0; bj < 2; ++bj)
#pragma unroll
                    for (int n = 0; n < 2; ++n) { const f32x4 v = acc[ai][bj][m][n]; sq += (v[0] * v[0] + v[1] * v[1]) + (v[2] * v[2] + v[3] * v[3]); }
                sq += __shfl_xor(sq, 16); sq += __shfl_xor(sq, 32);
                if (fq == 0) P[(ai * 128 + wr * 64 + m * 16 + fr) * 4 + wc] = sq; }
        __syncthreads();
        const int row = wid * 32 + (lane & 31);
        if (lane < 32) { const float t = (P[row * 4 + 0] + P[row * 4 + 1]) + (P[row * 4 + 2] + P[row * 4 + 3]);
            __hip_atomic_store(xbuf + ((size_t)(u.pm * 256 + row) * 4 + u.pn), (unsigned long long)__float_as_uint(t), __ATOMIC_RELAXED, __HIP_MEMORY_SCOPE_AGENT); }
        asm volatile("s_waitcnt vmcnt(0)" ::: "memory");
        if (lane == 0) __hip_atomic_fetch_add(cnt + 64 * u.pm, 1u, __ATOMIC_RELAXED, __HIP_MEMORY_SCOPE_AGENT);
        if (wid == 0) {
            for (unsigned spins = 0; spins < (1u << 22); ++spins) { if ((unsigned)__builtin_amdgcn_readfirstlane(__hip_atomic_load(cnt + 64 * u.pm, __ATOMIC_RELAXED, __HIP_MEMORY_SCOPE_AGENT)) >= 32u) break; __builtin_amdgcn_s_sleep(2); }
            __builtin_amdgcn_fence(__ATOMIC_ACQUIRE, "agent");
        }
        asm volatile("s_waitcnt vmcnt(0) lgkmcnt(0)" ::: "memory");
        __syncthreads();
        if (lane < 32) { const unsigned long long* slot = xbuf + (size_t)(u.pm * 256 + row) * 4; float t = 0.f;
#pragma unroll
            for (int q = 0; q < 4; ++q) t += __uint_as_float((unsigned)__hip_atomic_load(slot + q, __ATOMIC_RELAXED, __HIP_MEMORY_SCOPE_AGENT));
            S[row] = rsqrtf(t * (1.f / 1024.f) + EPSF); }
        __syncthreads();
#pragma unroll
        for (int bj = 0; bj < 2; ++bj) {
            const f32x4 f0 = *(const f32x4*)(fg + col0 + bj * 128), f1 = *(const f32x4*)(fg + col0 + bj * 128 + 4);
#pragma unroll
            for (int ai = 0; ai < 2; ++ai)
#pragma unroll
                for (int m = 0; m < 4; ++m) { const size_t off = (size_t)(row0 + ai * 128 + m * 16) * DM + col0 + bj * 128; const float r = S[ai * 128 + wr * 64 + m * 16 + fr];
                    *(f32x4*)(out + off) = acc[ai][bj][m][0] * r * f0; *(f32x4*)(out + off + 4) = acc[ai][bj][m][1] * r * f1; }
        }
    }
};
struct GateOrder { int pm, pn;
    __device__ __forceinline__ bool next(int i, pg8::Unit& u) const { if (i >= 3) return false; u.pm = pm; u.pn = pn + 4 * i; return true; }
    __device__ __forceinline__ void a_ready(const pg8::Unit&) const {}
    __device__ __forceinline__ void done(const pg8::Unit&) const {} };
struct OneUnit { int pm, pn;
    __device__ __forceinline__ bool next(int i, pg8::Unit& u) const { if (i >= 1) return false; u.pm = pm; u.pn = pn; return true; }
    __device__ __forceinline__ void a_ready(const pg8::Unit&) const {}
    __device__ __forceinline__ void done(const pg8::Unit&) const {} };

__device__ __forceinline__ void phase_mod(const Params& p, float* MODP) {
    for (int u = blockIdx.x; u < 192; u += gridDim.x) {
        const int l = u / 96, r = u % 96, ks = r / 6, jb = r % 6; int tx_ = threadIdx.x; asm volatile("" : "+v"(tx_)); const int j = jb * 512 + tx_;
        const float* w = p.w_ada + ((size_t)l * 1024 + ks * 64) * 3072 + j; const float* c0 = p.c + ks * 64; const float* c1 = p.c + 1024 + ks * 64;
        float a0 = 0.f, a1 = 0.f;
#pragma unroll 8
        for (int k = 0; k < 64; ++k) { const float wv = w[(size_t)k * 3072]; a0 += c0[k] * wv; a1 += c1[k] * wv; }
        st4f(MODP + ((l * 16 + ks) * 2 + 0) * 3072 + j, a0); st4f(MODP + ((l * 16 + ks) * 2 + 1) * 3072 + j, a1);
    }
}

struct TItem { const float* src; int ld; bf16_t* dst; };
__device__ __forceinline__ TItem transpose_item(const Params& p, int l, int it, bf16_t* WinT, bf16_t* WbrT, bf16_t* WoutT) {
    TItem t;
    if (it < 1792) { const int nt = it >> 4, kt = it & 15, n0 = nt * 64, c0 = n0 < 1536 ? n0 : n0 + 8;
        t.src = p.w_in + (size_t)l * 1024 * NIN + (size_t)kt * 64 * NIN + c0; t.ld = NIN; t.dst = WinT + (size_t)n0 * 1024 + kt * 64;
    } else if (it < 2048) { const int j = it - 1792, nt = j >> 4, kt = j & 15, k0 = kt * 64;
        const float* src = k0 < 512 ? p.w_br_m + (size_t)l * 512 * 1024 + (size_t)k0 * 1024 : (k0 < 768 ? p.w_br_p + (size_t)l * 256 * 1024 + (size_t)(k0 - 512) * 1024 : p.w_br_s + (size_t)l * 256 * 1024 + (size_t)(k0 - 768) * 1024);
        t.src = src + nt * 64; t.ld = 1024; t.dst = WbrT + (size_t)nt * 64 * 1024 + k0;
    } else { const int j = it - 2048, nt = j >> 4, kt = j & 15;
        t.src = p.w_out + (size_t)l * 1024 * 1024 + (size_t)kt * 64 * 1024 + nt * 64; t.ld = 1024; t.dst = WoutT + (size_t)nt * 64 * 1024 + kt * 64; }
    return t;
}
__device__ __forceinline__ void phase_prep(const Params& p, int l, const float* xin, LAS unsigned char* lds, unsigned char* ws_in) {
    size_t wz_ = 0; asm volatile("" : "+s"(wz_)); unsigned char* ws = ws_in + wz_;
    int tid_ = threadIdx.x; asm volatile("" : "+v"(tid_)); const int tid = tid_, lane = tid & 63, wid = tid >> 6;
    bf16_t* WinT = (bf16_t*)(ws + WS_WIN); bf16_t* WbrT = (bf16_t*)(ws + WS_WBR); bf16_t* WoutT = (bf16_t*)(ws + WS_WOUT);
    LAS float* tl = (LAS float*)lds;
    { float tv[8]; int it = blockIdx.x;
      if (it < 2304) { const TItem t0 = transpose_item(p, l, it, WinT, WbrT, WoutT);
#pragma unroll
          for (int i = 0; i < 8; ++i) tv[i] = t0.src[(size_t)(i * 8 + (tid >> 6)) * t0.ld + (tid & 63)]; }
      for (; it < 2304; it += gridDim.x) {
          const TItem t = transpose_item(p, l, it, WinT, WbrT, WoutT);
#pragma unroll
          for (int i = 0; i < 8; ++i) tl[(i * 8 + (tid >> 6)) * 65 + (tid & 63)] = tv[i];
          __syncthreads();
          if (it + (int)gridDim.x < 2304) { const TItem tn = transpose_item(p, l, it + gridDim.x, WinT, WbrT, WoutT);
#pragma unroll
              for (int i = 0; i < 8; ++i) tv[i] = tn.src[(size_t)(i * 8 + (tid >> 6)) * tn.ld + (tid & 63)]; }
#pragma unroll
          for (int i = 0; i < 4; ++i) { const int nn = i * 16 + (tid >> 5), kk = (tid & 31) * 2; st4(t.dst + (size_t)nn * 1024 + kk, cvt_pk_bf16(tl[kk * 65 + nn], tl[(kk + 1) * 65 + nn])); }
          __syncthreads();
      } }
    const float* MODP = (const float*)(ws + WS_SMALL + SM_MODP) + (size_t)l * 16 * 2 * 3072;
    float* GATEV = (float*)(ws + WS_SMALL + SM_GATEV) + l * 2048; float* IFG = (float*)(ws + WS_SMALL + SM_IF + (size_t)l * NTOK * 32);
    bf16_t* H = (bf16_t*)(ws + WS_H);
    LAS float* A = (LAS float*)(lds + 16896); LAS float* Sh = A + 1024; LAS float* Wif = Sh + 1024;
    for (int rb = blockIdx.x; rb < 256; rb += gridDim.x) {
        const int b = (rb * 64) / SEQ;
        __syncthreads();
#pragma unroll
        for (int q = 0; q < 2; ++q) { const int k = tid + q * 512; float sh = p.b_ada[l * 3072 + k], sc = p.b_ada[l * 3072 + 1024 + k];
            for (int ks = 0; ks < 16; ++ks) { sh += MODP[(ks * 2 + b) * 3072 + k]; sc += MODP[(ks * 2 + b) * 3072 + 1024 + k]; }
            A[k] = p.norm_g[l * 1024 + k] * (1.f + sc); Sh[k] = sh; }
        if (rb < 4) { const int e = rb * 512 + tid, bb = e >> 10, j = e & 1023; float g = p.b_ada[l * 3072 + 2048 + j];
            for (int ks = 0; ks < 16; ++ks) g += MODP[(ks * 2 + bb) * 3072 + 2048 + j];
            st4f(GATEV + bb * 1024 + j, g); }
#pragma unroll
        for (int q = 0; q < 16; ++q) { const int e = tid + q * 512, k = e >> 3, g = e & 7; Wif[g * 1024 + k] = p.w_in[(size_t)l * 1024 * NIN + (size_t)k * NIN + 1536 + g]; }
        __syncthreads();
        f32x4 xn[4];
        { const float* xr0 = xin + (size_t)(rb * 64 + wid * 8) * DM;
#pragma unroll
          for (int j = 0; j < 4; ++j) xn[j] = *(const f32x4*)(xr0 + (j >> 1) * 512 + lane * 8 + (j & 1) * 4); }
        for (int i = 0; i < 8; ++i) {
            const int row = rb * 64 + wid * 8 + i;
            f32x4 xv[4]; float ss = 0.f;
#pragma unroll
            for (int j = 0; j < 4; ++j) { xv[j] = xn[j]; ss += xv[j][0] * xv[j][0] + xv[j][1] * xv[j][1] + xv[j][2] * xv[j][2] + xv[j][3] * xv[j][3]; }
            if (i < 7) { const float* xr1 = xin + (size_t)(row + 1) * DM;
#pragma unroll
                for (int j = 0; j < 4; ++j) xn[j] = *(const f32x4*)(xr1 + (j >> 1) * 512 + lane * 8 + (j & 1) * 4); }
            ss = wave_sum(ss); const float rstd = rsqrtf(ss * (1.f / 1024.f) + EPSF);
            float gp[8];
#pragma unroll
            for (int g = 0; g < 8; ++g) gp[g] = 0.f;
            f32x4 hv[4];
#pragma unroll
            for (int j = 0; j < 4; ++j) { const int k = (j >> 1) * 512 + lane * 8 + (j & 1) * 4; const f32x4 a = *(const LAS f32x4*)(A + k), sft = *(const LAS f32x4*)(Sh + k);
                hv[j] = xv[j] * rstd * a + sft;
#pragma unroll
                for (int g = 0; g < 8; ++g) { const f32x4 wv = *(const LAS f32x4*)(Wif + g * 1024 + k); gp[g] += hv[j][0] * wv[0] + hv[j][1] * wv[1] + hv[j][2] * wv[2] + hv[j][3] * wv[3]; } }
#pragma unroll
            for (int j = 0; j < 2; ++j) { u32x4 w; w.x = cvt_pk_bf16(hv[2 * j][0], hv[2 * j][1]); w.y = cvt_pk_bf16(hv[2 * j][2], hv[2 * j][3]); w.z = cvt_pk_bf16(hv[2 * j + 1][0], hv[2 * j + 1][1]); w.w = cvt_pk_bf16(hv[2 * j + 1][2], hv[2 * j + 1][3]);
                st16(H + (size_t)row * DM + j * 512 + lane * 8, w); }
#pragma unroll
            for (int g = 0; g < 8; ++g) gp[g] = wave_sum(gp[g]);
            float outv = gp[0];
#pragma unroll
            for (int g = 1; g < 8; ++g) outv = (lane == g) ? gp[g] : outv;
            if (lane < 8) st4f(IFG + (size_t)row * 8 + lane, outv + p.m_gate_b[l * 8 + lane]);
        }
    }
    __syncthreads();
}

constexpr int LP = 136;
constexpr int OFF_Q = 0, OFF_K = 34816, OFF_V = 69632, OFF_C = 104448, OFF_AR = 139264;
template <int MODE> __device__ __forceinline__ void mlstm_gates(const float* IFG, int tok0, int hd, float mprev, LAS float* ar, int tid) {
    if (tid < 64) { const int l = tid;
        const float i0 = IFG[(size_t)(tok0 + 2 * l) * 8 + hd], i1 = IFG[(size_t)(tok0 + 2 * l + 1) * 8 + hd];
        const float f0 = logsig(IFG[(size_t)(tok0 + 2 * l) * 8 + 4 + hd]), f1 = logsig(IFG[(size_t)(tok0 + 2 * l + 1) * 8 + 4 + hd]);
        float sc = f0 + f1;
#pragma unroll
        for (int d = 1; d < 64; d <<= 1) { const float t = __shfl_up(sc, d); if (l >= d) sc += t; }
        const float c1 = sc, c0 = sc - f1;
        ar[2 * l] = i0; ar[2 * l + 1] = i1; ar[128 + 2 * l] = c0; ar[128 + 2 * l + 1] = c1;
        if (MODE == 1) { const float bend = __shfl(c1, 63); const float a0 = bend - c0 + i0, a1 = bend - c1 + i1; float am = fmaxf(a0, a1);
#pragma unroll
            for (int m = 32; m >= 1; m >>= 1) am = fmaxf(am, __shfl_xor(am, m));
            ar[3 * 128 + 2 * l] = __expf(a0 - am); ar[3 * 128 + 2 * l + 1] = __expf(a1 - am);
            if (l == 0) { ar[7 * 128] = bend; ar[7 * 128 + 1] = am; } }
        if (MODE == 3) { const float g0 = i0 - c0, g1 = i1 - c1; float pm = fmaxf(g0, g1);
#pragma unroll
            for (int d = 1; d < 64; d <<= 1) { const float t = __shfl_up(pm, d); if (l >= d) pm = fmaxf(pm, t); }
            float pprev = __shfl_up(pm, 1); if (l == 0) pprev = -3.0e38f;
            const float pm0 = fmaxf(pprev, g0), pm1 = pm;
            const float mt0 = c0 + fmaxf(mprev, pm0), mt1 = c1 + fmaxf(mprev, pm1);
            ar[2 * 128 + 2 * l] = g0; ar[2 * 128 + 2 * l + 1] = g1;
            ar[3 * 128 + 2 * l] = __expf(c0 + mprev - mt0); ar[3 * 128 + 2 * l + 1] = __expf(c1 + mprev - mt1);
            ar[4 * 128 + 2 * l] = c0 - mt0; ar[4 * 128 + 2 * l + 1] = c1 - mt1;
            ar[5 * 128 + 2 * l] = __expf(-mt0); ar[5 * 128 + 2 * l + 1] = __expf(-mt1); }
    }
}
template <bool TR> __device__ __forceinline__ void stage_conv(const bf16_t* PROJ, int colbase, const float* cw, const float* cb, int ch0, int tok0, int pos0, float scale, LAS bf16_t* dst, int tid) {
    const int d0 = (tid & 15) * 8, s0 = (tid >> 4) * 4;
    float x[7][8];
    const bf16_t* src = PROJ + (size_t)tok0 * NPA + colbase + d0;
#pragma unroll
    for (int r = 0; r < 7; ++r) { const int sr = s0 - 3 + r; u32x4 v = {0u, 0u, 0u, 0u}; if (pos0 + sr >= 0) v = *(const u32x4*)(src + (ptrdiff_t)sr * NPA);
        x[r][0] = bflo(v.x); x[r][1] = bfhi(v.x); x[r][2] = bflo(v.y); x[r][3] = bfhi(v.y); x[r][4] = bflo(v.z); x[r][5] = bfhi(v.z); x[r][6] = bflo(v.w); x[r][7] = bfhi(v.w); }
    float o[4][8];
    { const f32x4 b0 = *(const f32x4*)(cb + ch0 + d0), b1 = *(const f32x4*)(cb + ch0 + d0 + 4);
#pragma unroll
      for (int i = 0; i < 4; ++i) { o[i][0] = b0[0]; o[i][1] = b0[1]; o[i][2] = b0[2]; o[i][3] = b0[3]; o[i][4] = b1[0]; o[i][5] = b1[1]; o[i][6] = b1[2]; o[i][7] = b1[3]; } }
#pragma unroll
    for (int j = 0; j < 4; ++j) { const f32x4 w0 = *(const f32x4*)(cw + j * 1024 + ch0 + d0), w1 = *(const f32x4*)(cw + j * 1024 + ch0 + d0 + 4);
#pragma unroll
        for (int i = 0; i < 4; ++i) { o[i][0] += w0[0] * x[i + j][0]; o[i][1] += w0[1] * x[i + j][1]; o[i][2] += w0[2] * x[i + j][2]; o[i][3] += w0[3] * x[i + j][3];
                                      o[i][4] += w1[0] * x[i + j][4]; o[i][5] += w1[1] * x[i + j][5]; o[i][6] += w1[2] * x[i + j][6]; o[i][7] += w1[3] * x[i + j][7]; } }
#pragma unroll
    for (int i = 0; i < 4; ++i)
#pragma unroll
        for (int c = 0; c < 8; ++c) o[i][c] = fsilu(o[i][c]) * scale;
    if (TR) {
#pragma unroll
        for (int c = 0; c < 8; ++c) { u32x2 w; w.x = cvt_pk_bf16(o[0][c], o[1][c]); w.y = cvt_pk_bf16(o[2][c], o[3][c]); *(LAS u32x2*)(dst + (d0 + c) * LP + s0) = w; }
    } else {
#pragma unroll
        for (int i = 0; i < 4; ++i) { u32x4 w; w.x = cvt_pk_bf16(o[i][0], o[i][1]); w.y = cvt_pk_bf16(o[i][2], o[i][3]); w.z = cvt_pk_bf16(o[i][4], o[i][5]); w.w = cvt_pk_bf16(o[i][6], o[i][7]); *(LAS u32x4*)(dst + (s0 + i) * LP + d0) = w; }
    }
}
template <bool SCALE> __device__ __forceinline__ void stage_vt(const bf16_t* PROJ, int tok0, int hd, const LAS float* wa, LAS bf16_t* dst, int tid) {
#pragma unroll
    for (int q = 0; q < 4; ++q) { const int s = tid & 127, d0 = ((tid >> 7) + 4 * q) * 8;
        const u32x4 v = *(const u32x4*)(PROJ + (size_t)(tok0 + s) * NPA + C_MV + hd * 128 + d0); const float sc = SCALE ? wa[s] : 1.f;
        const unsigned wv[4] = {v.x, v.y, v.z, v.w};
#pragma unroll
        for (int e = 0; e < 4; ++e) { const float lo = bflo(wv[e]) * sc, hi = bfhi(wv[e]) * sc;
            dst[(d0 + 2 * e) * LP + s] = SCALE ? f2bf(lo) : (bf16_t)(wv[e] & 0xffffu); dst[(d0 + 2 * e + 1) * LP + s] = SCALE ? f2bf(hi) : (bf16_t)(wv[e] >> 16); } }
}

__device__ __forceinline__ void mlstm_m1(const Params& p, int l, LAS unsigned char* lds, unsigned char* ws_in) {
    size_t wz_ = 0; asm volatile("" : "+s"(wz_)); unsigned char* ws = ws_in + wz_;
    int tid_ = threadIdx.x; asm volatile("" : "+v"(tid_)); const int tid = tid_, lane = tid & 63, wid = tid >> 6, fr = lane & 15, fq = lane >> 4;
    const bf16_t* PROJ = (const bf16_t*)(ws + WS_PROJ); const float* IFG = (const float*)(ws + WS_SMALL + SM_IF + (size_t)l * NTOK * 32);
    float* DC = (float*)(ws + WS_DC); float* DN = (float*)(ws + WS_SMALL + SM_DN + (size_t)l * 262144); float* BEND = (float*)(ws + WS_SMALL + SM_BEND + (size_t)l * 65536); float* AMAX = (float*)(ws + WS_SMALL + SM_AMAX + (size_t)l * 65536);
    LAS float* ar = (LAS float*)(lds + OFF_AR); LAS bf16_t* Vt = (LAS bf16_t*)(lds + OFF_V); LAS bf16_t* Kt = (LAS bf16_t*)(lds + OFF_K);
    for (int u = blockIdx.x; u < 512; u += gridDim.x) {
        const int b = u >> 8, hd = (u >> 6) & 3, c = u & 63, tok0 = b * SEQ + c * 128, pos0 = c * 128;
        __syncthreads();
        mlstm_gates<1>(IFG, tok0, hd, 0.f, ar, tid);
        __syncthreads();
        const float bend = ar[7 * 128], amax = ar[7 * 128 + 1];
        stage_vt<true>(PROJ, tok0, hd, ar + 3 * 128, Vt, tid);
        stage_conv<true>(PROJ, C_MK + hd * 128, p.conv_w + (size_t)l * 4096, p.conv_b + l * 1024, 512 + hd * 128, tok0, pos0, 0.08838834764831845f, Kt, tid);
        __syncthreads();
        f32x4 acc[8];
#pragma unroll
        for (int j = 0; j < 8; ++j) acc[j] = (f32x4){0.f, 0.f, 0.f, 0.f};
#pragma unroll
        for (int ks = 0; ks < 4; ++ks) { const bf16x8 a = ldfrag((const LAS unsigned char*)(Vt + (16 * wid + fr) * LP + ks * 32 + fq * 8));
#pragma unroll
            for (int j = 0; j < 8; ++j) acc[j] = mfma16(ldfrag((const LAS unsigned char*)(Kt + (16 * j + fr) * LP + ks * 32 + fq * 8)), a, acc[j]); }
        bf16_t* dcu = (bf16_t*)(DC + (size_t)u * 16384);
#pragma unroll
        for (int j = 0; j < 8; ++j) { u32x2 w; w.x = cvt_pk_bf16(acc[j][0], acc[j][1]); w.y = cvt_pk_bf16(acc[j][2], acc[j][3]); st8(dcu + (16 * wid + fr) * 128 + 16 * j + 4 * fq, w); }
        if (tid < 128) { float sn = 0.f;
#pragma unroll 4
            for (int jj = 0; jj < 16; ++jj) { const u32x4 kv = *(const LAS u32x4*)(Kt + tid * LP + jj * 8); const f32x4 w0 = *(const LAS f32x4*)(ar + 3 * 128 + jj * 8), w1 = *(const LAS f32x4*)(ar + 3 * 128 + jj * 8 + 4);
                sn += w0[0] * bflo(kv.x) + w0[1] * bfhi(kv.x) + w0[2] * bflo(kv.y) + w0[3] * bfhi(kv.y) + w1[0] * bflo(kv.z) + w1[1] * bfhi(kv.z) + w1[2] * bflo(kv.w) + w1[3] * bfhi(kv.w); }
            st4f(DN + u * 128 + tid, sn); }
        if (tid == 0) { st4f(BEND + u * 32, bend); st4f(AMAX + u * 32, amax); }
    }
    __syncthreads();
}

__device__ __forceinline__ void scan_load(float (&dcv)[64], unsigned char* ws, int idx) {
    const int bh = idx >> 14, e = idx & 16383; const bf16_t* base = (const bf16_t*)(ws + WS_DC) + (size_t)bh * 64 * 32768 + e;
#pragma unroll
    for (int c = 0; c < 64; ++c) dcv[c] = bf2f(base[(size_t)c * 32768]);
}
__device__ __forceinline__ void scan_finish(const float (&dcv)[64], int l, unsigned char* ws, int idx) {
    const float* BEND = (const float*)(ws + WS_SMALL + SM_BEND + (size_t)l * 65536); const float* AMAX = (const float*)(ws + WS_SMALL + SM_AMAX + (size_t)l * 65536);
    float* MPREV = (float*)(ws + WS_SMALL + SM_MPREV + (size_t)l * 2048);
    const int bh = idx >> 14, e = idx & 16383;
    float m = 0.f, cst = 0.f;
#pragma unroll
    for (int c = 0; c < 64; ++c) { const float be = BEND[(bh * 64 + c) * 32], am = AMAX[(bh * 64 + c) * 32]; const float mn = fmaxf(be + m, am), dec = __expf(be + m - mn), inw = __expf(am - mn);
        cprev_slot(ws, bh * 64 + c)[e] = f2bf(cst); cst = dec * cst + inw * dcv[c]; if (e == 0) st4f(MPREV + bh * 64 + c, m); m = mn; }
}
__device__ __forceinline__ void mlstm_scan(int l, unsigned char* ws_in) {
    size_t wz_ = 0; asm volatile("" : "+s"(wz_)); unsigned char* ws = ws_in + wz_;
    int tx_ = threadIdx.x; asm volatile("" : "+v"(tx_));
    for (int idx = blockIdx.x * 512 + tx_; idx < 8 * 16384; idx += gridDim.x * 512) { float dcv[64]; scan_load(dcv, ws, idx); scan_finish(dcv, l, ws, idx); }
}
__device__ __forceinline__ void mlstm_scan_n(int l, unsigned char* ws_in) {
    size_t wz_ = 0; asm volatile("" : "+s"(wz_)); unsigned char* ws = ws_in + wz_;
    float* DN = (float*)(ws + WS_SMALL + SM_DN + (size_t)l * 262144); const float* BEND = (const float*)(ws + WS_SMALL + SM_BEND + (size_t)l * 65536); const float* AMAX = (const float*)(ws + WS_SMALL + SM_AMAX + (size_t)l * 65536);
    int tx_ = threadIdx.x; asm volatile("" : "+v"(tx_));
    for (int idx = (tx_ < 64 && gridDim.x >= 16) ? (int)blockIdx.x * 64 + tx_ : (gridDim.x >= 16 ? 8 * 128 : (int)blockIdx.x * 512 + tx_); idx < 8 * 128; idx += (gridDim.x >= 16 ? 8 * 128 : gridDim.x * 512)) {
        const int bh = idx >> 7, e = idx & 127;
        float* base = DN + (size_t)bh * 64 * 128 + e;
        float dcv[64];
#pragma unroll
        for (int c = 0; c < 64; ++c) dcv[c] = base[c * 128];
        float m = 0.f, cst = 0.f;
#pragma unroll
        for (int c = 0; c < 64; ++c) { const float be = BEND[(bh * 64 + c) * 32], am = AMAX[(bh * 64 + c) * 32]; const float mn = fmaxf(be + m, am), dec = __expf(be + m - mn), inw = __expf(am - mn);
            st4f(base + c * 128, cst); cst = dec * cst + inw * dcv[c]; m = mn; }
    }
}

__device__ __forceinline__ void mlstm_m3(const Params& p, int l, LAS unsigned char* lds, unsigned char* ws_in) {
    size_t wz_ = 0; asm volatile("" : "+s"(wz_)); unsigned char* ws = ws_in + wz_;
    int tid_ = threadIdx.x; asm volatile("" : "+v"(tid_)); const int tid = tid_, lane = tid & 63, wid = tid >> 6, fr = lane & 15, fq = lane >> 4;
    const bf16_t* PROJ = (const bf16_t*)(ws + WS_PROJ); const float* IFG = (const float*)(ws + WS_SMALL + SM_IF + (size_t)l * NTOK * 32);
    const float* DC = (const float*)(ws + WS_DC); const float* DN = (const float*)(ws + WS_SMALL + SM_DN + (size_t)l * 262144); const float* MPREV = (const float*)(ws + WS_SMALL + SM_MPREV + (size_t)l * 2048);
    bf16_t* Y = (bf16_t*)(ws + WS_Y);
    LAS float* ar = (LAS float*)(lds + OFF_AR);
    LAS bf16_t* Qc = (LAS bf16_t*)(lds + OFF_Q); LAS bf16_t* Kc = (LAS bf16_t*)(lds + OFF_K); LAS bf16_t* Vt = (LAS bf16_t*)(lds + OFF_V); LAS bf16_t* Cp = (LAS bf16_t*)(lds + OFF_C);
    for (int u = blockIdx.x; u < 512; u += gridDim.x) {
        const int b = u >> 8, hd = (u >> 6) & 3, c = u & 63, tok0 = b * SEQ + c * 128, pos0 = c * 128;
        __syncthreads();
        const float mprev = MPREV[u];
        mlstm_gates<3>(IFG, tok0, hd, mprev, ar, tid);
        if (tid >= 64 && tid < 192) ar[6 * 128 + tid - 64] = DN[u * 128 + tid - 64];
        stage_conv<false>(PROJ, C_MQ + hd * 128, p.conv_w + (size_t)l * 4096, p.conv_b + l * 1024, hd * 128, tok0, pos0, 1.f, Qc, tid);
        stage_conv<false>(PROJ, C_MK + hd * 128, p.conv_w + (size_t)l * 4096, p.conv_b + l * 1024, 512 + hd * 128, tok0, pos0, 0.08838834764831845f, Kc, tid);
        stage_vt<false>(PROJ, tok0, hd, nullptr, Vt, tid);
        { const bf16_t* cpu = cprev_slot(ws, u);
#pragma unroll
          for (int q = 0; q < 4; ++q) { const int e = (q * 512 + tid) * 8, v = e >> 7, k = e & 127; *(LAS u32x4*)(Cp + v * LP + k) = *(const u32x4*)(cpu + e); } }
        __syncthreads();
        const int tl = 16 * wid + fr;
        bf16x8 qf[4];
#pragma unroll
        for (int ks = 0; ks < 4; ++ks) qf[ks] = ldfrag((const LAS unsigned char*)(Qc + tl * LP + ks * 32 + fq * 8));
        f32x4 acc[8];
#pragma unroll
        for (int vi = 0; vi < 8; ++vi) { acc[vi] = (f32x4){0.f, 0.f, 0.f, 0.f};
#pragma unroll
            for (int ks = 0; ks < 4; ++ks) acc[vi] = mfma16(ldfrag((const LAS unsigned char*)(Cp + (16 * vi + fr) * LP + ks * 32 + fq * 8)), qf[ks], acc[vi]); }
        float deni = 0.f;
#pragma unroll
        for (int kk = 0; kk < 4; ++kk) { const u32x4 qv = *(const LAS u32x4*)(Qc + tl * LP + fq * 32 + kk * 8); const f32x4 n0 = *(const LAS f32x4*)(ar + 6 * 128 + fq * 32 + kk * 8), n1 = *(const LAS f32x4*)(ar + 6 * 128 + fq * 32 + kk * 8 + 4);
            deni += n0[0] * bflo(qv.x) + n0[1] * bfhi(qv.x) + n0[2] * bflo(qv.y) + n0[3] * bfhi(qv.y) + n1[0] * bflo(qv.z) + n1[1] * bfhi(qv.z) + n1[2] * bflo(qv.w) + n1[3] * bfhi(qv.w); }
        deni += __shfl_xor(deni, 16); deni += __shfl_xor(deni, 32);
        const float wi = ar[3 * 128 + tl], et = ar[4 * 128 + tl], emt = ar[5 * 128 + tl];
#pragma unroll
        for (int vi = 0; vi < 8; ++vi) acc[vi] *= wi;
        float den = 0.f;
        for (int sp = 0; sp <= (wid >> 1); ++sp) {
            float pv[8];
#pragma unroll
            for (int h2 = 0; h2 < 2; ++h2) { const int tile = 2 * sp + h2; f32x4 sa = (f32x4){0.f, 0.f, 0.f, 0.f};
#pragma unroll
                for (int ks = 0; ks < 4; ++ks) sa = mfma16(ldfrag((const LAS unsigned char*)(Kc + (16 * tile + fr) * LP + ks * 32 + fq * 8)), qf[ks], sa);
                const f32x4 gk = *(const LAS f32x4*)(ar + 2 * 128 + 16 * tile + 4 * fq);
#pragma unroll
                for (int r = 0; r < 4; ++r) { const int sl = 16 * tile + 4 * fq + r; const float wgt = (sl <= tl) ? __expf(et + gk[r]) : 0.f; const float pp = wgt * sa[r]; den += pp; pv[h2 * 4 + r] = pp; } }
            u32x4 pw; pw.x = cvt_pk_bf16(pv[0], pv[1]); pw.y = cvt_pk_bf16(pv[2], pv[3]); pw.z = cvt_pk_bf16(pv[4], pv[5]); pw.w = cvt_pk_bf16(pv[6], pv[7]);
            const bf16x8 pf = __builtin_bit_cast(bf16x8, pw);
#pragma unroll
            for (int vi = 0; vi < 8; ++vi) { const LAS unsigned char* vr = (const LAS unsigned char*)(Vt + (16 * vi + fr) * LP + 32 * sp + 4 * fq);
                acc[vi] = mfma16(ldfrag2(vr, vr + 32), pf, acc[vi]); }
        }
        den += __shfl_xor(den, 16); den += __shfl_xor(den, 32);
        const float dtot = wi * deni + den; const float hinv = 1.f / fmaxf(fabsf(dtot), emt);
        const size_t tokr = (size_t)(tok0 + tl);
        float ssq = 0.f;
#pragma unroll
        for (int vi = 0; vi < 8; ++vi) { const u32x2 o = *(const u32x2*)(PROJ + tokr * NPA + C_MO + hd * 128 + 16 * vi + 4 * fq);
            acc[vi][0] *= hinv * bflo(o.x); acc[vi][1] *= hinv * bfhi(o.x); acc[vi][2] *= hinv * bflo(o.y); acc[vi][3] *= hinv * bfhi(o.y);
            ssq += acc[vi][0] * acc[vi][0] + acc[vi][1] * acc[vi][1] + acc[vi][2] * acc[vi][2] + acc[vi][3] * acc[vi][3]; }
        ssq += __shfl_xor(ssq, 16); ssq += __shfl_xor(ssq, 32);
        const float rinv = rsqrtf(ssq * (1.f / 128.f) + EPSF);
#pragma unroll
        for (int vi = 0; vi < 8; ++vi) { const int vc = hd * 128 + 16 * vi + 4 * fq; const u32x2 z = *(const u32x2*)(PROJ + tokr * NPA + C_MZ + vc); const f32x4 g = *(const f32x4*)(p.m_norm_g + l * 512 + vc);
            u32x2 w; w.x = cvt_pk_bf16(acc[vi][0] * rinv * g[0] * bflo(z.x), acc[vi][1] * rinv * g[1] * bfhi(z.x)); w.y = cvt_pk_bf16(acc[vi][2] * rinv * g[2] * bflo(z.y), acc[vi][3] * rinv * g[3] * bfhi(z.y));
            st8(Y + tokr * DM + vc, w); }
    }
    __syncthreads();
}

__device__ __forceinline__ void pool_phase(const Params& p, int l, LAS unsigned char* lds, unsigned char* ws_in) {
    size_t wz_ = 0; asm volatile("" : "+s"(wz_)); unsigned char* ws = ws_in + wz_;
    int tid_ = threadIdx.x; asm volatile("" : "+v"(tid_)); const int tid = tid_; const bf16_t* PROJ = (const bf16_t*)(ws + WS_PROJ); bf16_t* Y = (bf16_t*)(ws + WS_Y);
    LAS float* U = (LAS float*)lds; LAS float* Wp = (LAS float*)(lds + 20480); LAS float* Pm = (LAS float*)(lds + 36864);
    for (int pu = blockIdx.x; pu < 1024; pu += gridDim.x) {
        const int tt = pu >> 2, g = pu & 3, tok0 = tt * 64, b = tok0 / SEQ, p0 = tok0 % SEQ, W = 2 << g;
        __syncthreads();
        for (int ch = tid; ch < 79 * 8; ch += 512) { const int row = ch >> 3, cc = (ch & 7) * 8, pos = p0 - 15 + row;
            u32x4 v = {0u, 0u, 0u, 0u}; if (pos >= 0) v = *(const u32x4*)(PROJ + (size_t)(b * SEQ + pos) * NPA + C_PU + g * 64 + cc);
            *(LAS f32x4*)(U + row * 64 + cc) = (f32x4){bflo(v.x), bfhi(v.x), bflo(v.y), bfhi(v.y)}; *(LAS f32x4*)(U + row * 64 + cc + 4) = (f32x4){bflo(v.z), bfhi(v.z), bflo(v.w), bfhi(v.w)}; }
#pragma unroll
        for (int q = 0; q < 8; ++q) Wp[q * 512 + tid] = p.pool_w[(size_t)l * 16384 + g * 4096 + q * 512 + tid];
        __syncthreads();
        const int t = tid >> 3, c0 = (tid & 7) * 8; const int cnt = min(W, p0 + t + 1); const float rc = 1.f / (float)cnt;
        { f32x4 s0 = (f32x4){0.f, 0.f, 0.f, 0.f}, s1 = s0;
          for (int j = 0; j < W; ++j) { s0 += *(const LAS f32x4*)(U + (15 + t - j) * 64 + c0); s1 += *(const LAS f32x4*)(U + (15 + t - j) * 64 + c0 + 4); }
          const f32x4 u0 = *(const LAS f32x4*)(U + (15 + t) * 64 + c0), u1 = *(const LAS f32x4*)(U + (15 + t) * 64 + c0 + 4);
#pragma unroll
          for (int e = 0; e < 4; ++e) { Pm[t * 65 + c0 + e] = s0[e] * rc - u0[e]; Pm[t * 65 + c0 + 4 + e] = s1[e] * rc - u1[e]; } }
        __syncthreads();
        float o[8];
#pragma unroll
        for (int e = 0; e < 8; ++e) o[e] = 0.f;
        for (int cc = 0; cc < 64; ++cc) { const float pv = Pm[t * 65 + cc]; const f32x4 w0 = *(const LAS f32x4*)(Wp + cc * 64 + c0), w1 = *(const LAS f32x4*)(Wp + cc * 64 + c0 + 4);
#pragma unroll
            for (int e = 0; e < 4; ++e) { o[e] += pv * w0[e]; o[4 + e] += pv * w1[e]; } }
        const size_t tok = (size_t)(tok0 + t); const u32x4 z = *(const u32x4*)(PROJ + tok * NPA + C_PZ + g * 64 + c0);
        const f32x4 s0 = *(const f32x4*)(p.pool_scale + l * 256 + g * 64 + c0), s1 = *(const f32x4*)(p.pool_scale + l * 256 + g * 64 + c0 + 4);
        u32x4 w; w.x = cvt_pk_bf16(o[0] * s0[0] * bflo(z.x), o[1] * s0[1] * bfhi(z.x)); w.y = cvt_pk_bf16(o[2] * s0[2] * bflo(z.y), o[3] * s0[3] * bfhi(z.y));
        w.z = cvt_pk_bf16(o[4] * s1[0] * bflo(z.z), o[5] * s1[1] * bfhi(z.z)); w.w = cvt_pk_bf16(o[6] * s1[2] * bflo(z.w), o[7] * s1[3] * bfhi(z.w));
        st16(Y + tok * DM + 512 + g * 64 + c0, w);
    }
    __syncthreads();
}

constexpr float SB_DEAD = -104.f * 1.4426950408889634f;
template <bool DIAG> __device__ __forceinline__ f32x4 sb_tile(const f32x4 z, int sbase, int tq, int fq, float& L) {
    float lf[4], ls[4];
#pragma unroll
    for (int r = 0; r < 4; ++r) { const float zz = z[r], l1p = __builtin_amdgcn_logf(1.f + __builtin_amdgcn_exp2f(-fabsf(zz)));
        const float lfv = -(fmaxf(zz, 0.f) + l1p), lsv = fminf(zz, 0.f) - l1p;
        if (DIAG) { const bool valid = (sbase + r) < tq; lf[r] = valid ? lfv : 0.f; ls[r] = valid ? lsv : -1.0e30f; } else { lf[r] = lfv; ls[r] = lsv; } }
    const float suf2 = lf[3], suf1 = suf2 + lf[2], suf0 = suf1 + lf[1], T = suf0 + lf[0];
    const float T16 = __shfl_down(T, 16), T32 = __shfl_down(T, 32), T48 = __shfl_down(T, 48);
    const float E = (fq < 3 ? T16 : 0.f) + (fq < 2 ? T32 : 0.f) + (fq < 1 ? T48 : 0.f);
    float Tt = T + __shfl_xor(T, 16); Tt += __shfl_xor(Tt, 32);
    const float base = L + E;
    f32x4 pv; pv[0] = __builtin_amdgcn_exp2f(ls[0] + base + suf0); pv[1] = __builtin_amdgcn_exp2f(ls[1] + base + suf1); pv[2] = __builtin_amdgcn_exp2f(ls[2] + base + suf2); pv[3] = __builtin_amdgcn_exp2f(ls[3] + base);
    L += Tt; return pv;
}
__device__ __forceinline__ void sb_phase(const Params& p, LAS unsigned char* lds, unsigned char* ws_in, int u_first, int u_end) {
    size_t wz_ = 0; asm volatile("" : "+s"(wz_)); unsigned char* ws = ws_in + wz_;
    int tid_ = threadIdx.x; asm volatile("" : "+v"(tid_)); const int tid = tid_, lane = tid & 63, wid = tid >> 6, fr = lane & 15, fq = lane >> 4;
    const bf16_t* PROJ = (const bf16_t*)(ws + WS_PROJ); bf16_t* Y = (bf16_t*)(ws + WS_Y);
    LAS bf16_t* Ks = (LAS bf16_t*)lds; LAS bf16_t* Vt = (LAS bf16_t*)(lds + 18432); LAS int* flags = (LAS int*)(lds + 36864);
    for (int u = u_first; u < u_end; u += gridDim.x) {
        const int b = u >> 8, hd = (u >> 6) & 3, qb = u & 63;
        const int tq = qb * 128 + 16 * wid + fr; const size_t tokq = (size_t)(b * SEQ + tq);
        bf16x8 qf[2];
#pragma unroll
        for (int ks = 0; ks < 2; ++ks) qf[ks] = *(const bf16x8*)(PROJ + tokq * NPA + C_SQ + hd * 64 + ks * 32 + fq * 8);
        f32x4 acc[4];
#pragma unroll
        for (int i = 0; i < 4; ++i) acc[i] = (f32x4){0.f, 0.f, 0.f, 0.f};
        float Lrun = 0.f;
        u32x4 kreg[2], vreg[2];
#pragma unroll
        for (int q = 0; q < 2; ++q) { const int row = tid & 127, d0 = ((tid >> 7) + 4 * q) * 8; const size_t tk = (size_t)(b * SEQ + qb * 128 + row);
            kreg[q] = *(const u32x4*)(PROJ + tk * NPA + C_SK + hd * 64 + d0); vreg[q] = *(const u32x4*)(PROJ + tk * NPA + C_SV + hd * 64 + d0); }
        for (int kb = qb; kb >= 0; --kb) {
            __syncthreads();
#pragma unroll
            for (int q = 0; q < 2; ++q) { const int row = tid & 127, d0 = ((tid >> 7) + 4 * q) * 8;
                *(LAS u32x4*)(Ks + row * 72 + d0) = kreg[q];
                const unsigned wv[4] = {vreg[q].x, vreg[q].y, vreg[q].z, vreg[q].w};
#pragma unroll
                for (int e = 0; e < 4; ++e) { Vt[(d0 + 2 * e) * LP + row] = (bf16_t)(wv[e] & 0xffffu); Vt[(d0 + 2 * e + 1) * LP + row] = (bf16_t)(wv[e] >> 16); } }
            if (kb > 0) {
#pragma unroll
                for (int q = 0; q < 2; ++q) { const int row = tid & 127, d0 = ((tid >> 7) + 4 * q) * 8; const size_t tk = (size_t)(b * SEQ + (kb - 1) * 128 + row);
                    kreg[q] = *(const u32x4*)(PROJ + tk * NPA + C_SK + hd * 64 + d0); vreg[q] = *(const u32x4*)(PROJ + tk * NPA + C_SV + hd * 64 + d0); } }
            if (tid < 8) flags[tid] = 0;
            __syncthreads();
            const bool walive = __ballot(Lrun >= SB_DEAD) != 0ull;
            if (walive) {
                const int sp_hi = (kb == qb) ? (wid >> 1) : 3;
                for (int sp = sp_hi; sp >= 0; --sp) {
                    if (__ballot(Lrun >= SB_DEAD) == 0ull) break;
                    f32x4 pvv[2];
#pragma unroll
                    for (int h2 = 1; h2 >= 0; --h2) { const int tile = 2 * sp + h2;
                        f32x4 z = (f32x4){0.f, 0.f, 0.f, 0.f};
#pragma unroll
                        for (int ks = 0; ks < 2; ++ks) z = mfma16(ldfrag((const LAS unsigned char*)(Ks + (16 * tile + fr) * 72 + ks * 32 + fq * 8)), qf[ks], z);
                        const int sbase = kb * 128 + 16 * tile + 4 * fq;
                        pvv[h2] = (kb == qb) ? sb_tile<true>(z, sbase, tq, fq, Lrun) : sb_tile<false>(z, sbase, tq, fq, Lrun); }
                    const float pv[8] = {pvv[0][0], pvv[0][1], pvv[0][2], pvv[0][3], pvv[1][0], pvv[1][1], pvv[1][2], pvv[1][3]};
                    u32x4 pw; pw.x = cvt_pk_bf16(pv[0], pv[1]); pw.y = cvt_pk_bf16(pv[2], pv[3]); pw.z = cvt_pk_bf16(pv[4], pv[5]); pw.w = cvt_pk_bf16(pv[6], pv[7]);
                    const bf16x8 pf = __builtin_bit_cast(bf16x8, pw);
#pragma unroll
                    for (int i = 0; i < 4; ++i) { const LAS unsigned char* vr = (const LAS unsigned char*)(Vt + (16 * i + fr) * LP + 32 * sp + 4 * fq);
                        acc[i] = mfma16(ldfrag2(vr, vr + 32), pf, acc[i]); }
                }
            }
            const bool still = __ballot(Lrun >= SB_DEAD) != 0ull;
            if (lane == 0 && still) flags[wid] = 1;
            __syncthreads();
            int any = 0;
#pragma unroll
            for (int i = 0; i < 8; ++i) any |= flags[i];
            if (!any) break;
        }
#pragma unroll
        for (int i = 0; i < 4; ++i) { const int dc = hd * 64 + 16 * i + 4 * fq; const u32x2 z = *(const u32x2*)(PROJ + tokq * NPA + C_SZ + dc);
            u32x2 w; w.x = cvt_pk_bf16(acc[i][0] * bflo(z.x), acc[i][1] * bfhi(z.x)); w.y = cvt_pk_bf16(acc[i][2] * bflo(z.y), acc[i][3] * bfhi(z.y));
            st8(Y + tokq * DM + 768 + dc, w); }
    }
    __syncthreads();
}

__device__ __forceinline__ void final_norm(const Params& p) {
    int tid_ = threadIdx.x; asm volatile("" : "+v"(tid_)); const int tid = tid_, lane = tid & 63, wid = tid >> 6;
    const int stride = gridDim.x * 8; int row = blockIdx.x * 8 + wid;
    f32x4 g[4];
#pragma unroll
    for (int j = 0; j < 4; ++j) g[j] = *(const f32x4*)(p.final_g + j * 256 + lane * 4);
    f32x4 xn[4];
    if (row < NTOK) {
#pragma unroll
        for (int j = 0; j < 4; ++j) xn[j] = *(const f32x4*)(p.out + (size_t)row * DM + j * 256 + lane * 4); }
    for (; row < NTOK; row += stride) {
        float* xr = p.out + (size_t)row * DM; f32x4 xv[4]; float ss = 0.f;
#pragma unroll
        for (int j = 0; j < 4; ++j) { xv[j] = xn[j]; ss += xv[j][0] * xv[j][0] + xv[j][1] * xv[j][1] + xv[j][2] * xv[j][2] + xv[j][3] * xv[j][3]; }
        if (row + stride < NTOK) {
#pragma unroll
            for (int j = 0; j < 4; ++j) xn[j] = *(const f32x4*)(p.out + (size_t)(row + stride) * DM + j * 256 + lane * 4); }
        ss = wave_sum(ss); const float rstd = rsqrtf(ss * (1.f / 1024.f) + EPSF);
#pragma unroll
        for (int j = 0; j < 4; ++j) *(f32x4*)(xr + j * 256 + lane * 4) = xv[j] * rstd * g[j];
    }
}

#define XB_TMO      128
#define XB_XCNT(j)  (256  + 64 * (j))
#define XB_XSUB(j)  (1280 + 64 * (j))
#define XB_XGEN(j)  (2304 + 64 * (j))
#define XB_TOP      3328
#define XB_TOPGEN   3392
#define XCD_BAR_WORDS 3456
#define XB_SPIN_CAP (1u << 18)

__device__ __forceinline__ unsigned xb_ld(unsigned* p)              { return __hip_atomic_load(p, __ATOMIC_RELAXED, __HIP_MEMORY_SCOPE_AGENT); }
__device__ __forceinline__ unsigned xb_add(unsigned* p, unsigned v) { return __hip_atomic_fetch_add(p, v, __ATOMIC_RELAXED, __HIP_MEMORY_SCOPE_AGENT); }
__device__ __forceinline__ unsigned xb_xcc_id() { return (unsigned)__builtin_amdgcn_s_getreg((3 << 11) | 20) & 0xFu; }
#define XB_SPIN(cond, bar) do { unsigned _sp = 0; while (cond) { __builtin_amdgcn_s_sleep(1); \
    if ((++_sp & 255u) == 0u) { if (xb_ld(&(bar)[XB_TMO])) break; if (_sp > XB_SPIN_CAP) { atomicAdd(&(bar)[XB_TMO], 1u); break; } } } } while (0)

struct XcdBarrier {
    unsigned* bar; unsigned x;
    volatile LAS unsigned* st;
};

__device__ __forceinline__ XcdBarrier xcd_barrier_post(unsigned* bar, volatile LAS unsigned* st) {
    XcdBarrier b; b.bar = bar; b.x = xb_xcc_id(); b.st = st;
    if (threadIdx.x == 0) (void)xb_add(&bar[XB_XCNT(b.x)], 1u);
    return b;
}
__device__ __forceinline__ void xcd_barrier_complete(unsigned* bar, unsigned x, unsigned& nloc, unsigned& nx) {
    const unsigned G = gridDim.x * gridDim.y * gridDim.z;
    unsigned sum, cnt, mine, sp = 0u;
    for (;;) {
        sum = 0u; cnt = 0u; mine = 0u;
#pragma unroll
        for (unsigned j = 0; j < 16; ++j) { const unsigned c = xb_ld(&bar[XB_XCNT(j)]); sum += c; cnt += (c > 0u) ? 1u : 0u; mine = (j == x) ? c : mine; }
        if (sum == G) break;
        __builtin_amdgcn_s_sleep(1);
        if ((++sp & 255u) == 0u) { if (xb_ld(&bar[XB_TMO])) break; if (sp > XB_SPIN_CAP) { atomicAdd(&bar[XB_TMO], 1u); break; } }
    }
    nloc = mine > 0u ? mine : 1u; nx = cnt > 0u ? cnt : 1u;
}

__device__ __forceinline__ void xcd_barrier(const XcdBarrier& b) {
    asm volatile("s_waitcnt vmcnt(0)" ::: "memory");
    __syncthreads();
    if (threadIdx.x == 0) {
        unsigned* bar = b.bar;
        __builtin_amdgcn_s_waitcnt(0);
        unsigned nloc = b.st[0], nx = b.st[1];
        if (nloc == 0u) { xcd_barrier_complete(bar, b.x, nloc, nx); b.st[0] = nloc; b.st[1] = nx; }
        const unsigned old = xb_add(&bar[XB_XSUB(b.x)], 1u);
        const unsigned gen = old / nloc;
        if (old + 1u == (gen + 1u) * nloc) {
            __builtin_amdgcn_fence(__ATOMIC_RELEASE, "agent");
            asm volatile("s_waitcnt vmcnt(0)" ::: "memory");
            const unsigned og = xb_add(&bar[XB_TOP], 1u);
            const unsigned tg = og / nx;
            if (og + 1u == (tg + 1u) * nx) xb_add(&bar[XB_TOPGEN], 1u);
            else XB_SPIN(xb_ld(&bar[XB_TOPGEN]) == tg, bar);
            __builtin_amdgcn_fence(__ATOMIC_ACQUIRE, "agent");
            xb_add(&bar[XB_XGEN(b.x)], 1u);
            asm volatile("s_waitcnt vmcnt(0)" ::: "memory");
        } else {
            XB_SPIN(xb_ld(&bar[XB_XGEN(b.x)]) == gen, bar);
            __builtin_amdgcn_fence(__ATOMIC_ACQUIRE, "agent");
            asm volatile("s_waitcnt vmcnt(0)" ::: "memory");
        }
    }
    __syncthreads();
}

constexpr int N_PHASES = 16;
__global__ void __launch_bounds__(512, 2) mk_fwd(Params p) {
    extern __shared__ __attribute__((aligned(16))) unsigned char lds_raw[];
    LAS unsigned char* lds = (LAS unsigned char*)lds_raw;
    cg::grid_group grid = cg::this_grid();
#define GSYNC_CG() do { asm volatile("s_waitcnt vmcnt(0) lgkmcnt(0)" ::: "memory"); __syncthreads(); \
        if (threadIdx.x < 64) { __builtin_amdgcn_fence(__ATOMIC_RELEASE, "agent"); asm volatile("s_waitcnt vmcnt(0)" ::: "memory"); } \
        grid.sync(); \
        if (threadIdx.x < 64) { __builtin_amdgcn_fence(__ATOMIC_ACQUIRE, "agent"); asm volatile("s_waitcnt vmcnt(0)" ::: "memory"); } \
        __syncthreads(); } while (0)
    const bool one_launch = (p.ph_hi - p.ph_lo == N_PHASES);
    volatile LAS unsigned* xst = (volatile LAS unsigned*)(lds + LDS_BYTES - 64);
    if (threadIdx.x == 0) { xst[0] = 0u; xst[1] = 0u; }
    __syncthreads();
    XcdBarrier xbar; xbar.bar = (unsigned*)(p.ws + WS_SMALL + SM_XBAR); xbar.x = 0; xbar.st = xst;
    if (one_launch) {
        if (blockIdx.x == 0) { unsigned* cw = (unsigned*)(p.ws + WS_SMALL + SM_XBAR); for (int i = threadIdx.x; i < (int)(XBAR_BYTES / 4); i += 512) cw[i] = 0u; }
        asm volatile("s_waitcnt vmcnt(0)" ::: "memory"); __syncthreads();
        if (threadIdx.x < 64) { __builtin_amdgcn_fence(__ATOMIC_RELEASE, "agent"); asm volatile("s_waitcnt vmcnt(0)" ::: "memory"); }
        grid.sync();
        if (threadIdx.x < 64) { __builtin_amdgcn_fence(__ATOMIC_ACQUIRE, "agent"); asm volatile("s_waitcnt vmcnt(0)" ::: "memory"); }
        __syncthreads();
        xbar = xcd_barrier_post((unsigned*)(p.ws + WS_SMALL + SM_XBAR), xst);
    }
#define GSYNC() do { if (one_launch) xcd_barrier(xbar); else GSYNC_CG(); } while (0)
#pragma unroll 1
    for (int ph = p.ph_lo; ph < p.ph_hi; ++ph) {
        if (ph == 0) { phase_mod(p, (float*)(p.ws + WS_SMALL + SM_MODP)); }
        else if (ph == N_PHASES - 1) { if (gridDim.x != 256) final_norm(p); }
        else {
        int l = (ph - 1) / 7, k = (ph - 1) % 7; asm volatile("" : "+s"(l), "+s"(k));
        const float* xin = (l == 0) ? p.x : p.out;
        int G = gridDim.x, bx = blockIdx.x; asm volatile("" : "+s"(G), "+s"(bx));
        size_t wz_ = 0; asm volatile("" : "+s"(wz_)); unsigned char* ws = p.ws + wz_;
        if (k == 0) { phase_prep(p, l, xin, lds, ws); }
        else if (k == 1) {
        {
            pg8::Gemm g{(const bf16_t*)(ws + WS_H), (const bf16_t*)(ws + WS_WIN), NTOK, NPA, DM, DM, DM}; pg8::StaticOrder S; S.init(NTOK, NPA, G, bx);
            EpiProj E{(bf16_t*)(ws + WS_PROJ), NPA, 0}; NoHook HK; f32x4 acc[2][2][4][2];
            pg8::gemm_phase<EpiProj, pg8::StaticOrder, NoHook, true, true>(lds, g, S, E, HK, acc);
        }
        }
        else if (k == 2) { mlstm_m1(p, l, lds, ws); pool_phase(p, l, lds, ws); }
        else if (k == 3) {
            if (G == 256) {
                int tx_ = threadIdx.x; asm volatile("" : "+v"(tx_)); const int idx = bx * 512 + tx_;
                float dcv[64]; scan_load(dcv, ws, idx);
                sb_phase(p, lds, ws, bx, 256);
                scan_finish(dcv, l, ws, idx);
                mlstm_scan_n(l, ws);
                sb_phase(p, lds, ws, 256 + bx, 512);
            } else { mlstm_scan(l, ws); mlstm_scan_n(l, ws); sb_phase(p, lds, ws, bx, 512); }
        }
        else if (k == 4) { mlstm_m3(p, l, lds, ws); }
        else if (k == 5) {
        {
            pg8::StaticOrder S; S.init(NTOK, DM, G, bx); pg8::Unit u; NoHook HK; f32x4 acc[2][2][4][2];
            const bf16_t* Gp = (const bf16_t*)(ws + WS_G); const bf16_t* Yp = (const bf16_t*)(ws + WS_Y); const bf16_t* Wb = (const bf16_t*)(ws + WS_WBR);
            for (int i = 0; S.next(i, u); ++i) {
                { pg8::Gemm g{(const bf16_t*)(ws + WS_H), (const bf16_t*)(ws + WS_WIN) + (size_t)NPA * 1024, NTOK, NG, DM, DM, DM}; GateOrder GO{u.pm, u.pn};
                  EpiProj E{(bf16_t*)(ws + WS_G), NG, 1};
                  pg8::gemm_phase<EpiProj, GateOrder, NoHook, true, true>(lds, g, GO, E, HK, acc); }
                __syncthreads();
                OneUnit OU{u.pm, u.pn}; EpiNone EN;
                { pg8::Gemm g{Yp, Wb, NTOK, DM, 512, DM, DM};
                  pg8::gemm_phase<EpiNone, OneUnit, NoHook, false, true, true>(lds, g, OU, EN, HK, acc); }
                gate_rescale(acc, Gp, p.gate_b + l * NG, u.pm, u.pn, 0); __syncthreads();
                { pg8::Gemm g{Yp + 512, Wb + 512, NTOK, DM, 256, DM, DM};
                  pg8::gemm_phase<EpiNone, OneUnit, NoHook, false, true, false>(lds, g, OU, EN, HK, acc); }
                gate_rescale(acc, Gp, p.gate_b + l * NG, u.pm, u.pn, 1024); __syncthreads();
                { pg8::Gemm g{Yp + 768, Wb + 768, NTOK, DM, 256, DM, DM}; EpiMerge E{(bf16_t*)(ws + WS_MERGED), Gp, p.gate_b + l * NG};
                  pg8::gemm_phase<EpiMerge, OneUnit, NoHook, false, true, false>(lds, g, OU, E, HK, acc); }
                __syncthreads();
            }
        }
        }
        else {
        {
            pg8::Gemm g{(const bf16_t*)(ws + WS_MERGED), (const bf16_t*)(ws + WS_WOUT), NTOK, DM, DM, DM, DM}; pg8::StaticOrder S; S.init(NTOK, DM, G, bx); pg8::Unit u;
            NoHook HK; f32x4 acc[2][2][4][2];
            if (l == 1 && G == 256) {
                EpiOutNorm E{xin, p.out, (const float*)(ws + WS_SMALL + SM_GATEV) + l * 2048, p.final_g, (unsigned long long*)(ws + WS_SMALL + SM_XEX), (unsigned*)(ws + WS_SMALL + SM_XBAR + 16384)};
                for (int i = 0; S.next(i, u); ++i) { OneUnit OU{u.pm, u.pn};
                    pg8::gemm_phase<EpiOutNorm, OneUnit, NoHook, false, true>(lds, g, OU, E, HK, acc); __syncthreads(); }
            } else {
                EpiOut E{xin, p.out, (const float*)(ws + WS_SMALL + SM_GATEV) + l * 2048};
                for (int i = 0; S.next(i, u); ++i) { OneUnit OU{u.pm, u.pn};
                    pg8::gemm_phase<EpiOut, OneUnit, NoHook, false, true>(lds, g, OU, E, HK, acc); __syncthreads(); }
            }
        }
        }
        }
        if (ph + 1 < p.ph_hi && !(gridDim.x == 256 && ph == N_PHASES - 2)) GSYNC();
    }
}

extern "C" void kernel_launch(void* const* d_in, const int* in_sizes, int n_in, void* d_out, int out_size, void* d_ws, size_t ws_size, hipStream_t stream) {
    static int grid_blocks = 0;
    if (grid_blocks == 0) {
        int dev = 0, cus = 0, per_cu = 0;
        if (n_in != 18 || out_size != NTOK * DM || ws_size < WS_SMALL + SM_END) { fprintf(stderr, "kernel_launch: unexpected shapes (n_in %d out %d ws %zu)\n", n_in, out_size, ws_size); grid_blocks = -1; return; }
        hipGetDevice(&dev); hipDeviceGetAttribute(&cus, hipDeviceAttributeMultiprocessorCount, dev);
        if (hipFuncSetAttribute((const void*)mk_fwd, hipFuncAttributeMaxDynamicSharedMemorySize, LDS_BYTES) != hipSuccess) { fprintf(stderr, "kernel_launch: hipFuncSetAttribute failed\n"); }
        if (hipOccupancyMaxActiveBlocksPerMultiprocessor(&per_cu, (const void*)mk_fwd, 512, LDS_BYTES) != hipSuccess || per_cu < 1) { fprintf(stderr, "kernel_launch: occupancy query gave %d\n", per_cu); per_cu = 1; }
        (void)hipGetLastError();
        grid_blocks = cus * per_cu;
    }
    if (grid_blocks < 0) return;
    Params p{};
    const float** f = (const float**)&p;
    for (int i = 0; i < 18; ++i) f[i] = (const float*)d_in[i];
    p.out = (float*)d_out; p.ws = (unsigned char*)d_ws;
#ifndef MK_PHASES_PER_LAUNCH
#define MK_PHASES_PER_LAUNCH N_PHASES
#endif
    if constexpr (MK_PHASES_PER_LAUNCH != N_PHASES) (void)hipMemsetAsync((unsigned char*)d_ws + WS_SMALL + SM_XBAR, 0, XBAR_BYTES, stream);
    for (int lo = 0; lo < N_PHASES; lo += MK_PHASES_PER_LAUNCH) {
        p.ph_lo = lo; p.ph_hi = lo + MK_PHASES_PER_LAUNCH < N_PHASES ? lo + MK_PHASES_PER_LAUNCH : N_PHASES;
        void* args[] = {&p};
        hipError_t e = hipLaunchCooperativeKernel((const void*)mk_fwd, dim3(grid_blocks), dim3(512), args, LDS_BYTES, stream);
        if (e != hipSuccess) { fprintf(stderr, "cooperative launch failed: %s (grid %d)\n", hipGetErrorString(e), grid_blocks); break; }
    }
}
```

```cpp
#include <hip/hip_runtime.h>
#include <hip/hip_cooperative_groups.h>
#include <cstdio>
#include <cstdint>
#include <cstddef>
namespace cg = cooperative_groups;
namespace pg8 {
#define PG8_LAS __attribute__((address_space(3)))
typedef unsigned short bf16_t;
typedef short bf16x8 __attribute__((ext_vector_type(8)));
typedef float f32x4 __attribute__((ext_vector_type(4)));
typedef unsigned u32x4 __attribute__((ext_vector_type(4)));
constexpr int BM = 256, BK = 64, HALF = 128, HTB = HALF * BK * 2  , STAGE_BYTES = 8 * HTB, NXCD = 8, WGM = 8;

__host__ __device__ __forceinline__ int lds_byte(int r, int c) { const int st = (r >> 4) * 2 + (c >> 5), rr = r & 15, cc = c & 31, ob = rr * 64 + cc * 2; return st * 1024 + (ob ^ (((ob >> 9) & 1) << 5)); }
__host__ __device__ __forceinline__ void stage_rc(int b, int& R, int& C) { const int st = b / 1024, sb = b % 1024, swz = sb ^ (((sb >> 9) & 1) << 5); R = (st >> 1) * 16 + swz / 64; C = (st & 1) * 32 + (swz % 64) / 2; }
__host__ __device__ __forceinline__ int perm32(int rho) { const int n = rho >> 4, i = rho & 15; return 8 * (i >> 2) + 4 * n + (i & 3); }

struct Unit { int pm, pn; };
struct Gemm { const bf16_t* A; const bf16_t* Bt; int M, N, K, lda, ldb; };

struct StaticOrder {
    int nM, nN, nwg, G, c;
    __host__ __device__ void init(int M, int N, int G_, int c_) { nM = M / BM; nN = N / BM; nwg = nM * nN; G = G_; c = c_; }
    __host__ __device__ bool next(int i, Unit& u) const {
        const long L = (long)i * G + c; if (L >= nwg) return false;
        int wgid = (int)L; { const int q = nwg / NXCD, r = nwg % NXCD, xcd = wgid % NXCD, off = wgid / NXCD; wgid = (xcd < r ? xcd * (q + 1) : r * (q + 1) + (xcd - r) * q) + off; }
        const int nig = WGM * nN, gid = wgid / nig, fm = gid * WGM, gsz = (nM - fm) < WGM ? (nM - fm) : WGM;
        u.pm = fm + ((wgid % nig) % gsz); u.pn = (wgid % nig) / gsz; return true;
    }
    __device__ __forceinline__ void a_ready(const Unit&) const {}
    __device__ __forceinline__ void done(const Unit&) const {}
};

__device__ __forceinline__ unsigned cvt_pk_bf16(float lo, float hi) { unsigned r; asm volatile("v_cvt_pk_bf16_f32 %0, %1, %2" : "=v"(r) : "v"(lo), "v"(hi)); return r; }
template <class Epi, class Sched, class Hook, bool ALIGN_EPI = false, bool SP2 = false, bool ZERO_ACC = true>
__device__ __forceinline__ void gemm_phase(PG8_LAS unsigned char* lds, const Gemm g, const Sched& S, const Epi& E, const Hook& HK, f32x4 (&acc)[2][2][4][2]) {
    int tid_ = threadIdx.x; asm volatile("" : "+v"(tid_));
    const int tid = tid_, wid = __builtin_amdgcn_readfirstlane(tid >> 6), lane = tid & 63, wr = wid >> 2, wc = wid & 3, fr = lane & 15, fq = lane >> 4;
    const int K = g.K, nt = K / BK;
    unsigned voffA[2], voffB[2];
#pragma unroll
    for (int i = 0; i < 2; ++i) { int R, C; stage_rc(tid * 16 + i * 8192, R, C); const int Rb = Epi::PERM ? ((R & ~31) + perm32(R & 31)) : R;
        voffA[i] = (unsigned)(R * g.lda + C) * 2u; voffB[i] = (unsigned)(Rb * g.ldb + C) * 2u; }
    const size_t kstep = (size_t)(BK * 2);
    const size_t hstepA = (size_t)HALF * g.lda * 2, hstepB = (size_t)HALF * g.ldb * 2;
    const size_t tstepA = 2 * hstepA, tstepB = 2 * hstepB;
    const unsigned ldsw = (unsigned)wid * 1024u;
    const int aoff = lds_byte(wr * 64 + fr, fq * 8), boff = lds_byte(wc * 32 + fr, fq * 8);
#define PG8_SA(b, h) (((b) * 2 + (h)) * HTB)
#define PG8_SB(b, h) ((4 + (b) * 2 + (h)) * HTB)
#define PG8_STAGE(bufoff, gbase, voff) do { _Pragma("unroll") for (int _i = 0; _i < 2; ++_i) \
        __builtin_amdgcn_global_load_lds((const unsigned*)((const char*)(gbase) + (voff)[_i]), (PG8_LAS unsigned*)(lds + (bufoff) + ldsw + _i * 8192), 16, 0, 0); } while (0)
#define PG8_LDA(dst, b, h) do { _Pragma("unroll") for (int m = 0; m < 4; ++m) _Pragma("unroll") for (int k = 0; k < 2; ++k) dst[m][k] = *(const PG8_LAS bf16x8*)(lds + PG8_SA(b, h) + aoff + m * 2048 + k * 1024); } while (0)
#define PG8_LDB(dst, b, h) do { _Pragma("unroll") for (int n = 0; n < 2; ++n) _Pragma("unroll") for (int k = 0; k < 2; ++k) dst[n][k] = *(const PG8_LAS bf16x8*)(lds + PG8_SB(b, h) + boff + n * 2048 + k * 1024); } while (0)
#define PG8_MMA(ai, bj, At, Bt) do { __builtin_amdgcn_s_setprio(1); _Pragma("unroll") for (int m = 0; m < 4; ++m) _Pragma("unroll") for (int n = 0; n < 2; ++n) _Pragma("unroll") for (int k = 0; k < 2; ++k) \
        acc[ai][bj][m][n] = __builtin_amdgcn_mfma_f32_16x16x32_bf16(Bt[n][k], At[m][k], acc[ai][bj][m][n], 0, 0, 0); __builtin_amdgcn_s_setprio(0); } while (0)
#define PG8_WAIT_V(n) asm volatile("s_waitcnt vmcnt(" #n ")" ::: "memory")
#define PG8_WAIT_L(n) asm volatile("s_waitcnt lgkmcnt(" #n ")" ::: "memory")
#define PG8_BAR __builtin_amdgcn_s_barrier()
#define PG8_SCHED __builtin_amdgcn_sched_barrier(0)
    Unit cur, nxt; int ui = 0;
    if (!S.next(0, cur)) return;
    if constexpr (ZERO_ACC) {
#pragma unroll
    for (int a = 0; a < 2; ++a)
#pragma unroll
        for (int b = 0; b < 2; ++b)
#pragma unroll
            for (int m = 0; m < 4; ++m)
#pragma unroll
                for (int n = 0; n < 2; ++n) acc[a][b][m][n] = (f32x4){0.f, 0.f, 0.f, 0.f};
    }
    bf16x8 At[4][2], B0[2][2], B1[2][2];
    const char* cA = (const char*)g.A + (size_t)cur.pm * tstepA; const char* cB = (const char*)g.Bt + (size_t)cur.pn * tstepB;
    S.a_ready(cur);
    if constexpr (SP2) {
        PG8_STAGE(PG8_SB(0, 0), cB, voffB); PG8_STAGE(PG8_SB(0, 1), cB + hstepB, voffB); PG8_STAGE(PG8_SA(0, 0), cA, voffA); PG8_STAGE(PG8_SA(0, 1), cA + hstepA, voffA);
        if (wr == 1) PG8_BAR;
        PG8_WAIT_V(2); PG8_BAR;
        PG8_STAGE(PG8_SB(1, 0), cB + kstep, voffB); PG8_STAGE(PG8_SA(1, 0), cA + kstep, voffA); PG8_STAGE(PG8_SB(1, 1), cB + hstepB + kstep, voffB);
        PG8_WAIT_V(6); PG8_BAR;
    } else {
        PG8_STAGE(PG8_SB(0, 0), cB, voffB); PG8_STAGE(PG8_SA(0, 0), cA, voffA); PG8_STAGE(PG8_SB(0, 1), cB + hstepB, voffB); PG8_STAGE(PG8_SA(0, 1), cA + hstepA, voffA);
        if (wr == 1) PG8_BAR;
        PG8_WAIT_V(4); PG8_BAR;
        PG8_STAGE(PG8_SB(1, 0), cB + kstep, voffB); PG8_STAGE(PG8_SA(1, 0), cA + kstep, voffA); PG8_STAGE(PG8_SB(1, 1), cB + hstepB + kstep, voffB);
        PG8_WAIT_V(6); PG8_BAR;
    }
    for (;;) {
        const bool has_next = S.next(ui + 1, nxt);
        const char* nA = has_next ? (const char*)g.A + (size_t)nxt.pm * tstepA : cA; const char* nB = has_next ? (const char*)g.Bt + (size_t)nxt.pn * tstepB : cB;
#pragma nounroll
        for (int t = 0; t < nt; t += 2) {
            const bool last = (t == nt - 2);
            if constexpr (Hook::ON) { if (t == Hook::T1 || t == Hook::T2) HK(acc, cur, t, wr, wc, fr, fq); }
            const char* a1 = cA + (size_t)(t + 1) * kstep;
            const char* a2 = last ? nA : cA + (size_t)(t + 2) * kstep; const char* b2 = last ? nB : cB + (size_t)(t + 2) * kstep;
            const char* a3 = a2 + kstep; const char* b3 = b2 + kstep;
            if (last && has_next) S.a_ready(nxt);
            if constexpr (SP2) {
            PG8_LDB(B0, 0, 0); PG8_LDB(B1, 0, 1); PG8_SCHED; PG8_LDA(At, 0, 0); PG8_STAGE(PG8_SA(1, 1), a1 + hstepA, voffA);
            PG8_WAIT_V(8); PG8_WAIT_L(0); PG8_BAR; PG8_MMA(0, 0, At, B0); PG8_MMA(0, 1, At, B1); PG8_BAR; PG8_SCHED;
            PG8_LDA(At, 0, 1); PG8_STAGE(PG8_SB(0, 0), b2, voffB); PG8_STAGE(PG8_SB(0, 1), b2 + hstepB, voffB); PG8_STAGE(PG8_SA(0, 0), a2, voffA);
            PG8_WAIT_V(8); PG8_WAIT_L(0); PG8_BAR; PG8_MMA(1, 0, At, B0); PG8_MMA(1, 1, At, B1); PG8_BAR; PG8_SCHED;
            PG8_LDB(B0, 1, 0); PG8_LDB(B1, 1, 1); PG8_SCHED; PG8_LDA(At, 1, 0); PG8_STAGE(PG8_SA(0, 1), a2 + hstepA, voffA);
            PG8_WAIT_V(8); PG8_WAIT_L(0); PG8_BAR; PG8_MMA(0, 0, At, B0); PG8_MMA(0, 1, At, B1); PG8_BAR; PG8_SCHED;
            PG8_LDA(At, 1, 1); PG8_STAGE(PG8_SB(1, 0), b3, voffB); PG8_STAGE(PG8_SB(1, 1), b3 + hstepB, voffB); PG8_STAGE(PG8_SA(1, 0), a3, voffA);
            PG8_WAIT_V(8); PG8_WAIT_L(0); PG8_BAR; PG8_MMA(1, 0, At, B0); PG8_MMA(1, 1, At, B1); PG8_BAR; PG8_SCHED;
            } else {
            PG8_LDB(B0, 0, 0); PG8_SCHED; PG8_LDA(At, 0, 0); PG8_STAGE(PG8_SA(1, 1), a1 + hstepA, voffA);
            PG8_WAIT_L(8); PG8_BAR; PG8_WAIT_L(0); PG8_MMA(0, 0, At, B0); PG8_BAR; PG8_SCHED;
            PG8_LDB(B1, 0, 1); PG8_STAGE(PG8_SB(0, 0), b2, voffB);
            PG8_BAR; PG8_WAIT_L(0); PG8_MMA(0, 1, At, B1); PG8_BAR;
            PG8_LDA(At, 0, 1); PG8_STAGE(PG8_SA(0, 0), a2, voffA);
            PG8_BAR; PG8_WAIT_L(0); PG8_MMA(1, 0, At, B0); PG8_BAR; PG8_SCHED;
            PG8_STAGE(PG8_SB(0, 1), b2 + hstepB, voffB);
            PG8_WAIT_V(6); PG8_BAR; PG8_MMA(1, 1, At, B1); PG8_BAR;
            PG8_LDB(B0, 1, 0); PG8_SCHED; PG8_LDA(At, 1, 0); PG8_STAGE(PG8_SA(0, 1), a2 + hstepA, voffA);
            PG8_WAIT_L(8); PG8_BAR; PG8_WAIT_L(0); PG8_MMA(0, 0, At, B0); PG8_BAR; PG8_SCHED;
            PG8_LDB(B1, 1, 1); PG8_STAGE(PG8_SB(1, 0), b3, voffB);
            PG8_BAR; PG8_WAIT_L(0); PG8_MMA(0, 1, At, B1); PG8_BAR;
            PG8_LDA(At, 1, 1); PG8_STAGE(PG8_SA(1, 0), a3, voffA);
            PG8_BAR; PG8_WAIT_L(0); PG8_MMA(1, 0, At, B0); PG8_BAR; PG8_SCHED;
            PG8_STAGE(PG8_SB(1, 1), b3 + hstepB, voffB);
            PG8_WAIT_V(6); PG8_BAR; PG8_MMA(1, 1, At, B1); PG8_BAR;
            }
        }
        if constexpr (ALIGN_EPI) { if (wr == 0) PG8_BAR; }
        if constexpr (!Epi::AFTER_DRAIN) { E(acc, cur, wr, wc, fr, fq); S.done(cur); }
        if (!has_next) break;
#pragma unroll
        for (int a = 0; a < 2; ++a)
#pragma unroll
            for (int b = 0; b < 2; ++b)
#pragma unroll
                for (int m = 0; m < 4; ++m)
#pragma unroll
                    for (int n = 0; n < 2; ++n) acc[a][b][m][n] = (f32x4){0.f, 0.f, 0.f, 0.f};
        cur = nxt; cA = nA; cB = nB; ++ui;
        if constexpr (ALIGN_EPI) { if (wr == 1) PG8_BAR; }
    }
    PG8_WAIT_V(0);
    if constexpr (!ALIGN_EPI) { if (wr == 0) PG8_BAR; }
    PG8_BAR;
    if constexpr (Epi::AFTER_DRAIN) { E.fused(acc, cur, wr, wc, fr, fq, lds, wid, lane); S.done(cur); }
#undef PG8_SA
#undef PG8_SB
#undef PG8_STAGE
#undef PG8_LDA
#undef PG8_LDB
#undef PG8_MMA
#undef PG8_WAIT_V
#undef PG8_WAIT_L
#undef PG8_BAR
#undef PG8_SCHED
}
}
#define LAS __attribute__((address_space(3)))
typedef unsigned short bf16_t;
typedef short bf16x8 __attribute__((ext_vector_type(8)));
typedef float f32x4 __attribute__((ext_vector_type(4)));
typedef unsigned u32x4 __attribute__((ext_vector_type(4)));
typedef unsigned u32x2 __attribute__((ext_vector_type(2)));
using pg8::cvt_pk_bf16;

constexpr int NTOK = 16384, DM = 1024, SEQ = 8192, NIN = 7176;
constexpr int NPA = 4096;
constexpr int NG = 3072;
constexpr float EPSF = 1e-6f;
constexpr int C_MQ = 0, C_MK = 512, C_MV = 1024, C_MO = 1536, C_MZ = 2048, C_PU = 2560, C_PZ = 2816, C_SQ = 3072, C_SK = 3328, C_SV = 3584, C_SZ = 3840;
constexpr size_t MiB = 1u << 20;
constexpr size_t WS_WIN = 0, WS_WBR = 14 * MiB, WS_WOUT = 16 * MiB, WS_H = 18 * MiB, WS_Y = 50 * MiB, WS_PROJ = 82 * MiB, WS_G = 82 * MiB, WS_MERGED = 178 * MiB,
                 WS_DC = 210 * MiB, WS_SMALL = 242 * MiB;
constexpr size_t SM_MODP = 0;
constexpr size_t SM_GATEV = SM_MODP + 2 * 16 * 2 * 3072 * 4;
constexpr size_t SM_IF = SM_GATEV + 2 * 2 * 1024 * 4;
constexpr size_t SM_DN = SM_IF + 2 * (size_t)NTOK * 8 * 4;
constexpr size_t SM_BEND = SM_DN + 2 * 512 * 128 * 4;
constexpr size_t SM_AMAX = SM_BEND + 4;
constexpr size_t SM_MPREV = SM_BEND + 2 * 512 * 128;
constexpr size_t SM_CPB = (SM_MPREV + 2 * 512 * 4 + 255) & ~(size_t)255;
constexpr size_t SM_XBAR = SM_CPB + (size_t)256 * 32768;
constexpr size_t XBAR_BYTES = 32768;
constexpr size_t SM_XEX = SM_XBAR + XBAR_BYTES;
constexpr size_t SM_END = SM_XEX + (size_t)NTOK * 4 * 8;
static_assert(WS_SMALL + SM_END <= 256 * MiB, "workspace map");
__device__ __forceinline__ bf16_t* cprev_slot(unsigned char* ws, int u) { return (bf16_t*)(u < 256 ? ws + WS_WIN + (size_t)u * 32768 : ws + WS_SMALL + SM_CPB + (size_t)(u - 256) * 32768); }
constexpr int LDS_BYTES = 147456;

struct Params {
    const float *x, *c, *norm_g, *w_ada, *b_ada, *w_in, *m_gate_b, *conv_w, *conv_b, *m_norm_g, *pool_w, *pool_scale, *w_br_m, *w_br_p, *w_br_s, *gate_b, *w_out, *final_g;
    float* out; unsigned char* ws; int ph_lo, ph_hi;
};

__device__ __forceinline__ float bf2f(unsigned short h) { return __uint_as_float(((unsigned)h) << 16); }
__device__ __forceinline__ float bflo(unsigned w) { return __uint_as_float(w << 16); }
__device__ __forceinline__ float bfhi(unsigned w) { return __uint_as_float(w & 0xffff0000u); }
__device__ __forceinline__ unsigned short f2bf(float f) { return (unsigned short)(cvt_pk_bf16(f, 0.f) & 0xffffu); }
__device__ __forceinline__ float fsigmoid(float x) { return __builtin_amdgcn_rcpf(1.f + __expf(-x)); }
__device__ __forceinline__ float fsilu(float x) { return x * fsigmoid(x); }
__device__ __forceinline__ float logsig(float x) { return fminf(x, 0.f) - log1pf(__expf(-fabsf(x))); }
__device__ __forceinline__ float wave_sum(float v) {
#pragma unroll
    for (int m = 32; m >= 1; m >>= 1) v += __shfl_xor(v, m);
    return v;
}
__device__ __forceinline__ f32x4 mfma16(bf16x8 a, bf16x8 b, f32x4 c) { return __builtin_amdgcn_mfma_f32_16x16x32_bf16(a, b, c, 0, 0, 0); }
__device__ __forceinline__ bf16x8 ldfrag(const LAS unsigned char* p) { return *(const LAS bf16x8*)p; }
__device__ __forceinline__ bf16x8 ldfrag2(const LAS unsigned char* pa, const LAS unsigned char* pb) {
    const u32x2 a = *(const LAS u32x2*)pa, b = *(const LAS u32x2*)pb; const u32x4 c = {a.x, a.y, b.x, b.y}; return __builtin_bit_cast(bf16x8, c);
}

#ifndef MK_WT
#define MK_WT 0
#endif
#if MK_WT
__device__ __forceinline__ void st16(void* p, u32x4 v) { asm volatile("global_store_dwordx4 %0, %1, off sc0 sc1\n\ts_nop 1" :: "v"(p), "v"(v) : "memory"); }
__device__ __forceinline__ void st16f(void* p, f32x4 v) { asm volatile("global_store_dwordx4 %0, %1, off sc0 sc1\n\ts_nop 1" :: "v"(p), "v"(v) : "memory"); }
__device__ __forceinline__ void st8(void* p, u32x2 v) { asm volatile("global_store_dwordx2 %0, %1, off sc0 sc1\n\ts_nop 1" :: "v"(p), "v"(v) : "memory"); }
__device__ __forceinline__ void st4(void* p, unsigned v) { asm volatile("global_store_dword %0, %1, off sc0 sc1\n\ts_nop 1" :: "v"(p), "v"(v) : "memory"); }
__device__ __forceinline__ void st4f(void* p, float v) { asm volatile("global_store_dword %0, %1, off sc0 sc1\n\ts_nop 1" :: "v"(p), "v"(v) : "memory"); }
#else
__device__ __forceinline__ void st16(void* p, u32x4 v) { *(u32x4*)p = v; }
__device__ __forceinline__ void st16f(void* p, f32x4 v) { *(f32x4*)p = v; }
__device__ __forceinline__ void st8(void* p, u32x2 v) { *(u32x2*)p = v; }
__device__ __forceinline__ void st4(void* p, unsigned v) { *(unsigned*)p = v; }
__device__ __forceinline__ void st4f(void* p, float v) { *(float*)p = v; }
#endif

struct NoHook { static constexpr bool ON = false; static constexpr int T1 = -1, T2 = -1;
    __device__ __forceinline__ void operator()(f32x4 (&)[2][2][4][2], const pg8::Unit&, int, int, int, int, int) const {} };

struct EpiProj {
    static constexpr bool PERM = true, AFTER_DRAIN = false;
    bf16_t* O; int pitch; int raw;
    __device__ __forceinline__ void operator()(const f32x4 (&acc)[2][2][4][2], const pg8::Unit& u, int wr, int wc, int fr, int fq) const {
        const int pn = u.pn; const int act = raw ? 0 : ((pn == 6 || pn == 7) ? 1 : ((pn == 8 || pn == 9 || pn == 11 || pn == 15) ? 2 : (pn == 12 ? 3 : 0)));
        const int row0 = u.pm * 256 + wr * 64 + fr, col0 = pn * 256 + wc * 32 + 8 * fq;
#pragma unroll
        for (int ai = 0; ai < 2; ++ai)
#pragma unroll
            for (int m = 0; m < 4; ++m) { bf16_t* rowp = O + (size_t)(row0 + ai * 128 + m * 16) * pitch + col0;
#pragma unroll
                for (int bj = 0; bj < 2; ++bj) { float v[8];
#pragma unroll
                    for (int e = 0; e < 4; ++e) { v[e] = acc[ai][bj][m][0][e]; v[4 + e] = acc[ai][bj][m][1][e]; }
                    if (act == 1) {
#pragma unroll
                        for (int e = 0; e < 8; ++e) v[e] = fsigmoid(v[e]);
                    } else if (act == 2) {
#pragma unroll
                        for (int e = 0; e < 8; ++e) v[e] = fsilu(v[e]);
                    } else if (act == 3) {
#pragma unroll
                        for (int e = 0; e < 8; ++e) v[e] *= 0.18033688011112042f;
                    }
                    u32x4 w; w.x = cvt_pk_bf16(v[0], v[1]); w.y = cvt_pk_bf16(v[2], v[3]); w.z = cvt_pk_bf16(v[4], v[5]); w.w = cvt_pk_bf16(v[6], v[7]);
                    st16(rowp + bj * 128, w); } }
    }
};

__device__ __forceinline__ void gate_rescale(f32x4 (&acc)[2][2][4][2], const bf16_t* G, const float* gbias, int pm, int pn, int goff) {
    int tx_ = threadIdx.x; asm volatile("" : "+v"(tx_)); const int wid = tx_ >> 6, lane = tx_ & 63, wr = wid >> 2, wc = wid & 3, fr = lane & 15, fq = lane >> 4;
    const int row0 = pm * 256 + wr * 64 + fr, col0 = pn * 256 + wc * 32 + 8 * fq;
    __builtin_amdgcn_sched_barrier(0);
#pragma unroll
    for (int bj = 0; bj < 2; ++bj) {
        const f32x4 ba0 = *(const f32x4*)(gbias + goff + col0 + bj * 128), ba1 = *(const f32x4*)(gbias + goff + col0 + bj * 128 + 4);
        const f32x4 bb0 = *(const f32x4*)(gbias + goff + 1024 + col0 + bj * 128), bb1 = *(const f32x4*)(gbias + goff + 1024 + col0 + bj * 128 + 4);
#pragma unroll
        for (int ai = 0; ai < 2; ++ai)
#pragma unroll
            for (int m = 0; m < 4; ++m) { const bf16_t* rowp = G + (size_t)(row0 + ai * 128 + m * 16) * NG + goff + col0 + bj * 128;
                const u32x4 a = *(const u32x4*)rowp, b = *(const u32x4*)(rowp + 1024);
                const unsigned aw[4] = {a.x, a.y, a.z, a.w}, bw[4] = {b.x, b.y, b.z, b.w};
                f32x4 r0, r1;
#pragma unroll
                for (int e = 0; e < 2; ++e) {
                    r0[2 * e]     = (1.f + __expf(-(bflo(bw[e]) + bb0[2 * e])))         * __builtin_amdgcn_rcpf(1.f + __expf(-(bflo(aw[e]) + ba0[2 * e])));
                    r0[2 * e + 1] = (1.f + __expf(-(bfhi(bw[e]) + bb0[2 * e + 1])))     * __builtin_amdgcn_rcpf(1.f + __expf(-(bfhi(aw[e]) + ba0[2 * e + 1])));
                    r1[2 * e]     = (1.f + __expf(-(bflo(bw[2 + e]) + bb1[2 * e])))     * __builtin_amdgcn_rcpf(1.f + __expf(-(bflo(aw[2 + e]) + ba1[2 * e])));
                    r1[2 * e + 1] = (1.f + __expf(-(bfhi(bw[2 + e]) + bb1[2 * e + 1]))) * __builtin_amdgcn_rcpf(1.f + __expf(-(bfhi(aw[2 + e]) + ba1[2 * e + 1]))); }
                acc[ai][bj][m][0] *= r0; acc[ai][bj][m][1] *= r1;
                asm volatile("" : "+v"(acc[ai][bj][m][0]), "+v"(acc[ai][bj][m][1]) :: "memory");
                __builtin_amdgcn_sched_barrier(0); }
    }
    asm volatile("s_waitcnt vmcnt(0)" ::: "memory"); __builtin_amdgcn_sched_barrier(0);
}
struct EpiNone { static constexpr bool PERM = true, AFTER_DRAIN = true;
    __device__ __forceinline__ void fused(const f32x4 (&)[2][2][4][2], const pg8::Unit&, int, int, int, int, LAS unsigned char*, int, int) const {} };
struct EpiMerge {
    static constexpr bool PERM = true, AFTER_DRAIN = true;
    bf16_t* O; const bf16_t* G; const float* gbias;
    __device__ __forceinline__ void fused(const f32x4 (&acc)[2][2][4][2], const pg8::Unit& u, int wr, int wc, int fr, int fq, LAS unsigned char*, int, int) const {
        const int row0 = u.pm * 256 + wr * 64 + fr, col0 = u.pn * 256 + wc * 32 + 8 * fq;
#pragma unroll
        for (int ai = 0; ai < 2; ++ai)
#pragma unroll
            for (int m = 0; m < 4; ++m) { const size_t row = (size_t)(row0 + ai * 128 + m * 16);
#pragma unroll
                for (int bj = 0; bj < 2; ++bj) { const u32x4 g = *(const u32x4*)(G + row * NG + 2048 + col0 + bj * 128);
                    const f32x4 b0 = *(const f32x4*)(gbias + 2048 + col0 + bj * 128), b1 = *(const f32x4*)(gbias + 2048 + col0 + bj * 128 + 4);
                    const f32x4 a0 = acc[ai][bj][m][0], a1 = acc[ai][bj][m][1];
                    u32x4 w; w.x = cvt_pk_bf16(a0[0] * fsigmoid(bflo(g.x) + b0[0]), a0[1] * fsigmoid(bfhi(g.x) + b0[1])); w.y = cvt_pk_bf16(a0[2] * fsigmoid(bflo(g.y) + b0[2]), a0[3] * fsigmoid(bfhi(g.y) + b0[3]));
                    w.z = cvt_pk_bf16(a1[0] * fsigmoid(bflo(g.z) + b1[0]), a1[1] * fsigmoid(bfhi(g.z) + b1[1])); w.w = cvt_pk_bf16(a1[2] * fsigmoid(bflo(g.w) + b1[2]), a1[3] * fsigmoid(bfhi(g.w) + b1[3]));
                    st16(O + row * DM + col0 + bj * 128, w); } }
    }
};
struct EpiOut {
    static constexpr bool PERM = true, AFTER_DRAIN = true;
    const float* xin; float* xout; const float* gate;
    __device__ __forceinline__ void fused(const f32x4 (&acc)[2][2][4][2], const pg8::Unit& u, int wr, int wc, int fr, int fq, LAS unsigned char*, int, int) const {
        const int row0 = u.pm * 256 + wr * 64 + fr, col0 = u.pn * 256 + wc * 32 + 8 * fq; const float* gb = gate + ((u.pm * 256) / SEQ) * 1024;
#pragma unroll
        for (int bj = 0; bj < 2; ++bj) {
            const f32x4 g0 = *(const f32x4*)(gb + col0 + bj * 128), g1 = *(const f32x4*)(gb + col0 + bj * 128 + 4);
#pragma unroll
            for (int ai = 0; ai < 2; ++ai)
#pragma unroll
                for (int m = 0; m < 4; ++m) { const size_t off = (size_t)(row0 + ai * 128 + m * 16) * DM + col0 + bj * 128;
                    const f32x4 x0 = *(const f32x4*)(xin + off), x1 = *(const f32x4*)(xin + off + 4);
                    st16f(xout + off, x0 + g0 * acc[ai][bj][m][0]); st16f(xout + off + 4, x1 + g1 * acc[ai][bj][m][1]); }
        }
    }
};
struct EpiOutNorm {
    static constexpr bool PERM = true, AFTER_DRAIN = true;
    const float* xin; float* out; const float* gate; const float* fg; unsigned long long* xbuf; unsigned* cnt;
    __device__ __forceinline__ void fused(f32x4 (&acc)[2][2][4][2], const pg8::Unit& u, int wr, int wc, int fr, int fq, LAS unsigned char* lds, int wid, int lane) const {
        const int row0 = u.pm * 256 + wr * 64 + fr, col0 = u.pn * 256 + wc * 32 + 8 * fq; const float* gb = gate + ((u.pm * 256) / SEQ) * 1024;
        LAS float* P = (LAS float*)lds; LAS float* S = (LAS float*)(lds + 8192);
#pragma unroll
        for (int bj = 0; bj < 2; ++bj) {
            const f32x4 g0 = *(const f32x4*)(gb + col0 + bj * 128), g1 = *(const f32x4*)(gb + col0 + bj * 128 + 4);
#pragma unroll
            for (int ai = 0; ai < 2; ++ai)
#pragma unroll
                for (int m = 0; m < 4; ++m) { const size_t off = (size_t)(row0 + ai * 128 + m * 16) * DM + col0 + bj * 128;
                    acc[ai][bj][m][0] = *(const f32x4*)(xin + off) + g0 * acc[ai][bj][m][0]; acc[ai][bj][m][1] = *(const f32x4*)(xin + off + 4) + g1 * acc[ai][bj][m][1];
                    asm volatile("" : "+v"(acc[ai][bj][m][0]), "+v"(acc[ai][bj][m][1]) :: "memory"); }
        }
#pragma unroll
        for (int ai = 0; ai < 2; ++ai)
#pragma unroll
            for (int m = 0; m < 4; ++m) { float sq = 0.f;
#pragma unroll
                for (int bj = 0; bj < 2; ++bj)
#pragma unroll
                    for (int n = 0; n < 2; ++n) { const f32x4 v = acc[ai][bj][m][n]; sq += (v[0] * v[0] + v[1] * v[1]) + (v[2] * v[2] + v[3] * v[3]); }
                sq += __shfl_xor(sq, 16); sq += __shfl_xor(sq, 32);
                if (fq == 0) P[(ai * 128 + wr * 64 + m * 16 + fr) * 4 + wc] = sq; }
        __syncthreads();
        const int row = wid * 32 + (lane & 31);
        if (lane < 32) { const float t = (P[row * 4 + 0] + P[row * 4 + 1]) + (P[row * 4 + 2] + P[row * 4 + 3]);
            __hip_atomic_store(xbuf + ((size_t)(u.pm * 256 + row) * 4 + u.pn), (unsigned long long)__float_as_uint(t), __ATOMIC_RELAXED, __HIP_MEMORY_SCOPE_AGENT); }
        asm volatile("s_waitcnt vmcnt(0)" ::: "memory");
        if (lane == 0) __hip_atomic_fetch_add(cnt + 64 * u.pm, 1u, __ATOMIC_RELAXED, __HIP_MEMORY_SCOPE_AGENT);
        if (wid == 0) {
            for (unsigned spins = 0; spins < (1u << 22); ++spins) { if ((unsigned)__builtin_amdgcn_readfirstlane(__hip_atomic_load(cnt + 64 * u.pm, __ATOMIC_RELAXED, __HIP_MEMORY_SCOPE_AGENT)) >= 32u) break; __builtin_amdgcn_s_sleep(2); }
            __builtin_amdgcn_fence(__ATOMIC_ACQUIRE, "agent");
        }
        asm volatile("s_waitcnt vmcnt(0) lgkmcnt(0)" ::: "memory");
        __syncthreads();
        if (lane < 32) { const unsigned long long* slot = xbuf + (size_t)(u.pm * 256 + row) * 4; float t = 0.f;
#pragma unroll
            for (int q = 0; q < 4; ++q) t += __uint_as_float((unsigned)__hip_atomic_load(slot + q, __ATOMIC_RELAXED, __HIP_MEMORY_SCOPE_AGENT));
            S[row] = rsqrtf(t * (1.f / 1024.f) + EPSF); }
        __syncthreads();
#pragma unroll
        for (int bj = 0; bj < 2; ++bj) {
            const f32x4 f0 = *(const f32x4*)(fg + col0 + bj * 128), f1 = *(const f32x4*)(fg + col0 + bj * 128 + 4);
#pragma unroll
            for (int ai = 0; ai < 2; ++ai)
#pragma unroll
                for (int m = 0; m < 4; ++m) { const size_t off = (size_t)(row0 + ai * 128 + m * 16) * DM + col0 + bj * 128; const float r = S[ai * 128 + wr * 64 + m * 16 + fr];
                    *(f32x4*)(out + off) = acc[ai][bj][m][0] * r * f0; *(f32x4*)(out + off + 4) = acc[ai][bj][m][1] * r * f1; }
        }
    }
};
struct GateOrder { int pm, pn;
    __device__ __forceinline__ bool next(int i, pg8::Unit& u) const { if (i >= 3) return false; u.pm = pm; u.pn = pn + 4 * i; return true; }
    __device__ __forceinline__ void a_ready(const pg8::Unit&) const {}
    __device__ __forceinline__ void done(const pg8::Unit&) const {} };
struct OneUnit { int pm, pn;
    __device__ __forceinline__ bool next(int i, pg8::Unit& u) const { if (i >= 1) return false; u.pm = pm; u.pn = pn; return true; }
    __device__ __forceinline__ void a_ready(const pg8::Unit&) const {}
    __device__ __forceinline__ void done(const pg8::Unit&) const {} };

__device__ __forceinline__ void phase_mod(const Params& p, float* MODP) {
    for (int u = blockIdx.x; u < 192; u += gridDim.x) {
        const int l = u / 96, r = u % 96, ks = r / 6, jb = r % 6; int tx_ = threadIdx.x; asm volatile("" : "+v"(tx_)); const int j = jb * 512 + tx_;
        const float* w = p.w_ada + ((size_t)l * 1024 + ks * 64) * 3072 + j; const float* c0 = p.c + ks * 64; const float* c1 = p.c + 1024 + ks * 64;
        float a0 = 0.f, a1 = 0.f;
#pragma unroll 8
        for (int k = 0; k < 64; ++k) { const float wv = w[(size_t)k * 3072]; a0 += c0[k] * wv; a1 += c1[k] * wv; }
        st4f(MODP + ((l * 16 + ks) * 2 + 0) * 3072 + j, a0); st4f(MODP + ((l * 16 + ks) * 2 + 1) * 3072 + j, a1);
    }
}

struct TItem { const float* src; int ld; bf16_t* dst; };
__device__ __forceinline__ TItem transpose_item(const Params& p, int l, int it, bf16_t* WinT, bf16_t* WbrT, bf16_t* WoutT) {
    TItem t;
    if (it < 1792) { const int nt = it >> 4, kt = it & 15, n0 = nt * 64, c0 = n0 < 1536 ? n0 : n0 + 8;
        t.src = p.w_in + (size_t)l * 1024 * NIN + (size_t)kt * 64 * NIN + c0; t.ld = NIN; t.dst = WinT + (size_t)n0 * 1024 + kt * 64;
    } else if (it < 2048) { const int j = it - 1792, nt = j >> 4, kt = j & 15, k0 = kt * 64;
        const float* src = k0 < 512 ? p.w_br_m + (size_t)l * 512 * 1024 + (size_t)k0 * 1024 : (k0 < 768 ? p.w_br_p + (size_t)l * 256 * 1024 + (size_t)(k0 - 512) * 1024 : p.w_br_s + (size_t)l * 256 * 1024 + (size_t)(k0 - 768) * 1024);
        t.src = src + nt * 64; t.ld = 1024; t.dst = WbrT + (size_t)nt * 64 * 1024 + k0;
    } else { const int j = it - 2048, nt = j >> 4, kt = j & 15;
        t.src = p.w_out + (size_t)l * 1024 * 1024 + (size_t)kt * 64 * 1024 + nt * 64; t.ld = 1024; t.dst = WoutT + (size_t)nt * 64 * 1024 + kt * 64; }
    return t;
}
__device__ __forceinline__ void phase_prep(const Params& p, int l, const float* xin, LAS unsigned char* lds, unsigned char* ws_in) {
    size_t wz_ = 0; asm volatile("" : "+s"(wz_)); unsigned char* ws = ws_in + wz_;
    int tid_ = threadIdx.x; asm volatile("" : "+v"(tid_)); const int tid = tid_, lane = tid & 63, wid = tid >> 6;
    bf16_t* WinT = (bf16_t*)(ws + WS_WIN); bf16_t* WbrT = (bf16_t*)(ws + WS_WBR); bf16_t* WoutT = (bf16_t*)(ws + WS_WOUT);
    LAS float* tl = (LAS float*)lds;
    { float tv[8]; int it = blockIdx.x;
      if (it < 2304) { const TItem t0 = transpose_item(p, l, it, WinT, WbrT, WoutT);
#pragma unroll
          for (int i = 0; i < 8; ++i) tv[i] = __builtin_nontemporal_load(t0.src + (size_t)(i * 8 + (tid >> 6)) * t0.ld + (tid & 63)); }
      for (; it < 2304; it += gridDim.x) {
          const TItem t = transpose_item(p, l, it, WinT, WbrT, WoutT);
#pragma unroll
          for (int i = 0; i < 8; ++i) tl[(i * 8 + (tid >> 6)) * 65 + (tid & 63)] = tv[i];
          __syncthreads();
          if (it + (int)gridDim.x < 2304) { const TItem tn = transpose_item(p, l, it + gridDim.x, WinT, WbrT, WoutT);
#pragma unroll
              for (int i = 0; i < 8; ++i) tv[i] = __builtin_nontemporal_load(tn.src + (size_t)(i * 8 + (tid >> 6)) * tn.ld + (tid & 63)); }
#pragma unroll
          for (int i = 0; i < 4; ++i) { const int nn = i * 16 + (tid >> 5), kk = (tid & 31) * 2; st4(t.dst + (size_t)nn * 1024 + kk, cvt_pk_bf16(tl[kk * 65 + nn], tl[(kk + 1) * 65 + nn])); }
          __syncthreads();
      } }
    const float* MODP = (const float*)(ws + WS_SMALL + SM_MODP) + (size_t)l * 16 * 2 * 3072;
    float* GATEV = (float*)(ws + WS_SMALL + SM_GATEV) + l * 2048; float* IFG = (float*)(ws + WS_SMALL + SM_IF + (size_t)l * NTOK * 32);
    bf16_t* H = (bf16_t*)(ws + WS_H);
    LAS float* A = (LAS float*)(lds + 16896); LAS float* Sh = A + 1024; LAS float* Wif = Sh + 1024;
    for (int rb = blockIdx.x; rb < 256; rb += gridDim.x) {
        const int b = (rb * 64) / SEQ;
        __syncthreads();
#pragma unroll
        for (int q = 0; q < 2; ++q) { const int k = tid + q * 512; float sh = p.b_ada[l * 3072 + k], sc = p.b_ada[l * 3072 + 1024 + k];
            for (int ks = 0; ks < 16; ++ks) { sh += MODP[(ks * 2 + b) * 3072 + k]; sc += MODP[(ks * 2 + b) * 3072 + 1024 + k]; }
            A[k] = p.norm_g[l * 1024 + k] * (1.f + sc); Sh[k] = sh; }
        if (rb < 4) { const int e = rb * 512 + tid, bb = e >> 10, j = e & 1023; float g = p.b_ada[l * 3072 + 2048 + j];
            for (int ks = 0; ks < 16; ++ks) g += MODP[(ks * 2 + bb) * 3072 + 2048 + j];
            st4f(GATEV + bb * 1024 + j, g); }
#pragma unroll
        for (int q = 0; q < 16; ++q) { const int e = tid + q * 512, k = e >> 3, g = e & 7; Wif[g * 1024 + k] = p.w_in[(size_t)l * 1024 * NIN + (size_t)k * NIN + 1536 + g]; }
        __syncthreads();
        f32x4 xn[4];
        { const float* xr0 = xin + (size_t)(rb * 64 + wid * 8) * DM;
#pragma unroll
          for (int j = 0; j < 4; ++j) xn[j] = __builtin_nontemporal_load((const f32x4*)(xr0 + (j >> 1) * 512 + lane * 8 + (j & 1) * 4)); }
        for (int i = 0; i < 8; ++i) {
            const int row = rb * 64 + wid * 8 + i;
            f32x4 xv[4]; float ss = 0.f;
#pragma unroll
            for (int j = 0; j < 4; ++j) { xv[j] = xn[j]; ss += xv[j][0] * xv[j][0] + xv[j][1] * xv[j][1] + xv[j][2] * xv[j][2] + xv[j][3] * xv[j][3]; }
            if (i < 7) { const float* xr1 = xin + (size_t)(row + 1) * DM;
#pragma unroll
                for (int j = 0; j < 4; ++j) xn[j] = __builtin_nontemporal_load((const f32x4*)(xr1 + (j >> 1) * 512 + lane * 8 + (j & 1) * 4)); }
            ss = wave_sum(ss); const float rstd = rsqrtf(ss * (1.f / 1024.f) + EPSF);
            float gp[8];
#pragma unroll
            for (int g = 0; g < 8; ++g) gp[g] = 0.f;
            f32x4 hv[4];
#pragma unroll
            for (int j = 0; j < 4; ++j) { const int k = (j >> 1) * 512 + lane * 8 + (j & 1) * 4; const f32x4 a = *(const LAS f32x4*)(A + k), sft = *(const LAS f32x4*)(Sh + k);
                hv[j] = xv[j] * rstd * a + sft;
#pragma unroll
                for (int g = 0; g < 8; ++g) { const f32x4 wv = *(const LAS f32x4*)(Wif + g * 1024 + k); gp[g] += hv[j][0] * wv[0] + hv[j][1] * wv[1] + hv[j][2] * wv[2] + hv[j][3] * wv[3]; } }
#pragma unroll
            for (int j = 0; j < 2; ++j) { u32x4 w; w.x = cvt_pk_bf16(hv[2 * j][0], hv[2 * j][1]); w.y = cvt_pk_bf16(hv[2 * j][2], hv[2 * j][3]); w.z = cvt_pk_bf16(hv[2 * j + 1][0], hv[2 * j + 1][1]); w.w = cvt_pk_bf16(hv[2 * j + 1][2], hv[2 * j + 1][3]);
                st16(H + (size_t)row * DM + j * 512 + lane * 8, w); }
#pragma unroll
            for (int g = 0; g < 8; ++g) gp[g] = wave_sum(gp[g]);
            float outv = gp[0];
#pragma unroll
            for (int g = 1; g < 8; ++g) outv = (lane == g) ? gp[g] : outv;
            if (lane < 8) st4f(IFG + (size_t)row * 8 + lane, outv + p.m_gate_b[l * 8 + lane]);
        }
    }
    __syncthreads();
}

constexpr int LP = 136;
constexpr int OFF_Q = 0, OFF_K = 34816, OFF_V = 69632, OFF_C = 104448, OFF_AR = 139264;
template <int MODE> __device__ __forceinline__ void mlstm_gates(const float* IFG, int tok0, int hd, float mprev, LAS float* ar, int tid) {
    if (tid < 64) { const int l = tid;
        const float i0 = IFG[(size_t)(tok0 + 2 * l) * 8 + hd], i1 = IFG[(size_t)(tok0 + 2 * l + 1) * 8 + hd];
        const float f0 = logsig(IFG[(size_t)(tok0 + 2 * l) * 8 + 4 + hd]), f1 = logsig(IFG[(size_t)(tok0 + 2 * l + 1) * 8 + 4 + hd]);
        float sc = f0 + f1;
#pragma unroll
        for (int d = 1; d < 64; d <<= 1) { const float t = __shfl_up(sc, d); if (l >= d) sc += t; }
        const float c1 = sc, c0 = sc - f1;
        ar[2 * l] = i0; ar[2 * l + 1] = i1; ar[128 + 2 * l] = c0; ar[128 + 2 * l + 1] = c1;
        if (MODE == 1) { const float bend = __shfl(c1, 63); const float a0 = bend - c0 + i0, a1 = bend - c1 + i1; float am = fmaxf(a0, a1);
#pragma unroll
            for (int m = 32; m >= 1; m >>= 1) am = fmaxf(am, __shfl_xor(am, m));
            ar[3 * 128 + 2 * l] = __expf(a0 - am); ar[3 * 128 + 2 * l + 1] = __expf(a1 - am);
            if (l == 0) { ar[7 * 128] = bend; ar[7 * 128 + 1] = am; } }
        if (MODE == 3) { const float g0 = i0 - c0, g1 = i1 - c1; float pm = fmaxf(g0, g1);
#pragma unroll
            for (int d = 1; d < 64; d <<= 1) { const float t = __shfl_up(pm, d); if (l >= d) pm = fmaxf(pm, t); }
            float pprev = __shfl_up(pm, 1); if (l == 0) pprev = -3.0e38f;
            const float pm0 = fmaxf(pprev, g0), pm1 = pm;
            const float mt0 = c0 + fmaxf(mprev, pm0), mt1 = c1 + fmaxf(mprev, pm1);
            ar[2 * 128 + 2 * l] = g0; ar[2 * 128 + 2 * l + 1] = g1;
            ar[3 * 128 + 2 * l] = __expf(c0 + mprev - mt0); ar[3 * 128 + 2 * l + 1] = __expf(c1 + mprev - mt1);
            ar[4 * 128 + 2 * l] = c0 - mt0; ar[4 * 128 + 2 * l + 1] = c1 - mt1;
            ar[5 * 128 + 2 * l] = __expf(-mt0); ar[5 * 128 + 2 * l + 1] = __expf(-mt1); }
    }
}
template <bool TR> __device__ __forceinline__ void stage_conv(const bf16_t* PROJ, int colbase, const float* cw, const float* cb, int ch0, int tok0, int pos0, float scale, LAS bf16_t* dst, int tid) {
    const int d0 = (tid & 15) * 8, s0 = (tid >> 4) * 4;
    float x[7][8];
    const bf16_t* src = PROJ + (size_t)tok0 * NPA + colbase + d0;
#pragma unroll
    for (int r = 0; r < 7; ++r) { const int sr = s0 - 3 + r; u32x4 v = {0u, 0u, 0u, 0u}; if (pos0 + sr >= 0) v = *(const u32x4*)(src + (ptrdiff_t)sr * NPA);
        x[r][0] = bflo(v.x); x[r][1] = bfhi(v.x); x[r][2] = bflo(v.y); x[r][3] = bfhi(v.y); x[r][4] = bflo(v.z); x[r][5] = bfhi(v.z); x[r][6] = bflo(v.w); x[r][7] = bfhi(v.w); }
    float o[4][8];
    { const f32x4 b0 = *(const f32x4*)(cb + ch0 + d0), b1 = *(const f32x4*)(cb + ch0 + d0 + 4);
#pragma unroll
      for (int i = 0; i < 4; ++i) { o[i][0] = b0[0]; o[i][1] = b0[1]; o[i][2] = b0[2]; o[i][3] = b0[3]; o[i][4] = b1[0]; o[i][5] = b1[1]; o[i][6] = b1[2]; o[i][7] = b1[3]; } }
#pragma unroll
    for (int j = 0; j < 4; ++j) { const f32x4 w0 = *(const f32x4*)(cw + j * 1024 + ch0 + d0), w1 = *(const f32x4*)(cw + j * 1024 + ch0 + d0 + 4);
#pragma unroll
        for (int i = 0; i < 4; ++i) { o[i][0] += w0[0] * x[i + j][0]; o[i][1] += w0[1] * x[i + j][1]; o[i][2] += w0[2] * x[i + j][2]; o[i][3] += w0[3] * x[i + j][3];
                                      o[i][4] += w1[0] * x[i + j][4]; o[i][5] += w1[1] * x[i + j][5]; o[i][6] += w1[2] * x[i + j][6]; o[i][7] += w1[3] * x[i + j][7]; } }
#pragma unroll
    for (int i = 0; i < 4; ++i)
#pragma unroll
        for (int c = 0; c < 8; ++c) o[i][c] = fsilu(o[i][c]) * scale;
    if (TR) {
#pragma unroll
        for (int c = 0; c < 8; ++c) { u32x2 w; w.x = cvt_pk_bf16(o[0][c], o[1][c]); w.y = cvt_pk_bf16(o[2][c], o[3][c]); *(LAS u32x2*)(dst + (d0 + c) * LP + s0) = w; }
    } else {
#pragma unroll
        for (int i = 0; i < 4; ++i) { u32x4 w; w.x = cvt_pk_bf16(o[i][0], o[i][1]); w.y = cvt_pk_bf16(o[i][2], o[i][3]); w.z = cvt_pk_bf16(o[i][4], o[i][5]); w.w = cvt_pk_bf16(o[i][6], o[i][7]); *(LAS u32x4*)(dst + (s0 + i) * LP + d0) = w; }
    }
}
template <bool SCALE> __device__ __forceinline__ void stage_vt(const bf16_t* PROJ, int tok0, int hd, const LAS float* wa, LAS bf16_t* dst, int tid) {
#pragma unroll
    for (int q = 0; q < 4; ++q) { const int s = tid & 127, d0 = ((tid >> 7) + 4 * q) * 8;
        const u32x4 v = *(const u32x4*)(PROJ + (size_t)(tok0 + s) * NPA + C_MV + hd * 128 + d0); const float sc = SCALE ? wa[s] : 1.f;
        const unsigned wv[4] = {v.x, v.y, v.z, v.w};
#pragma unroll
        for (int e = 0; e < 4; ++e) { const float lo = bflo(wv[e]) * sc, hi = bfhi(wv[e]) * sc;
            dst[(d0 + 2 * e) * LP + s] = SCALE ? f2bf(lo) : (bf16_t)(wv[e] & 0xffffu); dst[(d0 + 2 * e + 1) * LP + s] = SCALE ? f2bf(hi) : (bf16_t)(wv[e] >> 16); } }
}

__device__ __forceinline__ void mlstm_m1(const Params& p, int l, LAS unsigned char* lds, unsigned char* ws_in) {
    size_t wz_ = 0; asm volatile("" : "+s"(wz_)); unsigned char* ws = ws_in + wz_;
    int tid_ = threadIdx.x; asm volatile("" : "+v"(tid_)); const int tid = tid_, lane = tid & 63, wid = tid >> 6, fr = lane & 15, fq = lane >> 4;
    const bf16_t* PROJ = (const bf16_t*)(ws + WS_PROJ); const float* IFG = (const float*)(ws + WS_SMALL + SM_IF + (size_t)l * NTOK * 32);
    float* DC = (float*)(ws + WS_DC); float* DN = (float*)(ws + WS_SMALL + SM_DN + (size_t)l * 262144); float* BEND = (float*)(ws + WS_SMALL + SM_BEND + (size_t)l * 65536); float* AMAX = (float*)(ws + WS_SMALL + SM_AMAX + (size_t)l * 65536);
    LAS float* ar = (LAS float*)(lds + OFF_AR); LAS bf16_t* Vt = (LAS bf16_t*)(lds + OFF_V); LAS bf16_t* Kt = (LAS bf16_t*)(lds + OFF_K);
    for (int u = blockIdx.x; u < 512; u += gridDim.x) {
        const int b = u >> 8, hd = (u >> 6) & 3, c = u & 63, tok0 = b * SEQ + c * 128, pos0 = c * 128;
        __syncthreads();
        mlstm_gates<1>(IFG, tok0, hd, 0.f, ar, tid);
        __syncthreads();
        const float bend = ar[7 * 128], amax = ar[7 * 128 + 1];
        stage_vt<true>(PROJ, tok0, hd, ar + 3 * 128, Vt, tid);
        stage_conv<true>(PROJ, C_MK + hd * 128, p.conv_w + (size_t)l * 4096, p.conv_b + l * 1024, 512 + hd * 128, tok0, pos0, 0.08838834764831845f, Kt, tid);
        __syncthreads();
        f32x4 acc[8];
#pragma unroll
        for (int j = 0; j < 8; ++j) acc[j] = (f32x4){0.f, 0.f, 0.f, 0.f};
#pragma unroll
        for (int ks = 0; ks < 4; ++ks) { const bf16x8 a = ldfrag((const LAS unsigned char*)(Vt + (16 * wid + fr) * LP + ks * 32 + fq * 8));
#pragma unroll
            for (int j = 0; j < 8; ++j) acc[j] = mfma16(ldfrag((const LAS unsigned char*)(Kt + (16 * j + fr) * LP + ks * 32 + fq * 8)), a, acc[j]); }
        bf16_t* dcu = (bf16_t*)(DC + (size_t)u * 16384);
#pragma unroll
        for (int j = 0; j < 8; ++j) { u32x2 w; w.x = cvt_pk_bf16(acc[j][0], acc[j][1]); w.y = cvt_pk_bf16(acc[j][2], acc[j][3]); st8(dcu + (16 * wid + fr) * 128 + 16 * j + 4 * fq, w); }
        if (tid < 128) { float sn = 0.f;
#pragma unroll 4
            for (int jj = 0; jj < 16; ++jj) { const u32x4 kv = *(const LAS u32x4*)(Kt + tid * LP + jj * 8); const f32x4 w0 = *(const LAS f32x4*)(ar + 3 * 128 + jj * 8), w1 = *(const LAS f32x4*)(ar + 3 * 128 + jj * 8 + 4);
                sn += w0[0] * bflo(kv.x) + w0[1] * bfhi(kv.x) + w0[2] * bflo(kv.y) + w0[3] * bfhi(kv.y) + w1[0] * bflo(kv.z) + w1[1] * bfhi(kv.z) + w1[2] * bflo(kv.w) + w1[3] * bfhi(kv.w); }
            st4f(DN + u * 128 + tid, sn); }
        if (tid == 0) { st4f(BEND + u * 32, bend); st4f(AMAX + u * 32, amax); }
    }
    __syncthreads();
}

__device__ __forceinline__ void scan_load(float (&dcv)[64], unsigned char* ws, int idx) {
    const int bh = idx >> 14, e = idx & 16383; const bf16_t* base = (const bf16_t*)(ws + WS_DC) + (size_t)bh * 64 * 32768 + e;
#pragma unroll
    for (int c = 0; c < 64; ++c) dcv[c] = bf2f(base[(size_t)c * 32768]);
}
__device__ __forceinline__ void scan_finish(const float (&dcv)[64], int l, unsigned char* ws, int idx) {
    const float* BEND = (const float*)(ws + WS_SMALL + SM_BEND + (size_t)l * 65536); const float* AMAX = (const float*)(ws + WS_SMALL + SM_AMAX + (size_t)l * 65536);
    float* MPREV = (float*)(ws + WS_SMALL + SM_MPREV + (size_t)l * 2048);
    const int bh = idx >> 14, e = idx & 16383;
    float m = 0.f, cst = 0.f;
#pragma unroll
    for (int c = 0; c < 64; ++c) { const float be = BEND[(bh * 64 + c) * 32], am = AMAX[(bh * 64 + c) * 32]; const float mn = fmaxf(be + m, am), dec = __expf(be + m - mn), inw = __expf(am - mn);
        cprev_slot(ws, bh * 64 + c)[e] = f2bf(cst); cst = dec * cst + inw * dcv[c]; if (e == 0) st4f(MPREV + bh * 64 + c, m); m = mn; }
}
__device__ __forceinline__ void mlstm_scan(int l, unsigned char* ws_in) {
    size_t wz_ = 0; asm volatile("" : "+s"(wz_)); unsigned char* ws = ws_in + wz_;
    int tx_ = threadIdx.x; asm volatile("" : "+v"(tx_));
    for (int idx = blockIdx.x * 512 + tx_; idx < 8 * 16384; idx += gridDim.x * 512) { float dcv[64]; scan_load(dcv, ws, idx); scan_finish(dcv, l, ws, idx); }
}
__device__ __forceinline__ void mlstm_scan_n(int l, unsigned char* ws_in) {
    size_t wz_ = 0; asm volatile("" : "+s"(wz_)); unsigned char* ws = ws_in + wz_;
    float* DN = (float*)(ws + WS_SMALL + SM_DN + (size_t)l * 262144); const float* BEND = (const float*)(ws + WS_SMALL + SM_BEND + (size_t)l * 65536); const float* AMAX = (const float*)(ws + WS_SMALL + SM_AMAX + (size_t)l * 65536);
    int tx_ = threadIdx.x; asm volatile("" : "+v"(tx_));
    for (int idx = (tx_ < 64 && gridDim.x >= 16) ? (int)blockIdx.x * 64 + tx_ : (gridDim.x >= 16 ? 8 * 128 : (int)blockIdx.x * 512 + tx_); idx < 8 * 128; idx += (gridDim.x >= 16 ? 8 * 128 : gridDim.x * 512)) {
        const int bh = idx >> 7, e = idx & 127;
        float* base = DN + (size_t)bh * 64 * 128 + e;
        float dcv[64];
#pragma unroll
        for (int c = 0; c < 64; ++c) dcv[c] = base[c * 128];
        float m = 0.f, cst = 0.f;
#pragma unroll
        for (int c = 0; c < 64; ++c) { const float be = BEND[(bh * 64 + c) * 32], am = AMAX[(bh * 64 + c) * 32]; const float mn = fmaxf(be + m, am), dec = __expf(be + m - mn), inw = __expf(am - mn);
            st4f(base + c * 128, cst); cst = dec * cst + inw * dcv[c]; m = mn; }
    }
}

__device__ __forceinline__ void mlstm_m3(const Params& p, int l, LAS unsigned char* lds, unsigned char* ws_in) {
    size_t wz_ = 0; asm volatile("" : "+s"(wz_)); unsigned char* ws = ws_in + wz_;
    int tid_ = threadIdx.x; asm volatile("" : "+v"(tid_)); const int tid = tid_, lane = tid & 63, wid = tid >> 6, fr = lane & 15, fq = lane >> 4;
    const bf16_t* PROJ = (const bf16_t*)(ws + WS_PROJ); const float* IFG = (const float*)(ws + WS_SMALL + SM_IF + (size_t)l * NTOK * 32);
    const float* DC = (const float*)(ws + WS_DC); const float* DN = (const float*)(ws + WS_SMALL + SM_DN + (size_t)l * 262144); const float* MPREV = (const float*)(ws + WS_SMALL + SM_MPREV + (size_t)l * 2048);
    bf16_t* Y = (bf16_t*)(ws + WS_Y);
    LAS float* ar = (LAS float*)(lds + OFF_AR);
    LAS bf16_t* Qc = (LAS bf16_t*)(lds + OFF_Q); LAS bf16_t* Kc = (LAS bf16_t*)(lds + OFF_K); LAS bf16_t* Vt = (LAS bf16_t*)(lds + OFF_V); LAS bf16_t* Cp = (LAS bf16_t*)(lds + OFF_C);
    for (int u = blockIdx.x; u < 512; u += gridDim.x) {
        const int b = u >> 8, hd = (u >> 6) & 3, c = u & 63, tok0 = b * SEQ + c * 128, pos0 = c * 128;
        __syncthreads();
        const float mprev = MPREV[u];
        mlstm_gates<3>(IFG, tok0, hd, mprev, ar, tid);
        if (tid >= 64 && tid < 192) ar[6 * 128 + tid - 64] = DN[u * 128 + tid - 64];
        stage_conv<false>(PROJ, C_MQ + hd * 128, p.conv_w + (size_t)l * 4096, p.conv_b + l * 1024, hd * 128, tok0, pos0, 1.f, Qc, tid);
        stage_conv<false>(PROJ, C_MK + hd * 128, p.conv_w + (size_t)l * 4096, p.conv_b + l * 1024, 512 + hd * 128, tok0, pos0, 0.08838834764831845f, Kc, tid);
        stage_vt<false>(PROJ, tok0, hd, nullptr, Vt, tid);
        { const bf16_t* cpu = cprev_slot(ws, u);
#pragma unroll
          for (int q = 0; q < 4; ++q) { const int e = (q * 512 + tid) * 8, v = e >> 7, k = e & 127; *(LAS u32x4*)(Cp + v * LP + k) = *(const u32x4*)(cpu + e); } }
        __syncthreads();
        const int tl = 16 * wid + fr;
        bf16x8 qf[4];
#pragma unroll
        for (int ks = 0; ks < 4; ++ks) qf[ks] = ldfrag((const LAS unsigned char*)(Qc + tl * LP + ks * 32 + fq * 8));
        f32x4 acc[8];
#pragma unroll
        for (int vi = 0; vi < 8; ++vi) { acc[vi] = (f32x4){0.f, 0.f, 0.f, 0.f};
#pragma unroll
            for (int ks = 0; ks < 4; ++ks) acc[vi] = mfma16(ldfrag((const LAS unsigned char*)(Cp + (16 * vi + fr) * LP + ks * 32 + fq * 8)), qf[ks], acc[vi]); }
        float deni = 0.f;
#pragma unroll
        for (int kk = 0; kk < 4; ++kk) { const u32x4 qv = *(const LAS u32x4*)(Qc + tl * LP + fq * 32 + kk * 8); const f32x4 n0 = *(const LAS f32x4*)(ar + 6 * 128 + fq * 32 + kk * 8), n1 = *(const LAS f32x4*)(ar + 6 * 128 + fq * 32 + kk * 8 + 4);
            deni += n0[0] * bflo(qv.x) + n0[1] * bfhi(qv.x) + n0[2] * bflo(qv.y) + n0[3] * bfhi(qv.y) + n1[0] * bflo(qv.z) + n1[1] * bfhi(qv.z) + n1[2] * bflo(qv.w) + n1[3] * bfhi(qv.w); }
        deni += __shfl_xor(deni, 16); deni += __shfl_xor(deni, 32);
        const float wi = ar[3 * 128 + tl], et = ar[4 * 128 + tl], emt = ar[5 * 128 + tl];
#pragma unroll
        for (int vi = 0; vi < 8; ++vi) acc[vi] *= wi;
        float den = 0.f;
        for (int sp = 0; sp <= (wid >> 1); ++sp) {
            float pv[8];
#pragma unroll
            for (int h2 = 0; h2 < 2; ++h2) { const int tile = 2 * sp + h2; f32x4 sa = (f32x4){0.f, 0.f, 0.f, 0.f};
#pragma unroll
                for (int ks = 0; ks < 4; ++ks) sa = mfma16(ldfrag((const LAS unsigned char*)(Kc + (16 * tile + fr) * LP + ks * 32 + fq * 8)), qf[ks], sa);
                const f32x4 gk = *(const LAS f32x4*)(ar + 2 * 128 + 16 * tile + 4 * fq);
#pragma unroll
                for (int r = 0; r < 4; ++r) { const int sl = 16 * tile + 4 * fq + r; const float wgt = (sl <= tl) ? __expf(et + gk[r]) : 0.f; const float pp = wgt * sa[r]; den += pp; pv[h2 * 4 + r] = pp; } }
            u32x4 pw; pw.x = cvt_pk_bf16(pv[0], pv[1]); pw.y = cvt_pk_bf16(pv[2], pv[3]); pw.z = cvt_pk_bf16(pv[4], pv[5]); pw.w = cvt_pk_bf16(pv[6], pv[7]);
            const bf16x8 pf = __builtin_bit_cast(bf16x8, pw);
#pragma unroll
            for (int vi = 0; vi < 8; ++vi) { const LAS unsigned char* vr = (const LAS unsigned char*)(Vt + (16 * vi + fr) * LP + 32 * sp + 4 * fq);
                acc[vi] = mfma16(ldfrag2(vr, vr + 32), pf, acc[vi]); }
        }
        den += __shfl_xor(den, 16); den += __shfl_xor(den, 32);
        const float dtot = wi * deni + den; const float hinv = 1.f / fmaxf(fabsf(dtot), emt);
        const size_t tokr = (size_t)(tok0 + tl);
        float ssq = 0.f;
#pragma unroll
        for (int vi = 0; vi < 8; ++vi) { const u32x2 o = *(const u32x2*)(PROJ + tokr * NPA + C_MO + hd * 128 + 16 * vi + 4 * fq);
            acc[vi][0] *= hinv * bflo(o.x); acc[vi][1] *= hinv * bfhi(o.x); acc[vi][2] *= hinv * bflo(o.y); acc[vi][3] *= hinv * bfhi(o.y);
            ssq += acc[vi][0] * acc[vi][0] + acc[vi][1] * acc[vi][1] + acc[vi][2] * acc[vi][2] + acc[vi][3] * acc[vi][3]; }
        ssq += __shfl_xor(ssq, 16); ssq += __shfl_xor(ssq, 32);
        const float rinv = rsqrtf(ssq * (1.f / 128.f) + EPSF);
#pragma unroll
        for (int vi = 0; vi < 8; ++vi) { const int vc = hd * 128 + 16 * vi + 4 * fq; const u32x2 z = *(const u32x2*)(PROJ + tokr * NPA + C_MZ + vc); const f32x4 g = *(const f32x4*)(p.m_norm_g + l * 512 + vc);
            u32x2 w; w.x = cvt_pk_bf16(acc[vi][0] * rinv * g[0] * bflo(z.x), acc[vi][1] * rinv * g[1] * bfhi(z.x)); w.y = cvt_pk_bf16(acc[vi][2] * rinv * g[2] * bflo(z.y), acc[vi][3] * rinv * g[3] * bfhi(z.y));
            st8(Y + tokr * DM + vc, w); }
    }
    __syncthreads();
}

__device__ __forceinline__ void pool_phase(const Params& p, int l, LAS unsigned char* lds, unsigned char* ws_in) {
    size_t wz_ = 0; asm volatile("" : "+s"(wz_)); unsigned char* ws = ws_in + wz_;
    int tid_ = threadIdx.x; asm volatile("" : "+v"(tid_)); const int tid = tid_; const bf16_t* PROJ = (const bf16_t*)(ws + WS_PROJ); bf16_t* Y = (bf16_t*)(ws + WS_Y);
    LAS float* U = (LAS float*)lds; LAS float* Wp = (LAS float*)(lds + 20480); LAS float* Pm = (LAS float*)(lds + 36864);
    for (int pu = blockIdx.x; pu < 1024; pu += gridDim.x) {
        const int tt = pu >> 2, g = pu & 3, tok0 = tt * 64, b = tok0 / SEQ, p0 = tok0 % SEQ, W = 2 << g;
        __syncthreads();
        for (int ch = tid; ch < 79 * 8; ch += 512) { const int row = ch >> 3, cc = (ch & 7) * 8, pos = p0 - 15 + row;
            u32x4 v = {0u, 0u, 0u, 0u}; if (pos >= 0) v = *(const u32x4*)(PROJ + (size_t)(b * SEQ + pos) * NPA + C_PU + g * 64 + cc);
            *(LAS f32x4*)(U + row * 64 + cc) = (f32x4){bflo(v.x), bfhi(v.x), bflo(v.y), bfhi(v.y)}; *(LAS f32x4*)(U + row * 64 + cc + 4) = (f32x4){bflo(v.z), bfhi(v.z), bflo(v.w), bfhi(v.w)}; }
#pragma unroll
        for (int q = 0; q < 8; ++q) Wp[q * 512 + tid] = p.pool_w[(size_t)l * 16384 + g * 4096 + q * 512 + tid];
        __syncthreads();
        const int t = tid >> 3, c0 = (tid & 7) * 8; const int cnt = min(W, p0 + t + 1); const float rc = 1.f / (float)cnt;
        { f32x4 s0 = (f32x4){0.f, 0.f, 0.f, 0.f}, s1 = s0;
          for (int j = 0; j < W; ++j) { s0 += *(const LAS f32x4*)(U + (15 + t - j) * 64 + c0); s1 += *(const LAS f32x4*)(U + (15 + t - j) * 64 + c0 + 4); }
          const f32x4 u0 = *(const LAS f32x4*)(U + (15 + t) * 64 + c0), u1 = *(const LAS f32x4*)(U + (15 + t) * 64 + c0 + 4);
#pragma unroll
          for (int e = 0; e < 4; ++e) { Pm[t * 65 + c0 + e] = s0[e] * rc - u0[e]; Pm[t * 65 + c0 + 4 + e] = s1[e] * rc - u1[e]; } }
        __syncthreads();
        float o[8];
#pragma unroll
        for (int e = 0; e < 8; ++e) o[e] = 0.f;
        for (int cc = 0; cc < 64; ++cc) { const float pv = Pm[t * 65 + cc]; const f32x4 w0 = *(const LAS f32x4*)(Wp + cc * 64 + c0), w1 = *(const LAS f32x4*)(Wp + cc * 64 + c0 + 4);
#pragma unroll
            for (int e = 0; e < 4; ++e) { o[e] += pv * w0[e]; o[4 + e] += pv * w1[e]; } }
        const size_t tok = (size_t)(tok0 + t); const u32x4 z = *(const u32x4*)(PROJ + tok * NPA + C_PZ + g * 64 + c0);
        const f32x4 s0 = *(const f32x4*)(p.pool_scale + l * 256 + g * 64 + c0), s1 = *(const f32x4*)(p.pool_scale + l * 256 + g * 64 + c0 + 4);
        u32x4 w; w.x = cvt_pk_bf16(o[0] * s0[0] * bflo(z.x), o[1] * s0[1] * bfhi(z.x)); w.y = cvt_pk_bf16(o[2] * s0[2] * bflo(z.y), o[3] * s0[3] * bfhi(z.y));
        w.z = cvt_pk_bf16(o[4] * s1[0] * bflo(z.z), o[5] * s1[1] * bfhi(z.z)); w.w = cvt_pk_bf16(o[6] * s1[2] * bflo(z.w), o[7] * s1[3] * bfhi(z.w));
        st16(Y + tok * DM + 512 + g * 64 + c0, w);
    }
    __syncthreads();
}

constexpr float SB_DEAD = -104.f * 1.4426950408889634f;
template <bool DIAG> __device__ __forceinline__ f32x4 sb_tile(const f32x4 z, int sbase, int tq, int fq, float& L) {
    float lf[4], ls[4];
#pragma unroll
    for (int r = 0; r < 4; ++r) { const float zz = z[r], l1p = __builtin_amdgcn_logf(1.f + __builtin_amdgcn_exp2f(-fabsf(zz)));
        const float lfv = -(fmaxf(zz, 0.f) + l1p), lsv = fminf(zz, 0.f) - l1p;
        if (DIAG) { const bool valid = (sbase + r) < tq; lf[r] = valid ? lfv : 0.f; ls[r] = valid ? lsv : -1.0e30f; } else { lf[r] = lfv; ls[r] = lsv; } }
    const float suf2 = lf[3], suf1 = suf2 + lf[2], suf0 = suf1 + lf[1], T = suf0 + lf[0];
    const float T16 = __shfl_down(T, 16), T32 = __shfl_down(T, 32), T48 = __shfl_down(T, 48);
    const float E = (fq < 3 ? T16 : 0.f) + (fq < 2 ? T32 : 0.f) + (fq < 1 ? T48 : 0.f);
    float Tt = T + __shfl_xor(T, 16); Tt += __shfl_xor(Tt, 32);
    const float base = L + E;
    f32x4 pv; pv[0] = __builtin_amdgcn_exp2f(ls[0] + base + suf0); pv[1] = __builtin_amdgcn_exp2f(ls[1] + base + suf1); pv[2] = __builtin_amdgcn_exp2f(ls[2] + base + suf2); pv[3] = __builtin_amdgcn_exp2f(ls[3] + base);
    L += Tt; return pv;
}
__device__ __forceinline__ void sb_phase(const Params& p, LAS unsigned char* lds, unsigned char* ws_in, int u_first, int u_end) {
    size_t wz_ = 0; asm volatile("" : "+s"(wz_)); unsigned char* ws = ws_in + wz_;
    int tid_ = threadIdx.x; asm volatile("" : "+v"(tid_)); const int tid = tid_, lane = tid & 63, wid = tid >> 6, fr = lane & 15, fq = lane >> 4;
    const bf16_t* PROJ = (const bf16_t*)(ws + WS_PROJ); bf16_t* Y = (bf16_t*)(ws + WS_Y);
    LAS bf16_t* Ks = (LAS bf16_t*)lds; LAS bf16_t* Vt = (LAS bf16_t*)(lds + 18432); LAS int* flags = (LAS int*)(lds + 36864);
    for (int u = u_first; u < u_end; u += gridDim.x) {
        const int b = u >> 8, hd = (u >> 6) & 3, qb = u & 63;
        const int tq = qb * 128 + 16 * wid + fr; const size_t tokq = (size_t)(b * SEQ + tq);
        bf16x8 qf[2];
#pragma unroll
        for (int ks = 0; ks < 2; ++ks) qf[ks] = *(const bf16x8*)(PROJ + tokq * NPA + C_SQ + hd * 64 + ks * 32 + fq * 8);
        f32x4 acc[4];
#pragma unroll
        for (int i = 0; i < 4; ++i) acc[i] = (f32x4){0.f, 0.f, 0.f, 0.f};
        float Lrun = 0.f;
        u32x4 kreg[2], vreg[2];
#pragma unroll
        for (int q = 0; q < 2; ++q) { const int row = tid & 127, d0 = ((tid >> 7) + 4 * q) * 8; const size_t tk = (size_t)(b * SEQ + qb * 128 + row);
            kreg[q] = *(const u32x4*)(PROJ + tk * NPA + C_SK + hd * 64 + d0); vreg[q] = *(const u32x4*)(PROJ + tk * NPA + C_SV + hd * 64 + d0); }
        for (int kb = qb; kb >= 0; --kb) {
            __syncthreads();
#pragma unroll
            for (int q = 0; q < 2; ++q) { const int row = tid & 127, d0 = ((tid >> 7) + 4 * q) * 8;
                *(LAS u32x4*)(Ks + row * 72 + d0) = kreg[q];
                const unsigned wv[4] = {vreg[q].x, vreg[q].y, vreg[q].z, vreg[q].w};
#pragma unroll
                for (int e = 0; e < 4; ++e) { Vt[(d0 + 2 * e) * LP + row] = (bf16_t)(wv[e] & 0xffffu); Vt[(d0 + 2 * e + 1) * LP + row] = (bf16_t)(wv[e] >> 16); } }
            if (kb > 0) {
#pragma unroll
                for (int q = 0; q < 2; ++q) { const int row = tid & 127, d0 = ((tid >> 7) + 4 * q) * 8; const size_t tk = (size_t)(b * SEQ + (kb - 1) * 128 + row);
                    kreg[q] = *(const u32x4*)(PROJ + tk * NPA + C_SK + hd * 64 + d0); vreg[q] = *(const u32x4*)(PROJ + tk * NPA + C_SV + hd * 64 + d0); } }
            if (tid < 8) flags[tid] = 0;
            __syncthreads();
            const bool walive = __ballot(Lrun >= SB_DEAD) != 0ull;
            if (walive) {
                const int sp_hi = (kb == qb) ? (wid >> 1) : 3;
                for (int sp = sp_hi; sp >= 0; --sp) {
                    if (__ballot(Lrun >= SB_DEAD) == 0ull) break;
                    f32x4 pvv[2];
#pragma unroll
                    for (int h2 = 1; h2 >= 0; --h2) { const int tile = 2 * sp + h2;
                        f32x4 z = (f32x4){0.f, 0.f, 0.f, 0.f};
#pragma unroll
                        for (int ks = 0; ks < 2; ++ks) z = mfma16(ldfrag((const LAS unsigned char*)(Ks + (16 * tile + fr) * 72 + ks * 32 + fq * 8)), qf[ks], z);
                        const int sbase = kb * 128 + 16 * tile + 4 * fq;
                        pvv[h2] = (kb == qb) ? sb_tile<true>(z, sbase, tq, fq, Lrun) : sb_tile<false>(z, sbase, tq, fq, Lrun); }
                    const float pv[8] = {pvv[0][0], pvv[0][1], pvv[0][2], pvv[0][3], pvv[1][0], pvv[1][1], pvv[1][2], pvv[1][3]};
                    u32x4 pw; pw.x = cvt_pk_bf16(pv[0], pv[1]); pw.y = cvt_pk_bf16(pv[2], pv[3]); pw.z = cvt_pk_bf16(pv[4], pv[5]); pw.w = cvt_pk_bf16(pv[6], pv[7]);
                    const bf16x8 pf = __builtin_bit_cast(bf16x8, pw);
#pragma unroll
                    for (int i = 0; i < 4; ++i) { const LAS unsigned char* vr = (const LAS unsigned char*)(Vt + (16 * i + fr) * LP + 32 * sp + 4 * fq);
                        acc[i] = mfma16(ldfrag2(vr, vr + 32), pf, acc[i]); }
                }
            }
            const bool still = __ballot(Lrun >= SB_DEAD) != 0ull;
            if (lane == 0 && still) flags[wid] = 1;
            __syncthreads();
            int any = 0;
#pragma unroll
            for (int i = 0; i < 8; ++i) any |= flags[i];
            if (!any) break;
        }
#pragma unroll
        for (int i = 0; i < 4; ++i) { const int dc = hd * 64 + 16 * i + 4 * fq; const u32x2 z = *(const u32x2*)(PROJ + tokq * NPA + C_SZ + dc);
            u32x2 w; w.x = cvt_pk_bf16(acc[i][0] * bflo(z.x), acc[i][1] * bfhi(z.x)); w.y = cvt_pk_bf16(acc[i][2] * bflo(z.y), acc[i][3] * bfhi(z.y));
            st8(Y + tokq * DM + 768 + dc, w); }
    }
    __syncthreads();
}

__device__ __forceinline__ void final_norm(const Params& p) {
    int tid_ = threadIdx.x; asm volatile("" : "+v"(tid_)); const int tid = tid_, lane = tid & 63, wid = tid >> 6;
    const int stride = gridDim.x * 8; int row = blockIdx.x * 8 + wid;
    f32x4 g[4];
#pragma unroll
    for (int j = 0; j < 4; ++j) g[j] = *(const f32x4*)(p.final_g + j * 256 + lane * 4);
    f32x4 xn[4];
    if (row < NTOK) {
#pragma unroll
        for (int j = 0; j < 4; ++j) xn[j] = *(const f32x4*)(p.out + (size_t)row * DM + j * 256 + lane * 4); }
    for (; row < NTOK; row += stride) {
        float* xr = p.out + (size_t)row * DM; f32x4 xv[4]; float ss = 0.f;
#pragma unroll
        for (int j = 0; j < 4; ++j) { xv[j] = xn[j]; ss += xv[j][0] * xv[j][0] + xv[j][1] * xv[j][1] + xv[j][2] * xv[j][2] + xv[j][3] * xv[j][3]; }
        if (row + stride < NTOK) {
#pragma unroll
            for (int j = 0; j < 4; ++j) xn[j] = *(const f32x4*)(p.out + (size_t)(row + stride) * DM + j * 256 + lane * 4); }
        ss = wave_sum(ss); const float rstd = rsqrtf(ss * (1.f / 1024.f) + EPSF);
#pragma unroll
        for (int j = 0; j < 4; ++j) *(f32x4*)(xr + j * 256 + lane * 4) = xv[j] * rstd * g[j];
    }
}

#define XB_TMO      128
#define XB_XCNT(j)  (256  + 64 * (j))
#define XB_XSUB(j)  (1280 + 64 * (j))
#define XB_XGEN(j)  (2304 + 64 * (j))
#define XB_TOP      3328
#define XB_TOPGEN   3392
#define XCD_BAR_WORDS 3456
#define XB_SPIN_CAP (1u << 18)

__device__ __forceinline__ unsigned xb_ld(unsigned* p)              { return __hip_atomic_load(p, __ATOMIC_RELAXED, __HIP_MEMORY_SCOPE_AGENT); }
__device__ __forceinline__ unsigned xb_add(unsigned* p, unsigned v) { return __hip_atomic_fetch_add(p, v, __ATOMIC_RELAXED, __HIP_MEMORY_SCOPE_AGENT); }
__device__ __forceinline__ unsigned xb_xcc_id() { return (unsigned)__builtin_amdgcn_s_getreg((3 << 11) | 20) & 0xFu; }
#define XB_SPIN(cond, bar) do { unsigned _sp = 0; while (cond) { __builtin_amdgcn_s_sleep(1); \
    if ((++_sp & 255u) == 0u) { if (xb_ld(&(bar)[XB_TMO])) break; if (_sp > XB_SPIN_CAP) { atomicAdd(&(bar)[XB_TMO], 1u); break; } } } } while (0)

struct XcdBarrier {
    unsigned* bar; unsigned x;
    volatile LAS unsigned* st;
};

__device__ __forceinline__ XcdBarrier xcd_barrier_post(unsigned* bar, volatile LAS unsigned* st) {
    XcdBarrier b; b.bar = bar; b.x = xb_xcc_id(); b.st = st;
    if (threadIdx.x == 0) (void)xb_add(&bar[XB_XCNT(b.x)], 1u);
    return b;
}
__device__ __forceinline__ void xcd_barrier_complete(unsigned* bar, unsigned x, unsigned& nloc, unsigned& nx) {
    const unsigned G = gridDim.x * gridDim.y * gridDim.z;
    unsigned sum, cnt, mine, sp = 0u;
    for (;;) {
        sum = 0u; cnt = 0u; mine = 0u;
#pragma unroll
        for (unsigned j = 0; j < 16; ++j) { const unsigned c = xb_ld(&bar[XB_XCNT(j)]); sum += c; cnt += (c > 0u) ? 1u : 0u; mine = (j == x) ? c : mine; }
        if (sum == G) break;
        __builtin_amdgcn_s_sleep(1);
        if ((++sp & 255u) == 0u) { if (xb_ld(&bar[XB_TMO])) break; if (sp > XB_SPIN_CAP) { atomicAdd(&bar[XB_TMO], 1u); break; } }
    }
    nloc = mine > 0u ? mine : 1u; nx = cnt > 0u ? cnt : 1u;
}

__device__ __forceinline__ void xcd_barrier(const XcdBarrier& b) {
    asm volatile("s_waitcnt vmcnt(0)" ::: "memory");
    __syncthreads();
    if (threadIdx.x == 0) {
        unsigned* bar = b.bar;
        __builtin_amdgcn_s_waitcnt(0);
        unsigned nloc = b.st[0], nx = b.st[1];
        if (nloc == 0u) { xcd_barrier_complete(bar, b.x, nloc, nx); b.st[0] = nloc; b.st[1] = nx; }
        const unsigned old = xb_add(&bar[XB_XSUB(b.x)], 1u);
        const unsigned gen = old / nloc;
        if (old + 1u == (gen + 1u) * nloc) {
            __builtin_amdgcn_fence(__ATOMIC_RELEASE, "agent");
            asm volatile("s_waitcnt vmcnt(0)" ::: "memory");
            const unsigned og = xb_add(&bar[XB_TOP], 1u);
            const unsigned tg = og / nx;
            if (og + 1u == (tg + 1u) * nx) xb_add(&bar[XB_TOPGEN], 1u);
            else XB_SPIN(xb_ld(&bar[XB_TOPGEN]) == tg, bar);
            __builtin_amdgcn_fence(__ATOMIC_ACQUIRE, "agent");
            xb_add(&bar[XB_XGEN(b.x)], 1u);
            asm volatile("s_waitcnt vmcnt(0)" ::: "memory");
        } else {
            XB_SPIN(xb_ld(&bar[XB_XGEN(b.x)]) == gen, bar);
            __builtin_amdgcn_fence(__ATOMIC_ACQUIRE, "agent");
            asm volatile("s_waitcnt vmcnt(0)" ::: "memory");
        }
    }
    __syncthreads();
}

constexpr int N_PHASES = 16;
__global__ void __launch_bounds__(512, 2) mk_fwd(Params p) {
    extern __shared__ __attribute__((aligned(16))) unsigned char lds_raw[];
    LAS unsigned char* lds = (LAS unsigned char*)lds_raw;
    cg::grid_group grid = cg::this_grid();
#define GSYNC_CG() do { asm volatile("s_waitcnt vmcnt(0) lgkmcnt(0)" ::: "memory"); __syncthreads(); \
        if (threadIdx.x < 64) { __builtin_amdgcn_fence(__ATOMIC_RELEASE, "agent"); asm volatile("s_waitcnt vmcnt(0)" ::: "memory"); } \
        grid.sync(); \
        if (threadIdx.x < 64) { __builtin_amdgcn_fence(__ATOMIC_ACQUIRE, "agent"); asm volatile("s_waitcnt vmcnt(0)" ::: "memory"); } \
        __syncthreads(); } while (0)
    const bool one_launch = (p.ph_hi - p.ph_lo == N_PHASES);
    volatile LAS unsigned* xst = (volatile LAS unsigned*)(lds + LDS_BYTES - 64);
    if (threadIdx.x == 0) { xst[0] = 0u; xst[1] = 0u; }
    __syncthreads();
    XcdBarrier xbar; xbar.bar = (unsigned*)(p.ws + WS_SMALL + SM_XBAR); xbar.x = 0; xbar.st = xst;
    if (one_launch) xbar = xcd_barrier_post((unsigned*)(p.ws + WS_SMALL + SM_XBAR), xst);
    if (one_launch) grid.sync();
#define GSYNC() do { if (one_launch) xcd_barrier(xbar); else GSYNC_CG(); } while (0)
#pragma unroll 1
    for (int ph = p.ph_lo; ph < p.ph_hi; ++ph) {
        if (ph == 0) { phase_mod(p, (float*)(p.ws + WS_SMALL + SM_MODP)); }
        else if (ph == N_PHASES - 1) { if (gridDim.x != 256) final_norm(p); }
        else {
        int l = (ph - 1) / 7, k = (ph - 1) % 7; asm volatile("" : "+s"(l), "+s"(k));
        const float* xin = (l == 0) ? p.x : p.out;
        int G = gridDim.x, bx = blockIdx.x; asm volatile("" : "+s"(G), "+s"(bx));
        size_t wz_ = 0; asm volatile("" : "+s"(wz_)); unsigned char* ws = p.ws + wz_;
        if (k == 0) { phase_prep(p, l, xin, lds, ws); }
        else if (k == 1) {
        {
            pg8::Gemm g{(const bf16_t*)(ws + WS_H), (const bf16_t*)(ws + WS_WIN), NTOK, NPA, DM, DM, DM}; pg8::StaticOrder S; S.init(NTOK, NPA, G, bx);
            EpiProj E{(bf16_t*)(ws + WS_PROJ), NPA, 0}; NoHook HK; f32x4 acc[2][2][4][2];
            pg8::gemm_phase<EpiProj, pg8::StaticOrder, NoHook, true, true>(lds, g, S, E, HK, acc);
        }
        }
        else if (k == 2) { mlstm_m1(p, l, lds, ws); pool_phase(p, l, lds, ws); }
        else if (k == 3) {
            if (G == 256) {
                int tx_ = threadIdx.x; asm volatile("" : "+v"(tx_)); const int idx = bx * 512 + tx_;
                float dcv[64]; scan_load(dcv, ws, idx);
                sb_phase(p, lds, ws, bx, 256);
                scan_finish(dcv, l, ws, idx);
                mlstm_scan_n(l, ws);
                sb_phase(p, lds, ws, 256 + bx, 512);
            } else { mlstm_scan(l, ws); mlstm_scan_n(l, ws); sb_phase(p, lds, ws, bx, 512); }
        }
        else if (k == 4) { mlstm_m3(p, l, lds, ws); }
        else if (k == 5) {
        {
            pg8::StaticOrder S; S.init(NTOK, DM, G, bx); pg8::Unit u; NoHook HK; f32x4 acc[2][2][4][2];
            const bf16_t* Gp = (const bf16_t*)(ws + WS_G); const bf16_t* Yp = (const bf16_t*)(ws + WS_Y); const bf16_t* Wb = (const bf16_t*)(ws + WS_WBR);
            for (int i = 0; S.next(i, u); ++i) {
                { pg8::Gemm g{(const bf16_t*)(ws + WS_H), (const bf16_t*)(ws + WS_WIN) + (size_t)NPA * 1024, NTOK, NG, DM, DM, DM}; GateOrder GO{u.pm, u.pn};
                  EpiProj E{(bf16_t*)(ws + WS_G), NG, 1};
                  pg8::gemm_phase<EpiProj, GateOrder, NoHook, true, true>(lds, g, GO, E, HK, acc); }
                __syncthreads();
                OneUnit OU{u.pm, u.pn}; EpiNone EN;
                { pg8::Gemm g{Yp, Wb, NTOK, DM, 512, DM, DM};
                  pg8::gemm_phase<EpiNone, OneUnit, NoHook, false, true, true>(lds, g, OU, EN, HK, acc); }
                gate_rescale(acc, Gp, p.gate_b + l * NG, u.pm, u.pn, 0); __syncthreads();
                { pg8::Gemm g{Yp + 512, Wb + 512, NTOK, DM, 256, DM, DM};
                  pg8::gemm_phase<EpiNone, OneUnit, NoHook, false, true, false>(lds, g, OU, EN, HK, acc); }
                gate_rescale(acc, Gp, p.gate_b + l * NG, u.pm, u.pn, 1024); __syncthreads();
                { pg8::Gemm g{Yp + 768, Wb + 768, NTOK, DM, 256, DM, DM}; EpiMerge E{(bf16_t*)(ws + WS_MERGED), Gp, p.gate_b + l * NG};
                  pg8::gemm_phase<EpiMerge, OneUnit, NoHook, false, true, false>(lds, g, OU, E, HK, acc); }
                __syncthreads();
            }
        }
        }
        else {
        {
            pg8::Gemm g{(const bf16_t*)(ws + WS_MERGED), (const bf16_t*)(ws + WS_WOUT), NTOK, DM, DM, DM, DM}; pg8::StaticOrder S; S.init(NTOK, DM, G, bx); pg8::Unit u;
            NoHook HK; f32x4 acc[2][2][4][2];
            if (l == 1 && G == 256) {
                EpiOutNorm E{xin, p.out, (const float*)(ws + WS_SMALL + SM_GATEV) + l * 2048, p.final_g, (unsigned long long*)(ws + WS_SMALL + SM_XEX), (unsigned*)(ws + WS_SMALL + SM_XBAR + 16384)};
                for (int i = 0; S.next(i, u); ++i) { OneUnit OU{u.pm, u.pn};
                    pg8::gemm_phase<EpiOutNorm, OneUnit, NoHook, false, true>(lds, g, OU, E, HK, acc); __syncthreads(); }
            } else {
                EpiOut E{xin, p.out, (const float*)(ws + WS_SMALL + SM_GATEV) + l * 2048};
                for (int i = 0; S.next(i, u); ++i) { OneUnit OU{u.pm, u.pn};
                    pg8::gemm_phase<EpiOut, OneUnit, NoHook, false, true>(lds, g, OU, E, HK, acc); __syncthreads(); }
            }
        }
        }
        }
        if (ph + 1 < p.ph_hi && !(gridDim.x == 256 && ph == N_PHASES - 2)) GSYNC();
    }
}

extern "C" void kernel_launch(void* const* d_in, const int* in_sizes, int n_in, void* d_out, int out_size, void* d_ws, size_t ws_size, hipStream_t stream) {
    static int grid_blocks = 0;
    if (grid_blocks == 0) {
        int dev = 0, cus = 0, per_cu = 0;
        if (n_in != 18 || out_size != NTOK * DM || ws_size < WS_SMALL + SM_END) { fprintf(stderr, "kernel_launch: unexpected shapes (n_in %d out %d ws %zu)\n", n_in, out_size, ws_size); grid_blocks = -1; return; }
        hipGetDevice(&dev); hipDeviceGetAttribute(&cus, hipDeviceAttributeMultiprocessorCount, dev);
        if (hipFuncSetAttribute((const void*)mk_fwd, hipFuncAttributeMaxDynamicSharedMemorySize, LDS_BYTES) != hipSuccess) { fprintf(stderr, "kernel_launch: hipFuncSetAttribute failed\n"); }
        if (hipOccupancyMaxActiveBlocksPerMultiprocessor(&per_cu, (const void*)mk_fwd, 512, LDS_BYTES) != hipSuccess || per_cu < 1) { fprintf(stderr, "kernel_launch: occupancy query gave %d\n", per_cu); per_cu = 1; }
        (void)hipGetLastError();
        grid_blocks = cus * per_cu;
    }
    if (grid_blocks < 0) return;
    Params p{};
    const float** f = (const float**)&p;
    for (int i = 0; i < 18; ++i) f[i] = (const float*)d_in[i];
    p.out = (float*)d_out; p.ws = (unsigned char*)d_ws;
#ifndef MK_PHASES_PER_LAUNCH
#define MK_PHASES_PER_LAUNCH N_PHASES
#endif
    (void)hipMemsetAsync((unsigned char*)d_ws + WS_SMALL + SM_XBAR, 0, XBAR_BYTES, stream);
    for (int lo = 0; lo < N_PHASES; lo += MK_PHASES_PER_LAUNCH) {
        p.ph_lo = lo; p.ph_hi = lo + MK_PHASES_PER_LAUNCH < N_PHASES ? lo + MK_PHASES_PER_LAUNCH : N_PHASES;
        void* args[] = {&p};
        hipError_t e = hipLaunchCooperativeKernel((const void*)mk_fwd, dim3(grid_blocks), dim3(512), args, LDS_BYTES, stream);
        if (e != hipSuccess) { fprintf(stderr, "cooperative launch failed: %s (grid %d)\n", hipGetErrorString(e), grid_blocks); break; }
    }
}
```

```cpp
#include <hip/hip_runtime.h>
#include <hip/hip_cooperative_groups.h>
#include <cstdio>
#include <cstdint>
#include <cstddef>
namespace cg = cooperative_groups;
namespace pg8 {
#define PG8_LAS __attribute__((address_space(3)))
typedef unsigned short bf16_t;
typedef short bf16x8 __attribute__((ext_vector_type(8)));
typedef float f32x4 __attribute__((ext_vector_type(4)));
typedef unsigned u32x4 __attribute__((ext_vector_type(4)));
constexpr int BM = 256, BK = 64, HALF = 128, HTB = HALF * BK * 2  , STAGE_BYTES = 8 * HTB, NXCD = 8, WGM = 8;

__host__ __device__ __forceinline__ int lds_byte(int r, int c) { const int st = (r >> 4) * 2 + (c >> 5), rr = r & 15, cc = c & 31, ob = rr * 64 + cc * 2; return st * 1024 + (ob ^ (((ob >> 9) & 1) << 5)); }
__host__ __device__ __forceinline__ void stage_rc(int b, int& R, int& C) { const int st = b / 1024, sb = b % 1024, swz = sb ^ (((sb >> 9) & 1) << 5); R = (st >> 1) * 16 + swz / 64; C = (st & 1) * 32 + (swz % 64) / 2; }
__host__ __device__ __forceinline__ int perm32(int rho) { const int n = rho >> 4, i = rho & 15; return 8 * (i >> 2) + 4 * n + (i & 3); }

struct Unit { int pm, pn; };
struct Gemm { const bf16_t* A; const bf16_t* Bt; int M, N, K, lda, ldb; };

struct StaticOrder {
    int nM, nN, nwg, G, c;
    __host__ __device__ void init(int M, int N, int G_, int c_) { nM = M / BM; nN = N / BM; nwg = nM * nN; G = G_; c = c_; }
    __host__ __device__ bool next(int i, Unit& u) const {
        const long L = (long)i * G + c; if (L >= nwg) return false;
        int wgid = (int)L; { const int q = nwg / NXCD, r = nwg % NXCD, xcd = wgid % NXCD, off = wgid / NXCD; wgid = (xcd < r ? xcd * (q + 1) : r * (q + 1) + (xcd - r) * q) + off; }
        const int nig = WGM * nN, gid = wgid / nig, fm = gid * WGM, gsz = (nM - fm) < WGM ? (nM - fm) : WGM;
        u.pm = fm + ((wgid % nig) % gsz); u.pn = (wgid % nig) / gsz; return true;
    }
    __device__ __forceinline__ void a_ready(const Unit&) const {}
    __device__ __forceinline__ void done(const Unit&) const {}
};

__device__ __forceinline__ unsigned cvt_pk_bf16(float lo, float hi) { unsigned r; asm volatile("v_cvt_pk_bf16_f32 %0, %1, %2" : "=v"(r) : "v"(lo), "v"(hi)); return r; }
template <class Epi, class Sched, class Hook, bool ALIGN_EPI = false, bool SP2 = false, bool ZERO_ACC = true>
__device__ __forceinline__ void gemm_phase(PG8_LAS unsigned char* lds, const Gemm g, const Sched& S, const Epi& E, const Hook& HK, f32x4 (&acc)[2][2][4][2]) {
    int tid_ = threadIdx.x; asm volatile("" : "+v"(tid_));
    const int tid = tid_, wid = __builtin_amdgcn_readfirstlane(tid >> 6), lane = tid & 63, wr = wid >> 2, wc = wid & 3, fr = lane & 15, fq = lane >> 4;
    const int K = g.K, nt = K / BK;
    unsigned voffA[2], voffB[2];
#pragma unroll
    for (int i = 0; i < 2; ++i) { int R, C; stage_rc(tid * 16 + i * 8192, R, C); const int Rb = Epi::PERM ? ((R & ~31) + perm32(R & 31)) : R;
        voffA[i] = (unsigned)(R * g.lda + C) * 2u; voffB[i] = (unsigned)(Rb * g.ldb + C) * 2u; }
    const size_t kstep = (size_t)(BK * 2);
    const size_t hstepA = (size_t)HALF * g.lda * 2, hstepB = (size_t)HALF * g.ldb * 2;
    const size_t tstepA = 2 * hstepA, tstepB = 2 * hstepB;
    const unsigned ldsw = (unsigned)wid * 1024u;
    const int aoff = lds_byte(wr * 64 + fr, fq * 8), boff = lds_byte(wc * 32 + fr, fq * 8);
#define PG8_SA(b, h) (((b) * 2 + (h)) * HTB)
#define PG8_SB(b, h) ((4 + (b) * 2 + (h)) * HTB)
#define PG8_STAGE(bufoff, gbase, voff) do { _Pragma("unroll") for (int _i = 0; _i < 2; ++_i) \
        __builtin_amdgcn_global_load_lds((const unsigned*)((const char*)(gbase) + (voff)[_i]), (PG8_LAS unsigned*)(lds + (bufoff) + ldsw + _i * 8192), 16, 0, 0); } while (0)
#define PG8_LDA(dst, b, h) do { _Pragma("unroll") for (int m = 0; m < 4; ++m) _Pragma("unroll") for (int k = 0; k < 2; ++k) dst[m][k] = *(const PG8_LAS bf16x8*)(lds + PG8_SA(b, h) + aoff + m * 2048 + k * 1024); } while (0)
#define PG8_LDB(dst, b, h) do { _Pragma("unroll") for (int n = 0; n < 2; ++n) _Pragma("unroll") for (int k = 0; k < 2; ++k) dst[n][k] = *(const PG8_LAS bf16x8*)(lds + PG8_SB(b, h) + boff + n * 2048 + k * 1024); } while (0)
#define PG8_MMA(ai, bj, At, Bt) do { __builtin_amdgcn_s_setprio(1); _Pragma("unroll") for (int m = 0; m < 4; ++m) _Pragma("unroll") for (int n = 0; n < 2; ++n) _Pragma("unroll") for (int k = 0; k < 2; ++k) \
        acc[ai][bj][m][n] = __builtin_amdgcn_mfma_f32_16x16x32_bf16(Bt[n][k], At[m][k], acc[ai][bj][m][n], 0, 0, 0); __builtin_amdgcn_s_setprio(0); } while (0)
#define PG8_WAIT_V(n) asm volatile("s_waitcnt vmcnt(" #n ")" ::: "memory")
#define PG8_WAIT_L(n) asm volatile("s_waitcnt lgkmcnt(" #n ")" ::: "memory")
#define PG8_BAR __builtin_amdgcn_s_barrier()
#define PG8_SCHED __builtin_amdgcn_sched_barrier(0)
    Unit cur, nxt; int ui = 0;
    if (!S.next(0, cur)) return;
    if constexpr (ZERO_ACC) {
#pragma unroll
    for (int a = 0; a < 2; ++a)
#pragma unroll
        for (int b = 0; b < 2; ++b)
#pragma unroll
            for (int m = 0; m < 4; ++m)
#pragma unroll
                for (int n = 0; n < 2; ++n) acc[a][b][m][n] = (f32x4){0.f, 0.f, 0.f, 0.f};
    }
    bf16x8 At[4][2], B0[2][2], B1[2][2];
    const char* cA = (const char*)g.A + (size_t)cur.pm * tstepA; const char* cB = (const char*)g.Bt + (size_t)cur.pn * tstepB;
    S.a_ready(cur);
    if constexpr (SP2) {
        PG8_STAGE(PG8_SB(0, 0), cB, voffB); PG8_STAGE(PG8_SB(0, 1), cB + hstepB, voffB); PG8_STAGE(PG8_SA(0, 0), cA, voffA); PG8_STAGE(PG8_SA(0, 1), cA + hstepA, voffA);
        if (wr == 1) PG8_BAR;
        PG8_WAIT_V(2); PG8_BAR;
        PG8_STAGE(PG8_SB(1, 0), cB + kstep, voffB); PG8_STAGE(PG8_SA(1, 0), cA + kstep, voffA); PG8_STAGE(PG8_SB(1, 1), cB + hstepB + kstep, voffB);
        PG8_WAIT_V(6); PG8_BAR;
    } else {
        PG8_STAGE(PG8_SB(0, 0), cB, voffB); PG8_STAGE(PG8_SA(0, 0), cA, voffA); PG8_STAGE(PG8_SB(0, 1), cB + hstepB, voffB); PG8_STAGE(PG8_SA(0, 1), cA + hstepA, voffA);
        if (wr == 1) PG8_BAR;
        PG8_WAIT_V(4); PG8_BAR;
        PG8_STAGE(PG8_SB(1, 0), cB + kstep, voffB); PG8_STAGE(PG8_SA(1, 0), cA + kstep, voffA); PG8_STAGE(PG8_SB(1, 1), cB + hstepB + kstep, voffB);
        PG8_WAIT_V(6); PG8_BAR;
    }
    for (;;) {
        const bool has_next = S.next(ui + 1, nxt);
        const char* nA = has_next ? (const char*)g.A + (size_t)nxt.pm * tstepA : cA; const char* nB = has_next ? (const char*)g.Bt + (size_t)nxt.pn * tstepB : cB;
#pragma nounroll
        for (int t = 0; t < nt; t += 2) {
            const bool last = (t == nt - 2);
            if constexpr (Hook::ON) { if (t == Hook::T1 || t == Hook::T2) HK(acc, cur, t, wr, wc, fr, fq); }
            const char* a1 = cA + (size_t)(t + 1) * kstep;
            const char* a2 = last ? nA : cA + (size_t)(t + 2) * kstep; const char* b2 = last ? nB : cB + (size_t)(t + 2) * kstep;
            const char* a3 = a2 + kstep; const char* b3 = b2 + kstep;
            if (last && has_next) S.a_ready(nxt);
            if constexpr (SP2) {
            PG8_LDB(B0, 0, 0); PG8_LDB(B1, 0, 1); PG8_SCHED; PG8_LDA(At, 0, 0); PG8_STAGE(PG8_SA(1, 1), a1 + hstepA, voffA);
            PG8_WAIT_V(8); PG8_WAIT_L(0); PG8_BAR; PG8_MMA(0, 0, At, B0); PG8_MMA(0, 1, At, B1); PG8_BAR; PG8_SCHED;
            PG8_LDA(At, 0, 1); PG8_STAGE(PG8_SB(0, 0), b2, voffB); PG8_STAGE(PG8_SB(0, 1), b2 + hstepB, voffB); PG8_STAGE(PG8_SA(0, 0), a2, voffA);
            PG8_WAIT_V(8); PG8_WAIT_L(0); PG8_BAR; PG8_MMA(1, 0, At, B0); PG8_MMA(1, 1, At, B1); PG8_BAR; PG8_SCHED;
            PG8_LDB(B0, 1, 0); PG8_LDB(B1, 1, 1); PG8_SCHED; PG8_LDA(At, 1, 0); PG8_STAGE(PG8_SA(0, 1), a2 + hstepA, voffA);
            PG8_WAIT_V(8); PG8_WAIT_L(0); PG8_BAR; PG8_MMA(0, 0, At, B0); PG8_MMA(0, 1, At, B1); PG8_BAR; PG8_SCHED;
            PG8_LDA(At, 1, 1); PG8_STAGE(PG8_SB(1, 0), b3, voffB); PG8_STAGE(PG8_SB(1, 1), b3 + hstepB, voffB); PG8_STAGE(PG8_SA(1, 0), a3, voffA);
            PG8_WAIT_V(8); PG8_WAIT_L(0); PG8_BAR; PG8_MMA(1, 0, At, B0); PG8_MMA(1, 1, At, B1); PG8_BAR; PG8_SCHED;
            } else {
            PG8_LDB(B0, 0, 0); PG8_SCHED; PG8_LDA(At, 0, 0); PG8_STAGE(PG8_SA(1, 1), a1 + hstepA, voffA);
            PG8_WAIT_L(8); PG8_BAR; PG8_WAIT_L(0); PG8_MMA(0, 0, At, B0); PG8_BAR; PG8_SCHED;
            PG8_LDB(B1, 0, 1); PG8_STAGE(PG8_SB(0, 0), b2, voffB);
            PG8_BAR; PG8_WAIT_L(0); PG8_MMA(0, 1, At, B1); PG8_BAR;
            PG8_LDA(At, 0, 1); PG8_STAGE(PG8_SA(0, 0), a2, voffA);
            PG8_BAR; PG8_WAIT_L(0); PG8_MMA(1, 0, At, B0); PG8_BAR; PG8_SCHED;
            PG8_STAGE(PG8_SB(0, 1), b2 + hstepB, voffB);
            PG8_WAIT_V(6); PG8_BAR; PG8_MMA(1, 1, At, B1); PG8_BAR;
            PG8_LDB(B0, 1, 0); PG8_SCHED; PG8_LDA(At, 1, 0); PG8_STAGE(PG8_SA(0, 1), a2 + hstepA, voffA);
            PG8_WAIT_L(8); PG8_BAR; PG8_WAIT_L(0); PG8_MMA(0, 0, At, B0); PG8_BAR; PG8_SCHED;
            PG8_LDB(B1, 1, 1); PG8_STAGE(PG8_SB(1, 0), b3, voffB);
            PG8_BAR; PG8_WAIT_L(0); PG8_MMA(0, 1, At, B1); PG8_BAR;
            PG8_LDA(At, 1, 1); PG8_STAGE(PG8_SA(1, 0), a3, voffA);
            PG8_BAR; PG8_WAIT_L(0); PG8_MMA(1, 0, At, B0); PG8_BAR; PG8_SCHED;
            PG8_STAGE(PG8_SB(1, 1), b3 + hstepB, voffB);
            PG8_WAIT_V(6); PG8_BAR; PG8_MMA(1, 1, At, B1); PG8_BAR;
            }
        }
        if constexpr (ALIGN_EPI) { if (wr == 0) PG8_BAR; }
        if constexpr (!Epi::AFTER_DRAIN) { E(acc, cur, wr, wc, fr, fq); S.done(cur); }
        if (!has_next) break;
#pragma unroll
        for (int a = 0; a < 2; ++a)
#pragma unroll
            for (int b = 0; b < 2; ++b)
#pragma unroll
                for (int m = 0; m < 4; ++m)
#pragma unroll
                    for (int n = 0; n < 2; ++n) acc[a][b][m][n] = (f32x4){0.f, 0.f, 0.f, 0.f};
        cur = nxt; cA = nA; cB = nB; ++ui;
        if constexpr (ALIGN_EPI) { if (wr == 1) PG8_BAR; }
    }
    PG8_WAIT_V(0);
    if constexpr (!ALIGN_EPI) { if (wr == 0) PG8_BAR; }
    PG8_BAR;
    if constexpr (Epi::AFTER_DRAIN) { E.fused(acc, cur, wr, wc, fr, fq, lds, wid, lane); S.done(cur); }
#undef PG8_SA
#undef PG8_SB
#undef PG8_STAGE
#undef PG8_LDA
#undef PG8_LDB
#undef PG8_MMA
#undef PG8_WAIT_V
#undef PG8_WAIT_L
#undef PG8_BAR
#undef PG8_SCHED
}
}
#define LAS __attribute__((address_space(3)))
typedef unsigned short bf16_t;
typedef short bf16x8 __attribute__((ext_vector_type(8)));
typedef float f32x4 __attribute__((ext_vector_type(4)));
typedef unsigned u32x4 __attribute__((ext_vector_type(4)));
typedef unsigned u32x2 __attribute__((ext_vector_type(2)));
using pg8::cvt_pk_bf16;

constexpr int NTOK = 16384, DM = 1024, SEQ = 8192, NIN = 7176;
constexpr int NPA = 4096;
constexpr int NG = 3072;
constexpr float EPSF = 1e-6f;
constexpr int C_MQ = 0, C_MK = 512, C_MV = 1024, C_MO = 1536, C_MZ = 2048, C_PU = 2560, C_PZ = 2816, C_SQ = 3072, C_SK = 3328, C_SV = 3584, C_SZ = 3840;
constexpr size_t MiB = 1u << 20;
constexpr size_t WS_WIN = 0, WS_WBR = 14 * MiB, WS_WOUT = 16 * MiB, WS_H = 18 * MiB, WS_Y = 50 * MiB, WS_PROJ = 82 * MiB, WS_G = 82 * MiB, WS_MERGED = 178 * MiB,
                 WS_DC = 210 * MiB, WS_SMALL = 242 * MiB;
constexpr size_t SM_MODP = 0;
constexpr size_t SM_GATEV = SM_MODP + 2 * 16 * 2 * 3072 * 4;
constexpr size_t SM_IF = SM_GATEV + 2 * 2 * 1024 * 4;
constexpr size_t SM_DN = SM_IF + 2 * (size_t)NTOK * 8 * 4;
constexpr size_t SM_BEND = SM_DN + 2 * 512 * 128 * 4;
constexpr size_t SM_AMAX = SM_BEND + 4;
constexpr size_t SM_MPREV = SM_BEND + 2 * 512 * 128;
constexpr size_t SM_CPB = (SM_MPREV + 2 * 512 * 4 + 255) & ~(size_t)255;
constexpr size_t SM_XBAR = SM_CPB + (size_t)256 * 32768;
constexpr size_t XBAR_BYTES = 32768;
constexpr size_t SM_XEX = SM_XBAR + XBAR_BYTES;
constexpr size_t SM_END = SM_XEX + (size_t)NTOK * 4 * 8;
static_assert(WS_SMALL + SM_END <= 256 * MiB, "workspace map");
__device__ __forceinline__ bf16_t* cprev_slot(unsigned char* ws, int u) { return (bf16_t*)(u < 256 ? ws + WS_WIN + (size_t)u * 32768 : ws + WS_SMALL + SM_CPB + (size_t)(u - 256) * 32768); }
constexpr int LDS_BYTES = 147456;

struct Params {
    const float *x, *c, *norm_g, *w_ada, *b_ada, *w_in, *m_gate_b, *conv_w, *conv_b, *m_norm_g, *pool_w, *pool_scale, *w_br_m, *w_br_p, *w_br_s, *gate_b, *w_out, *final_g;
    float* out; unsigned char* ws; int ph_lo, ph_hi;
};

__device__ __forceinline__ float bf2f(unsigned short h) { return __uint_as_float(((unsigned)h) << 16); }
__device__ __forceinline__ float bflo(unsigned w) { return __uint_as_float(w << 16); }
__device__ __forceinline__ float bfhi(unsigned w) { return __uint_as_float(w & 0xffff0000u); }
__device__ __forceinline__ unsigned short f2bf(float f) { return (unsigned short)(cvt_pk_bf16(f, 0.f) & 0xffffu); }
__device__ __forceinline__ float fsigmoid(float x) { return __builtin_amdgcn_rcpf(1.f + __expf(-x)); }
__device__ __forceinline__ float fsilu(float x) { return x * fsigmoid(x); }
__device__ __forceinline__ float logsig(float x) { return fminf(x, 0.f) - log1pf(__expf(-fabsf(x))); }
__device__ __forceinline__ float wave_sum(float v) {
#pragma unroll
    for (int m = 32; m >= 1; m >>= 1) v += __shfl_xor(v, m);
    return v;
}
__device__ __forceinline__ f32x4 mfma16(bf16x8 a, bf16x8 b, f32x4 c) { return __builtin_amdgcn_mfma_f32_16x16x32_bf16(a, b, c, 0, 0, 0); }
__device__ __forceinline__ bf16x8 ldfrag(const LAS unsigned char* p) { return *(const LAS bf16x8*)p; }
__device__ __forceinline__ bf16x8 ldfrag2(const LAS unsigned char* pa, const LAS unsigned char* pb) {
    const u32x2 a = *(const LAS u32x2*)pa, b = *(const LAS u32x2*)pb; const u32x4 c = {a.x, a.y, b.x, b.y}; return __builtin_bit_cast(bf16x8, c);
}

#ifndef MK_WT
#define MK_WT 0
#endif
#if MK_WT
__device__ __forceinline__ void st16(void* p, u32x4 v) { asm volatile("global_store_dwordx4 %0, %1, off sc0 sc1\n\ts_nop 1" :: "v"(p), "v"(v) : "memory"); }
__device__ __forceinline__ void st16f(void* p, f32x4 v) { asm volatile("global_store_dwordx4 %0, %1, off sc0 sc1\n\ts_nop 1" :: "v"(p), "v"(v) : "memory"); }
__device__ __forceinline__ void st8(void* p, u32x2 v) { asm volatile("global_store_dwordx2 %0, %1, off sc0 sc1\n\ts_nop 1" :: "v"(p), "v"(v) : "memory"); }
__device__ __forceinline__ void st4(void* p, unsigned v) { asm volatile("global_store_dword %0, %1, off sc0 sc1\n\ts_nop 1" :: "v"(p), "v"(v) : "memory"); }
__device__ __forceinline__ void st4f(void* p, float v) { asm volatile("global_store_dword %0, %1, off sc0 sc1\n\ts_nop 1" :: "v"(p), "v"(v) : "memory"); }
#else
__device__ __forceinline__ void st16(void* p, u32x4 v) { *(u32x4*)p = v; }
__device__ __forceinline__ void st16f(void* p, f32x4 v) { *(f32x4*)p = v; }
__device__ __forceinline__ void st8(void* p, u32x2 v) { *(u32x2*)p = v; }
__device__ __forceinline__ void st4(void* p, unsigned v) { *(unsigned*)p = v; }
__device__ __forceinline__ void st4f(void* p, float v) { *(float*)p = v; }
#endif

struct NoHook { static constexpr bool ON = false; static constexpr int T1 = -1, T2 = -1;
    __device__ __forceinline__ void operator()(f32x4 (&)[2][2][4][2], const pg8::Unit&, int, int, int, int, int) const {} };

struct EpiProj {
    static constexpr bool PERM = true, AFTER_DRAIN = false;
    bf16_t* O; int pitch; int raw;
    __device__ __forceinline__ void operator()(const f32x4 (&acc)[2][2][4][2], const pg8::Unit& u, int wr, int wc, int fr, int fq) const {
        const int pn = u.pn; const int act = raw ? 0 : ((pn == 6 || pn == 7) ? 1 : ((pn == 8 || pn == 9 || pn == 11 || pn == 15) ? 2 : (pn == 12 ? 3 : 0)));
        const int row0 = u.pm * 256 + wr * 64 + fr, col0 = pn * 256 + wc * 32 + 8 * fq;
#pragma unroll
        for (int ai = 0; ai < 2; ++ai)
#pragma unroll
            for (int m = 0; m < 4; ++m) { bf16_t* rowp = O + (size_t)(row0 + ai * 128 + m * 16) * pitch + col0;
#pragma unroll
                for (int bj = 0; bj < 2; ++bj) { float v[8];
#pragma unroll
                    for (int e = 0; e < 4; ++e) { v[e] = acc[ai][bj][m][0][e]; v[4 + e] = acc[ai][bj][m][1][e]; }
                    if (act == 1) {
#pragma unroll
                        for (int e = 0; e < 8; ++e) v[e] = fsigmoid(v[e]);
                    } else if (act == 2) {
#pragma unroll
                        for (int e = 0; e < 8; ++e) v[e] = fsilu(v[e]);
                    } else if (act == 3) {
#pragma unroll
                        for (int e = 0; e < 8; ++e) v[e] *= 0.18033688011112042f;
                    }
                    u32x4 w; w.x = cvt_pk_bf16(v[0], v[1]); w.y = cvt_pk_bf16(v[2], v[3]); w.z = cvt_pk_bf16(v[4], v[5]); w.w = cvt_pk_bf16(v[6], v[7]);
                    st16(rowp + bj * 128, w); } }
    }
};

__device__ __forceinline__ void gate_rescale(f32x4 (&acc)[2][2][4][2], const bf16_t* G, const float* gbias, int pm, int pn, int goff) {
    int tx_ = threadIdx.x; asm volatile("" : "+v"(tx_)); const int wid = tx_ >> 6, lane = tx_ & 63, wr = wid >> 2, wc = wid & 3, fr = lane & 15, fq = lane >> 4;
    const int row0 = pm * 256 + wr * 64 + fr, col0 = pn * 256 + wc * 32 + 8 * fq;
    __builtin_amdgcn_sched_barrier(0);
#pragma unroll
    for (int bj = 0; bj < 2; ++bj) {
        const f32x4 ba0 = *(const f32x4*)(gbias + goff + col0 + bj * 128), ba1 = *(const f32x4*)(gbias + goff + col0 + bj * 128 + 4);
        const f32x4 bb0 = *(const f32x4*)(gbias + goff + 1024 + col0 + bj * 128), bb1 = *(const f32x4*)(gbias + goff + 1024 + col0 + bj * 128 + 4);
#pragma unroll
        for (int ai = 0; ai < 2; ++ai)
#pragma unroll
            for (int m = 0; m < 4; ++m) { const bf16_t* rowp = G + (size_t)(row0 + ai * 128 + m * 16) * NG + goff + col0 + bj * 128;
                const u32x4 a = *(const u32x4*)rowp, b = *(const u32x4*)(rowp + 1024);
                const unsigned aw[4] = {a.x, a.y, a.z, a.w}, bw[4] = {b.x, b.y, b.z, b.w};
                f32x4 r0, r1;
#pragma unroll
                for (int e = 0; e < 2; ++e) {
                    r0[2 * e]     = (1.f + __expf(-(bflo(bw[e]) + bb0[2 * e])))         * __builtin_amdgcn_rcpf(1.f + __expf(-(bflo(aw[e]) + ba0[2 * e])));
                    r0[2 * e + 1] = (1.f + __expf(-(bfhi(bw[e]) + bb0[2 * e + 1])))     * __builtin_amdgcn_rcpf(1.f + __expf(-(bfhi(aw[e]) + ba0[2 * e + 1])));
                    r1[2 * e]     = (1.f + __expf(-(bflo(bw[2 + e]) + bb1[2 * e])))     * __builtin_amdgcn_rcpf(1.f + __expf(-(bflo(aw[2 + e]) + ba1[2 * e])));
                    r1[2 * e + 1] = (1.f + __expf(-(bfhi(bw[2 + e]) + bb1[2 * e + 1]))) * __builtin_amdgcn_rcpf(1.f + __expf(-(bfhi(aw[2 + e]) + ba1[2 * e + 1]))); }
                acc[ai][bj][m][0] *= r0; acc[ai][bj][m][1] *= r1;
                asm volatile("" : "+v"(acc[ai][bj][m][0]), "+v"(acc[ai][bj][m][1]) :: "memory");
                __builtin_amdgcn_sched_barrier(0); }
    }
    asm volatile("s_waitcnt vmcnt(0)" ::: "memory"); __builtin_amdgcn_sched_barrier(0);
}
struct EpiNone { static constexpr bool PERM = true, AFTER_DRAIN = true;
    __device__ __forceinline__ void fused(const f32x4 (&)[2][2][4][2], const pg8::Unit&, int, int, int, int, LAS unsigned char*, int, int) const {} };
struct EpiMerge {
    static constexpr bool PERM = true, AFTER_DRAIN = true;
    bf16_t* O; const bf16_t* G; const float* gbias;
    __device__ __forceinline__ void fused(const f32x4 (&acc)[2][2][4][2], const pg8::Unit& u, int wr, int wc, int fr, int fq, LAS unsigned char*, int, int) const {
        const int row0 = u.pm * 256 + wr * 64 + fr, col0 = u.pn * 256 + wc * 32 + 8 * fq;
#pragma unroll
        for (int ai = 0; ai < 2; ++ai)
#pragma unroll
            for (int m = 0; m < 4; ++m) { const size_t row = (size_t)(row0 + ai * 128 + m * 16);
#pragma unroll
                for (int bj = 0; bj < 2; ++bj) { const u32x4 g = *(const u32x4*)(G + row * NG + 2048 + col0 + bj * 128);
                    const f32x4 b0 = *(const f32x4*)(gbias + 2048 + col0 + bj * 128), b1 = *(const f32x4*)(gbias + 2048 + col0 + bj * 128 + 4);
                    const f32x4 a0 = acc[ai][bj][m][0], a1 = acc[ai][bj][m][1];
                    u32x4 w; w.x = cvt_pk_bf16(a0[0] * fsigmoid(bflo(g.x) + b0[0]), a0[1] * fsigmoid(bfhi(g.x) + b0[1])); w.y = cvt_pk_bf16(a0[2] * fsigmoid(bflo(g.y) + b0[2]), a0[3] * fsigmoid(bfhi(g.y) + b0[3]));
                    w.z = cvt_pk_bf16(a1[0] * fsigmoid(bflo(g.z) + b1[0]), a1[1] * fsigmoid(bfhi(g.z) + b1[1])); w.w = cvt_pk_bf16(a1[2] * fsigmoid(bflo(g.w) + b1[2]), a1[3] * fsigmoid(bfhi(g.w) + b1[3]));
                    st16(O + row * DM + col0 + bj * 128, w); } }
    }
};
struct EpiOut {
    static constexpr bool PERM = true, AFTER_DRAIN = true;
    const float* xin; float* xout; const float* gate;
    __device__ __forceinline__ void fused(const f32x4 (&acc)[2][2][4][2], const pg8::Unit& u, int wr, int wc, int fr, int fq, LAS unsigned char*, int, int) const {
        const int row0 = u.pm * 256 + wr * 64 + fr, col0 = u.pn * 256 + wc * 32 + 8 * fq; const float* gb = gate + ((u.pm * 256) / SEQ) * 1024;
#pragma unroll
        for (int bj = 0; bj < 2; ++bj) {
            const f32x4 g0 = *(const f32x4*)(gb + col0 + bj * 128), g1 = *(const f32x4*)(gb + col0 + bj * 128 + 4);
#pragma unroll
            for (int ai = 0; ai < 2; ++ai)
#pragma unroll
                for (int m = 0; m < 4; ++m) { const size_t off = (size_t)(row0 + ai * 128 + m * 16) * DM + col0 + bj * 128;
                    const f32x4 x0 = __builtin_nontemporal_load((const f32x4*)(xin + off)), x1 = __builtin_nontemporal_load((const f32x4*)(xin + off + 4));
                    st16f(xout + off, x0 + g0 * acc[ai][bj][m][0]); st16f(xout + off + 4, x1 + g1 * acc[ai][bj][m][1]); }
        }
    }
};
struct EpiOutNorm {
    static constexpr bool PERM = true, AFTER_DRAIN = true;
    const float* xin; float* out; const float* gate; const float* fg; unsigned long long* xbuf; unsigned* cnt;
    __device__ __forceinline__ void fused(f32x4 (&acc)[2][2][4][2], const pg8::Unit& u, int wr, int wc, int fr, int fq, LAS unsigned char* lds, int wid, int lane) const {
        const int row0 = u.pm * 256 + wr * 64 + fr, col0 = u.pn * 256 + wc * 32 + 8 * fq; const float* gb = gate + ((u.pm * 256) / SEQ) * 1024;
        LAS float* P = (LAS float*)lds; LAS float* S = (LAS float*)(lds + 8192);
#pragma unroll
        for (int bj = 0; bj < 2; ++bj) {
            const f32x4 g0 = *(const f32x4*)(gb + col0 + bj * 128), g1 = *(const f32x4*)(gb + col0 + bj * 128 + 4);
#pragma unroll
            for (int ai = 0; ai < 2; ++ai)
#pragma unroll
                for (int m = 0; m < 4; ++m) { const size_t off = (size_t)(row0 + ai * 128 + m * 16) * DM + col0 + bj * 128;
                    acc[ai][bj][m][0] = __builtin_nontemporal_load((const f32x4*)(xin + off)) + g0 * acc[ai][bj][m][0]; acc[ai][bj][m][1] = __builtin_nontemporal_load((const f32x4*)(xin + off + 4)) + g1 * acc[ai][bj][m][1];
                    asm volatile("" : "+v"(acc[ai][bj][m][0]), "+v"(acc[ai][bj][m][1]) :: "memory"); }
        }
#pragma unroll
        for (int ai = 0; ai < 2; ++ai)
#pragma unroll
            for (int m = 0; m < 4; ++m) { float sq = 0.f;
#pragma unroll
                for (int bj = 0; bj < 2; ++bj)
#pragma unroll
                    for (int n = 0; n < 2; ++n) { const f32x4 v = acc[ai][bj][m][n]; sq += (v[0] * v[0] + v[1] * v[1]) + (v[2] * v[2] + v[3] * v[3]); }
                sq += __shfl_xor(sq, 16); sq += __shfl_xor(sq, 32);
                if (fq == 0) P[(ai * 128 + wr * 64 + m * 16 + fr) * 4 + wc] = sq; }
        __syncthreads();
        const int row = wid * 32 + (lane & 31);
        if (lane < 32) { const float t = (P[row * 4 + 0] + P[row * 4 + 1]) + (P[row * 4 + 2] + P[row * 4 + 3]);
            __hip_atomic_store(xbuf + ((size_t)(u.pm * 256 + row) * 4 + u.pn), (unsigned long long)__float_as_uint(t), __ATOMIC_RELAXED, __HIP_MEMORY_SCOPE_AGENT); }
        asm volatile("s_waitcnt vmcnt(0)" ::: "memory");
        if (lane == 0) __hip_atomic_fetch_add(cnt + 64 * u.pm, 1u, __ATOMIC_RELAXED, __HIP_MEMORY_SCOPE_AGENT);
        if (wid == 0) {
            for (unsigned spins = 0; spins < (1u << 22); ++spins) { if ((unsigned)__builtin_amdgcn_readfirstlane(__hip_atomic_load(cnt + 64 * u.pm, __ATOMIC_RELAXED, __HIP_MEMORY_SCOPE_AGENT)) >= 32u) break; __builtin_amdgcn_s_sleep(2); }
            __builtin_amdgcn_fence(__ATOMIC_ACQUIRE, "agent");
        }
        asm volatile("s_waitcnt vmcnt(0) lgkmcnt(0)" ::: "memory");
        __syncthreads();
        if (lane < 32) { const unsigned long long* slot = xbuf + (size_t)(u.pm * 256 + row) * 4; float t = 0.f;
#pragma unroll
            for (int q = 0; q < 4; ++q) t += __uint_as_float((unsigned)__hip_atomic_load(slot + q, __ATOMIC_RELAXED, __HIP_MEMORY_SCOPE_AGENT));
            S[row] = rsqrtf(t * (1.f / 1024.f) + EPSF); }
        __syncthreads();
#pragma unroll
        for (int bj = 0; bj < 2; ++bj) {
            const f32x4 f0 = *(const f32x4*)(fg + col0 + bj * 128), f1 = *(const f32x4*)(fg + col0 + bj * 128 + 4);
#pragma unroll
            for (int ai = 0; ai < 2; ++ai)
#pragma unroll
                for (int m = 0; m < 4; ++m) { const size_t off = (size_t)(row0 + ai * 128 + m * 16) * DM + col0 + bj * 128; const float r = S[ai * 128 + wr * 64 + m * 16 + fr];
                    *(f32x4*)(out + off) = acc[ai][bj][m][0] * r * f0; *(f32x4*)(out + off + 4) = acc[ai][bj][m][1] * r * f1; }
        }
    }
};
struct GateOrder { int pm, pn;
    __device__ __forceinline__ bool next(int i, pg8::Unit& u) const { if (i >= 3) return false; u.pm = pm; u.pn = pn + 4 * i; return true; }
    __device__ __forceinline__ void a_ready(const pg8::Unit&) const {}
    __device__ __forceinline__ void done(const pg8::Unit&) const {} };
struct OneUnit { int pm, pn;
    __device__ __forceinline__ bool next(int i, pg8::Unit& u) const { if (i >= 1) return false; u.pm = pm; u.pn = pn; return true; }
    __device__ __forceinline__ void a_ready(const pg8::Unit&) const {}
    __device__ __forceinline__ void done(const pg8::Unit&) const {} };

__device__ __forceinline__ void phase_mod(const Params& p, float* MODP) {
    for (int u = blockIdx.x; u < 192; u += gridDim.x) {
        const int l = u / 96, r = u % 96, ks = r / 6, jb = r % 6; int tx_ = threadIdx.x; asm volatile("" : "+v"(tx_)); const int j = jb * 512 + tx_;
        const float* w = p.w_ada + ((size_t)l * 1024 + ks * 64) * 3072 + j; const float* c0 = p.c + ks * 64; const float* c1 = p.c + 1024 + ks * 64;
        float a0 = 0.f, a1 = 0.f;
#pragma unroll 8
        for (int k = 0; k < 64; ++k) { const float wv = w[(size_t)k * 3072]; a0 += c0[k] * wv; a1 += c1[k] * wv; }
        st4f(MODP + ((l * 16 + ks) * 2 + 0) * 3072 + j, a0); st4f(MODP + ((l * 16 + ks) * 2 + 1) * 3072 + j, a1);
    }
}

struct TItem { const float* src; int ld; bf16_t* dst; };
__device__ __forceinline__ TItem transpose_item(const Params& p, int l, int it, bf16_t* WinT, bf16_t* WbrT, bf16_t* WoutT) {
    TItem t;
    if (it < 1792) { const int nt = it >> 4, kt = it & 15, n0 = nt * 64, c0 = n0 < 1536 ? n0 : n0 + 8;
        t.src = p.w_in + (size_t)l * 1024 * NIN + (size_t)kt * 64 * NIN + c0; t.ld = NIN; t.dst = WinT + (size_t)n0 * 1024 + kt * 64;
    } else if (it < 2048) { const int j = it - 1792, nt = j >> 4, kt = j & 15, k0 = kt * 64;
        const float* src = k0 < 512 ? p.w_br_m + (size_t)l * 512 * 1024 + (size_t)k0 * 1024 : (k0 < 768 ? p.w_br_p + (size_t)l * 256 * 1024 + (size_t)(k0 - 512) * 1024 : p.w_br_s + (size_t)l * 256 * 1024 + (size_t)(k0 - 768) * 1024);
        t.src = src + nt * 64; t.ld = 1024; t.dst = WbrT + (size_t)nt * 64 * 1024 + k0;
    } else { const int j = it - 2048, nt = j >> 4, kt = j & 15;
        t.src = p.w_out + (size_t)l * 1024 * 1024 + (size_t)kt * 64 * 1024 + nt * 64; t.ld = 1024; t.dst = WoutT + (size_t)nt * 64 * 1024 + kt * 64; }
    return t;
}
__device__ __forceinline__ void phase_prep(const Params& p, int l, const float* xin, LAS unsigned char* lds, unsigned char* ws_in) {
    size_t wz_ = 0; asm volatile("" : "+s"(wz_)); unsigned char* ws = ws_in + wz_;
    int tid_ = threadIdx.x; asm volatile("" : "+v"(tid_)); const int tid = tid_, lane = tid & 63, wid = tid >> 6;
    bf16_t* WinT = (bf16_t*)(ws + WS_WIN); bf16_t* WbrT = (bf16_t*)(ws + WS_WBR); bf16_t* WoutT = (bf16_t*)(ws + WS_WOUT);
    LAS float* tl = (LAS float*)lds;
    { float tv[8]; int it = blockIdx.x;
      if (it < 2304) { const TItem t0 = transpose_item(p, l, it, WinT, WbrT, WoutT);
#pragma unroll
          for (int i = 0; i < 8; ++i) tv[i] = __builtin_nontemporal_load(t0.src + (size_t)(i * 8 + (tid >> 6)) * t0.ld + (tid & 63)); }
      for (; it < 2304; it += gridDim.x) {
          const TItem t = transpose_item(p, l, it, WinT, WbrT, WoutT);
#pragma unroll
          for (int i = 0; i < 8; ++i) tl[(i * 8 + (tid >> 6)) * 65 + (tid & 63)] = tv[i];
          __syncthreads();
          if (it + (int)gridDim.x < 2304) { const TItem tn = transpose_item(p, l, it + gridDim.x, WinT, WbrT, WoutT);
#pragma unroll
              for (int i = 0; i < 8; ++i) tv[i] = __builtin_nontemporal_load(tn.src + (size_t)(i * 8 + (tid >> 6)) * tn.ld + (tid & 63)); }
#pragma unroll
          for (int i = 0; i < 4; ++i) { const int nn = i * 16 + (tid >> 5), kk = (tid & 31) * 2; st4(t.dst + (size_t)nn * 1024 + kk, cvt_pk_bf16(tl[kk * 65 + nn], tl[(kk + 1) * 65 + nn])); }
          __syncthreads();
      } }
    const float* MODP = (const float*)(ws + WS_SMALL + SM_MODP) + (size_t)l * 16 * 2 * 3072;
    float* GATEV = (float*)(ws + WS_SMALL + SM_GATEV) + l * 2048; float* IFG = (float*)(ws + WS_SMALL + SM_IF + (size_t)l * NTOK * 32);
    bf16_t* H = (bf16_t*)(ws + WS_H);
    LAS float* A = (LAS float*)(lds + 16896); LAS float* Sh = A + 1024; LAS float* Wif = Sh + 1024;
    for (int rb = blockIdx.x; rb < 256; rb += gridDim.x) {
        const int b = (rb * 64) / SEQ;
        __syncthreads();
#pragma unroll
        for (int q = 0; q < 2; ++q) { const int k = tid + q * 512; float sh = p.b_ada[l * 3072 + k], sc = p.b_ada[l * 3072 + 1024 + k];
            for (int ks = 0; ks < 16; ++ks) { sh += MODP[(ks * 2 + b) * 3072 + k]; sc += MODP[(ks * 2 + b) * 3072 + 1024 + k]; }
            A[k] = p.norm_g[l * 1024 + k] * (1.f + sc); Sh[k] = sh; }
        if (rb < 4) { const int e = rb * 512 + tid, bb = e >> 10, j = e & 1023; float g = p.b_ada[l * 3072 + 2048 + j];
            for (int ks = 0; ks < 16; ++ks) g += MODP[(ks * 2 + bb) * 3072 + 2048 + j];
            st4f(GATEV + bb * 1024 + j, g); }
#pragma unroll
        for (int q = 0; q < 16; ++q) { const int e = tid + q * 512, k = e >> 3, g = e & 7; Wif[g * 1024 + k] = p.w_in[(size_t)l * 1024 * NIN + (size_t)k * NIN + 1536 + g]; }
        __syncthreads();
        f32x4 xn[4];
        { const float* xr0 = xin + (size_t)(rb * 64 + wid * 8) * DM;
#pragma unroll
          for (int j = 0; j < 4; ++j) xn[j] = __builtin_nontemporal_load((const f32x4*)(xr0 + (j >> 1) * 512 + lane * 8 + (j & 1) * 4)); }
        for (int i = 0; i < 8; ++i) {
            const int row = rb * 64 + wid * 8 + i;
            f32x4 xv[4]; float ss = 0.f;
#pragma unroll
            for (int j = 0; j < 4; ++j) { xv[j] = xn[j]; ss += xv[j][0] * xv[j][0] + xv[j][1] * xv[j][1] + xv[j][2] * xv[j][2] + xv[j][3] * xv[j][3]; }
            if (i < 7) { const float* xr1 = xin + (size_t)(row + 1) * DM;
#pragma unroll
                for (int j = 0; j < 4; ++j) xn[j] = __builtin_nontemporal_load((const f32x4*)(xr1 + (j >> 1) * 512 + lane * 8 + (j & 1) * 4)); }
            ss = wave_sum(ss); const float rstd = rsqrtf(ss * (1.f / 1024.f) + EPSF);
            float gp[8];
#pragma unroll
            for (int g = 0; g < 8; ++g) gp[g] = 0.f;
            f32x4 hv[4];
#pragma unroll
            for (int j = 0; j < 4; ++j) { const int k = (j >> 1) * 512 + lane * 8 + (j & 1) * 4; const f32x4 a = *(const LAS f32x4*)(A + k), sft = *(const LAS f32x4*)(Sh + k);
                hv[j] = xv[j] * rstd * a + sft;
#pragma unroll
                for (int g = 0; g < 8; ++g) { const f32x4 wv = *(const LAS f32x4*)(Wif + g * 1024 + k); gp[g] += hv[j][0] * wv[0] + hv[j][1] * wv[1] + hv[j][2] * wv[2] + hv[j][3] * wv[3]; } }
#pragma unroll
            for (int j = 0; j < 2; ++j) { u32x4 w; w.x = cvt_pk_bf16(hv[2 * j][0], hv[2 * j][1]); w.y = cvt_pk_bf16(hv[2 * j][2], hv[2 * j][3]); w.z = cvt_pk_bf16(hv[2 * j + 1][0], hv[2 * j + 1][1]); w.w = cvt_pk_bf16(hv[2 * j + 1][2], hv[2 * j + 1][3]);
                st16(H + (size_t)row * DM + j * 512 + lane * 8, w); }
#pragma unroll
            for (int g = 0; g < 8; ++g) gp[g] = wave_sum(gp[g]);
            float outv = gp[0];
#pragma unroll
            for (int g = 1; g < 8; ++g) outv = (lane == g) ? gp[g] : outv;
            if (lane < 8) st4f(IFG + (size_t)row * 8 + lane, outv + p.m_gate_b[l * 8 + lane]);
        }
    }
    __syncthreads();
}

constexpr int LP = 136;
constexpr int OFF_Q = 0, OFF_K = 34816, OFF_V = 69632, OFF_C = 104448, OFF_AR = 139264;
template <int MODE> __device__ __forceinline__ void mlstm_gates(const float* IFG, int tok0, int hd, float mprev, LAS float* ar, int tid) {
    if (tid < 64) { const int l = tid;
        const float i0 = IFG[(size_t)(tok0 + 2 * l) * 8 + hd], i1 = IFG[(size_t)(tok0 + 2 * l + 1) * 8 + hd];
        const float f0 = logsig(IFG[(size_t)(tok0 + 2 * l) * 8 + 4 + hd]), f1 = logsig(IFG[(size_t)(tok0 + 2 * l + 1) * 8 + 4 + hd]);
        float sc = f0 + f1;
#pragma unroll
        for (int d = 1; d < 64; d <<= 1) { const float t = __shfl_up(sc, d); if (l >= d) sc += t; }
        const float c1 = sc, c0 = sc - f1;
        ar[2 * l] = i0; ar[2 * l + 1] = i1; ar[128 + 2 * l] = c0; ar[128 + 2 * l + 1] = c1;
        if (MODE == 1) { const float bend = __shfl(c1, 63); const float a0 = bend - c0 + i0, a1 = bend - c1 + i1; float am = fmaxf(a0, a1);
#pragma unroll
            for (int m = 32; m >= 1; m >>= 1) am = fmaxf(am, __shfl_xor(am, m));
            ar[3 * 128 + 2 * l] = __expf(a0 - am); ar[3 * 128 + 2 * l + 1] = __expf(a1 - am);
            if (l == 0) { ar[7 * 128] = bend; ar[7 * 128 + 1] = am; } }
        if (MODE == 3) { const float g0 = i0 - c0, g1 = i1 - c1; float pm = fmaxf(g0, g1);
#pragma unroll
            for (int d = 1; d < 64; d <<= 1) { const float t = __shfl_up(pm, d); if (l >= d) pm = fmaxf(pm, t); }
            float pprev = __shfl_up(pm, 1); if (l == 0) pprev = -3.0e38f;
            const float pm0 = fmaxf(pprev, g0), pm1 = pm;
            const float mt0 = c0 + fmaxf(mprev, pm0), mt1 = c1 + fmaxf(mprev, pm1);
            ar[2 * 128 + 2 * l] = g0; ar[2 * 128 + 2 * l + 1] = g1;
            ar[3 * 128 + 2 * l] = __expf(c0 + mprev - mt0); ar[3 * 128 + 2 * l + 1] = __expf(c1 + mprev - mt1);
            ar[4 * 128 + 2 * l] = c0 - mt0; ar[4 * 128 + 2 * l + 1] = c1 - mt1;
            ar[5 * 128 + 2 * l] = __expf(-mt0); ar[5 * 128 + 2 * l + 1] = __expf(-mt1); }
    }
}
template <bool TR> __device__ __forceinline__ void stage_conv(const bf16_t* PROJ, int colbase, const float* cw, const float* cb, int ch0, int tok0, int pos0, float scale, LAS bf16_t* dst, int tid) {
    const int d0 = (tid & 15) * 8, s0 = (tid >> 4) * 4;
    float x[7][8];
    const bf16_t* src = PROJ + (size_t)tok0 * NPA + colbase + d0;
#pragma unroll
    for (int r = 0; r < 7; ++r) { const int sr = s0 - 3 + r; u32x4 v = {0u, 0u, 0u, 0u}; if (pos0 + sr >= 0) v = *(const u32x4*)(src + (ptrdiff_t)sr * NPA);
        x[r][0] = bflo(v.x); x[r][1] = bfhi(v.x); x[r][2] = bflo(v.y); x[r][3] = bfhi(v.y); x[r][4] = bflo(v.z); x[r][5] = bfhi(v.z); x[r][6] = bflo(v.w); x[r][7] = bfhi(v.w); }
    float o[4][8];
    { const f32x4 b0 = *(const f32x4*)(cb + ch0 + d0), b1 = *(const f32x4*)(cb + ch0 + d0 + 4);
#pragma unroll
      for (int i = 0; i < 4; ++i) { o[i][0] = b0[0]; o[i][1] = b0[1]; o[i][2] = b0[2]; o[i][3] = b0[3]; o[i][4] = b1[0]; o[i][5] = b1[1]; o[i][6] = b1[2]; o[i][7] = b1[3]; } }
#pragma unroll
    for (int j = 0; j < 4; ++j) { const f32x4 w0 = *(const f32x4*)(cw + j * 1024 + ch0 + d0), w1 = *(const f32x4*)(cw + j * 1024 + ch0 + d0 + 4);
#pragma unroll
        for (int i = 0; i < 4; ++i) { o[i][0] += w0[0] * x[i + j][0]; o[i][1] += w0[1] * x[i + j][1]; o[i][2] += w0[2] * x[i + j][2]; o[i][3] += w0[3] * x[i + j][3];
                                      o[i][4] += w1[0] * x[i + j][4]; o[i][5] += w1[1] * x[i + j][5]; o[i][6] += w1[2] * x[i + j][6]; o[i][7] += w1[3] * x[i + j][7]; } }
#pragma unroll
    for (int i = 0; i < 4; ++i)
#pragma unroll
        for (int c = 0; c < 8; ++c) o[i][c] = fsilu(o[i][c]) * scale;
    if (TR) {
#pragma unroll
        for (int c = 0; c < 8; ++c) { u32x2 w; w.x = cvt_pk_bf16(o[0][c], o[1][c]); w.y = cvt_pk_bf16(o[2][c], o[3][c]); *(LAS u32x2*)(dst + (d0 + c) * LP + s0) = w; }
    } else {
#pragma unroll
        for (int i = 0; i < 4; ++i) { u32x4 w; w.x = cvt_pk_bf16(o[i][0], o[i][1]); w.y = cvt_pk_bf16(o[i][2], o[i][3]); w.z = cvt_pk_bf16(o[i][4], o[i][5]); w.w = cvt_pk_bf16(o[i][6], o[i][7]); *(LAS u32x4*)(dst + (s0 + i) * LP + d0) = w; }
    }
}
template <bool SCALE> __device__ __forceinline__ void stage_vt(const bf16_t* PROJ, int tok0, int hd, const LAS float* wa, LAS bf16_t* dst, int tid) {
#pragma unroll
    for (int q = 0; q < 4; ++q) { const int s = tid & 127, d0 = ((tid >> 7) + 4 * q) * 8;
        const u32x4 v = *(const u32x4*)(PROJ + (size_t)(tok0 + s) * NPA + C_MV + hd * 128 + d0); const float sc = SCALE ? wa[s] : 1.f;
        const unsigned wv[4] = {v.x, v.y, v.z, v.w};
#pragma unroll
        for (int e = 0; e < 4; ++e) { const float lo = bflo(wv[e]) * sc, hi = bfhi(wv[e]) * sc;
            dst[(d0 + 2 * e) * LP + s] = SCALE ? f2bf(lo) : (bf16_t)(wv[e] & 0xffffu); dst[(d0 + 2 * e + 1) * LP + s] = SCALE ? f2bf(hi) : (bf16_t)(wv[e] >> 16); } }
}

__device__ __forceinline__ void mlstm_m1(const Params& p, int l, LAS unsigned char* lds, unsigned char* ws_in) {
    size_t wz_ = 0; asm volatile("" : "+s"(wz_)); unsigned char* ws = ws_in + wz_;
    int tid_ = threadIdx.x; asm volatile("" : "+v"(tid_)); const int tid = tid_, lane = tid & 63, wid = tid >> 6, fr = lane & 15, fq = lane >> 4;
    const bf16_t* PROJ = (const bf16_t*)(ws + WS_PROJ); const float* IFG = (const float*)(ws + WS_SMALL + SM_IF + (size_t)l * NTOK * 32);
    float* DC = (float*)(ws + WS_DC); float* DN = (float*)(ws + WS_SMALL + SM_DN + (size_t)l * 262144); float* BEND = (float*)(ws + WS_SMALL + SM_BEND + (size_t)l * 65536); float* AMAX = (float*)(ws + WS_SMALL + SM_AMAX + (size_t)l * 65536);
    LAS float* ar = (LAS float*)(lds + OFF_AR); LAS bf16_t* Vt = (LAS bf16_t*)(lds + OFF_V); LAS bf16_t* Kt = (LAS bf16_t*)(lds + OFF_K);
    for (int u = blockIdx.x; u < 512; u += gridDim.x) {
        const int b = u >> 8, hd = (u >> 6) & 3, c = u & 63, tok0 = b * SEQ + c * 128, pos0 = c * 128;
        __syncthreads();
        mlstm_gates<1>(IFG, tok0, hd, 0.f, ar, tid);
        __syncthreads();
        const float bend = ar[7 * 128], amax = ar[7 * 128 + 1];
        stage_vt<true>(PROJ, tok0, hd, ar + 3 * 128, Vt, tid);
        stage_conv<true>(PROJ, C_MK + hd * 128, p.conv_w + (size_t)l * 4096, p.conv_b + l * 1024, 512 + hd * 128, tok0, pos0, 0.08838834764831845f, Kt, tid);
        __syncthreads();
        f32x4 acc[8];
#pragma unroll
        for (int j = 0; j < 8; ++j) acc[j] = (f32x4){0.f, 0.f, 0.f, 0.f};
#pragma unroll
        for (int ks = 0; ks < 4; ++ks) { const bf16x8 a = ldfrag((const LAS unsigned char*)(Vt + (16 * wid + fr) * LP + ks * 32 + fq * 8));
#pragma unroll
            for (int j = 0; j < 8; ++j) acc[j] = mfma16(ldfrag((const LAS unsigned char*)(Kt + (16 * j + fr) * LP + ks * 32 + fq * 8)), a, acc[j]); }
        bf16_t* dcu = (bf16_t*)(DC + (size_t)u * 16384);
#pragma unroll
        for (int j = 0; j < 8; ++j) { u32x2 w; w.x = cvt_pk_bf16(acc[j][0], acc[j][1]); w.y = cvt_pk_bf16(acc[j][2], acc[j][3]); st8(dcu + (16 * wid + fr) * 128 + 16 * j + 4 * fq, w); }
        if (tid < 128) { float sn = 0.f;
#pragma unroll 4
            for (int jj = 0; jj < 16; ++jj) { const u32x4 kv = *(const LAS u32x4*)(Kt + tid * LP + jj * 8); const f32x4 w0 = *(const LAS f32x4*)(ar + 3 * 128 + jj * 8), w1 = *(const LAS f32x4*)(ar + 3 * 128 + jj * 8 + 4);
                sn += w0[0] * bflo(kv.x) + w0[1] * bfhi(kv.x) + w0[2] * bflo(kv.y) + w0[3] * bfhi(kv.y) + w1[0] * bflo(kv.z) + w1[1] * bfhi(kv.z) + w1[2] * bflo(kv.w) + w1[3] * bfhi(kv.w); }
            st4f(DN + u * 128 + tid, sn); }
        if (tid == 0) { st4f(BEND + u * 32, bend); st4f(AMAX + u * 32, amax); }
    }
    __syncthreads();
}

__device__ __forceinline__ void scan_load(float (&dcv)[64], unsigned char* ws, int idx) {
    const int bh = idx >> 14, e = idx & 16383; const bf16_t* base = (const bf16_t*)(ws + WS_DC) + (size_t)bh * 64 * 32768 + e;
#pragma unroll
    for (int c = 0; c < 64; ++c) dcv[c] = bf2f(base[(size_t)c * 32768]);
}
__device__ __forceinline__ void scan_finish(const float (&dcv)[64], int l, unsigned char* ws, int idx) {
    const float* BEND = (const float*)(ws + WS_SMALL + SM_BEND + (size_t)l * 65536); const float* AMAX = (const float*)(ws + WS_SMALL + SM_AMAX + (size_t)l * 65536);
    float* MPREV = (float*)(ws + WS_SMALL + SM_MPREV + (size_t)l * 2048);
    const int bh = idx >> 14, e = idx & 16383;
    float m = 0.f, cst = 0.f;
#pragma unroll
    for (int c = 0; c < 64; ++c) { const float be = BEND[(bh * 64 + c) * 32], am = AMAX[(bh * 64 + c) * 32]; const float mn = fmaxf(be + m, am), dec = __expf(be + m - mn), inw = __expf(am - mn);
        cprev_slot(ws, bh * 64 + c)[e] = f2bf(cst); cst = dec * cst + inw * dcv[c]; if (e == 0) st4f(MPREV + bh * 64 + c, m); m = mn; }
}
__device__ __forceinline__ void mlstm_scan(int l, unsigned char* ws_in) {
    size_t wz_ = 0; asm volatile("" : "+s"(wz_)); unsigned char* ws = ws_in + wz_;
    int tx_ = threadIdx.x; asm volatile("" : "+v"(tx_));
    for (int idx = blockIdx.x * 512 + tx_; idx < 8 * 16384; idx += gridDim.x * 512) { float dcv[64]; scan_load(dcv, ws, idx); scan_finish(dcv, l, ws, idx); }
}
__device__ __forceinline__ void mlstm_scan_n(int l, unsigned char* ws_in) {
    size_t wz_ = 0; asm volatile("" : "+s"(wz_)); unsigned char* ws = ws_in + wz_;
    float* DN = (float*)(ws + WS_SMALL + SM_DN + (size_t)l * 262144); const float* BEND = (const float*)(ws + WS_SMALL + SM_BEND + (size_t)l * 65536); const float* AMAX = (const float*)(ws + WS_SMALL + SM_AMAX + (size_t)l * 65536);
    int tx_ = threadIdx.x; asm volatile("" : "+v"(tx_));
    for (int idx = (tx_ < 64 && gridDim.x >= 16) ? (int)blockIdx.x * 64 + tx_ : (gridDim.x >= 16 ? 8 * 128 : (int)blockIdx.x * 512 + tx_); idx < 8 * 128; idx += (gridDim.x >= 16 ? 8 * 128 : gridDim.x * 512)) {
        const int bh = idx >> 7, e = idx & 127;
        float* base = DN + (size_t)bh * 64 * 128 + e;
        float dcv[64];
#pragma unroll
        for (int c = 0; c < 64; ++c) dcv[c] = base[c * 128];
        float m = 0.f, cst = 0.f;
#pragma unroll
        for (int c = 0; c < 64; ++c) { const float be = BEND[(bh * 64 + c) * 32], am = AMAX[(bh * 64 + c) * 32]; const float mn = fmaxf(be + m, am), dec = __expf(be + m - mn), inw = __expf(am - mn);
            st4f(base + c * 128, cst); cst = dec * cst + inw * dcv[c]; m = mn; }
    }
}

__device__ __forceinline__ void mlstm_m3(const Params& p, int l, LAS unsigned char* lds, unsigned char* ws_in) {
    size_t wz_ = 0; asm volatile("" : "+s"(wz_)); unsigned char* ws = ws_in + wz_;
    int tid_ = threadIdx.x; asm volatile("" : "+v"(tid_)); const int tid = tid_, lane = tid & 63, wid = tid >> 6, fr = lane & 15, fq = lane >> 4;
    const bf16_t* PROJ = (const bf16_t*)(ws + WS_PROJ); const float* IFG = (const float*)(ws + WS_SMALL + SM_IF + (size_t)l * NTOK * 32);
    const float* DC = (const float*)(ws + WS_DC); const float* DN = (const float*)(ws + WS_SMALL + SM_DN + (size_t)l * 262144); const float* MPREV = (const float*)(ws + WS_SMALL + SM_MPREV + (size_t)l * 2048);
    bf16_t* Y = (bf16_t*)(ws + WS_Y);
    LAS float* ar = (LAS float*)(lds + OFF_AR);
    LAS bf16_t* Qc = (LAS bf16_t*)(lds + OFF_Q); LAS bf16_t* Kc = (LAS bf16_t*)(lds + OFF_K); LAS bf16_t* Vt = (LAS bf16_t*)(lds + OFF_V); LAS bf16_t* Cp = (LAS bf16_t*)(lds + OFF_C);
    for (int u = blockIdx.x; u < 512; u += gridDim.x) {
        const int b = u >> 8, hd = (u >> 6) & 3, c = u & 63, tok0 = b * SEQ + c * 128, pos0 = c * 128;
        __syncthreads();
        const float mprev = MPREV[u];
        mlstm_gates<3>(IFG, tok0, hd, mprev, ar, tid);
        if (tid >= 64 && tid < 192) ar[6 * 128 + tid - 64] = DN[u * 128 + tid - 64];
        stage_conv<false>(PROJ, C_MQ + hd * 128, p.conv_w + (size_t)l * 4096, p.conv_b + l * 1024, hd * 128, tok0, pos0, 1.f, Qc, tid);
        stage_conv<false>(PROJ, C_MK + hd * 128, p.conv_w + (size_t)l * 4096, p.conv_b + l * 1024, 512 + hd * 128, tok0, pos0, 0.08838834764831845f, Kc, tid);
        stage_vt<false>(PROJ, tok0, hd, nullptr, Vt, tid);
        { const bf16_t* cpu = cprev_slot(ws, u);
#pragma unroll
          for (int q = 0; q < 4; ++q) { const int e = (q * 512 + tid) * 8, v = e >> 7, k = e & 127; *(LAS u32x4*)(Cp + v * LP + k) = *(const u32x4*)(cpu + e); } }
        __syncthreads();
        const int tl = 16 * wid + fr;
        bf16x8 qf[4];
#pragma unroll
        for (int ks = 0; ks < 4; ++ks) qf[ks] = ldfrag((const LAS unsigned char*)(Qc + tl * LP + ks * 32 + fq * 8));
        f32x4 acc[8];
#pragma unroll
        for (int vi = 0; vi < 8; ++vi) { acc[vi] = (f32x4){0.f, 0.f, 0.f, 0.f};
#pragma unroll
            for (int ks = 0; ks < 4; ++ks) acc[vi] = mfma16(ldfrag((const LAS unsigned char*)(Cp + (16 * vi + fr) * LP + ks * 32 + fq * 8)), qf[ks], acc[vi]); }
        float deni = 0.f;
#pragma unroll
        for (int kk = 0; kk < 4; ++kk) { const u32x4 qv = *(const LAS u32x4*)(Qc + tl * LP + fq * 32 + kk * 8); const f32x4 n0 = *(const LAS f32x4*)(ar + 6 * 128 + fq * 32 + kk * 8), n1 = *(const LAS f32x4*)(ar + 6 * 128 + fq * 32 + kk * 8 + 4);
            deni += n0[0] * bflo(qv.x) + n0[1] * bfhi(qv.x) + n0[2] * bflo(qv.y) + n0[3] * bfhi(qv.y) + n1[0] * bflo(qv.z) + n1[1] * bfhi(qv.z) + n1[2] * bflo(qv.w) + n1[3] * bfhi(qv.w); }
        deni += __shfl_xor(deni, 16); deni += __shfl_xor(deni, 32);
        const float wi = ar[3 * 128 + tl], et = ar[4 * 128 + tl], emt = ar[5 * 128 + tl];
#pragma unroll
        for (int vi = 0; vi < 8; ++vi) acc[vi] *= wi;
        float den = 0.f;
        for (int sp = 0; sp <= (wid >> 1); ++sp) {
            float pv[8];
#pragma unroll
            for (int h2 = 0; h2 < 2; ++h2) { const int tile = 2 * sp + h2; f32x4 sa = (f32x4){0.f, 0.f, 0.f, 0.f};
#pragma unroll
                for (int ks = 0; ks < 4; ++ks) sa = mfma16(ldfrag((const LAS unsigned char*)(Kc + (16 * tile + fr) * LP + ks * 32 + fq * 8)), qf[ks], sa);
                const f32x4 gk = *(const LAS f32x4*)(ar + 2 * 128 + 16 * tile + 4 * fq);
#pragma unroll
                for (int r = 0; r < 4; ++r) { const int sl = 16 * tile + 4 * fq + r; const float wgt = (sl <= tl) ? __expf(et + gk[r]) : 0.f; const float pp = wgt * sa[r]; den += pp; pv[h2 * 4 + r] = pp; } }
            u32x4 pw; pw.x = cvt_pk_bf16(pv[0], pv[1]); pw.y = cvt_pk_bf16(pv[2], pv[3]); pw.z = cvt_pk_bf16(pv[4], pv[5]); pw.w = cvt_pk_bf16(pv[6], pv[7]);
            const bf16x8 pf = __builtin_bit_cast(bf16x8, pw);
#pragma unroll
            for (int vi = 0; vi < 8; ++vi) { const LAS unsigned char* vr = (const LAS unsigned char*)(Vt + (16 * vi + fr) * LP + 32 * sp + 4 * fq);
                acc[vi] = mfma16(ldfrag2(vr, vr + 32), pf, acc[vi]); }
        }
        den += __shfl_xor(den, 16); den += __shfl_xor(den, 32);
        const float dtot = wi * deni + den; const float hinv = 1.f / fmaxf(fabsf(dtot), emt);
        const size_t tokr = (size_t)(tok0 + tl);
        float ssq = 0.f;
#pragma unroll
        for (int vi = 0; vi < 8; ++vi) { const u32x2 o = *(const u32x2*)(PROJ + tokr * NPA + C_MO + hd * 128 + 16 * vi + 4 * fq);
            acc[vi][0] *= hinv * bflo(o.x); acc[vi][1] *= hinv * bfhi(o.x); acc[vi][2] *= hinv * bflo(o.y); acc[vi][3] *= hinv * bfhi(o.y);
            ssq += acc[vi][0] * acc[vi][0] + acc[vi][1] * acc[vi][1] + acc[vi][2] * acc[vi][2] + acc[vi][3] * acc[vi][3]; }
        ssq += __shfl_xor(ssq, 16); ssq += __shfl_xor(ssq, 32);
        const float rinv = rsqrtf(ssq * (1.f / 128.f) + EPSF);
#pragma unroll
        for (int vi = 0; vi < 8; ++vi) { const int vc = hd * 128 + 16 * vi + 4 * fq; const u32x2 z = *(const u32x2*)(PROJ + tokr * NPA + C_MZ + vc); const f32x4 g = *(const f32x4*)(p.m_norm_g + l * 512 + vc);
            u32x2 w; w.x = cvt_pk_bf16(acc[vi][0] * rinv * g[0] * bflo(z.x), acc[vi][1] * rinv * g[1] * bfhi(z.x)); w.y = cvt_pk_bf16(acc[vi][2] * rinv * g[2] * bflo(z.y), acc[vi][3] * rinv * g[3] * bfhi(z.y));
            st8(Y + tokr * DM + vc, w); }
    }
    __syncthreads();
}

__device__ __forceinline__ void pool_phase(const Params& p, int l, LAS unsigned char* lds, unsigned char* ws_in) {
    size_t wz_ = 0; asm volatile("" : "+s"(wz_)); unsigned char* ws = ws_in + wz_;
    int tid_ = threadIdx.x; asm volatile("" : "+v"(tid_)); const int tid = tid_; const bf16_t* PROJ = (const bf16_t*)(ws + WS_PROJ); bf16_t* Y = (bf16_t*)(ws + WS_Y);
    LAS float* U = (LAS float*)lds; LAS float* Wp = (LAS float*)(lds + 20480); LAS float* Pm = (LAS float*)(lds + 36864);
    for (int pu = blockIdx.x; pu < 1024; pu += gridDim.x) {
        const int tt = pu >> 2, g = pu & 3, tok0 = tt * 64, b = tok0 / SEQ, p0 = tok0 % SEQ, W = 2 << g;
        __syncthreads();
        for (int ch = tid; ch < 79 * 8; ch += 512) { const int row = ch >> 3, cc = (ch & 7) * 8, pos = p0 - 15 + row;
            u32x4 v = {0u, 0u, 0u, 0u}; if (pos >= 0) v = *(const u32x4*)(PROJ + (size_t)(b * SEQ + pos) * NPA + C_PU + g * 64 + cc);
            *(LAS f32x4*)(U + row * 64 + cc) = (f32x4){bflo(v.x), bfhi(v.x), bflo(v.y), bfhi(v.y)}; *(LAS f32x4*)(U + row * 64 + cc + 4) = (f32x4){bflo(v.z), bfhi(v.z), bflo(v.w), bfhi(v.w)}; }
#pragma unroll
        for (int q = 0; q < 8; ++q) Wp[q * 512 + tid] = p.pool_w[(size_t)l * 16384 + g * 4096 + q * 512 + tid];
        __syncthreads();
        const int t = tid >> 3, c0 = (tid & 7) * 8; const int cnt = min(W, p0 + t + 1); const float rc = 1.f / (float)cnt;
        { f32x4 s0 = (f32x4){0.f, 0.f, 0.f, 0.f}, s1 = s0;
          for (int j = 0; j < W; ++j) { s0 += *(const LAS f32x4*)(U + (15 + t - j) * 64 + c0); s1 += *(const LAS f32x4*)(U + (15 + t - j) * 64 + c0 + 4); }
          const f32x4 u0 = *(const LAS f32x4*)(U + (15 + t) * 64 + c0), u1 = *(const LAS f32x4*)(U + (15 + t) * 64 + c0 + 4);
#pragma unroll
          for (int e = 0; e < 4; ++e) { Pm[t * 65 + c0 + e] = s0[e] * rc - u0[e]; Pm[t * 65 + c0 + 4 + e] = s1[e] * rc - u1[e]; } }
        __syncthreads();
        float o[8];
#pragma unroll
        for (int e = 0; e < 8; ++e) o[e] = 0.f;
        for (int cc = 0; cc < 64; ++cc) { const float pv = Pm[t * 65 + cc]; const f32x4 w0 = *(const LAS f32x4*)(Wp + cc * 64 + c0), w1 = *(const LAS f32x4*)(Wp + cc * 64 + c0 + 4);
#pragma unroll
            for (int e = 0; e < 4; ++e) { o[e] += pv * w0[e]; o[4 + e] += pv * w1[e]; } }
        const size_t tok = (size_t)(tok0 + t); const u32x4 z = *(const u32x4*)(PROJ + tok * NPA + C_PZ + g * 64 + c0);
        const f32x4 s0 = *(const f32x4*)(p.pool_scale + l * 256 + g * 64 + c0), s1 = *(const f32x4*)(p.pool_scale + l * 256 + g * 64 + c0 + 4);
        u32x4 w; w.x = cvt_pk_bf16(o[0] * s0[0] * bflo(z.x), o[1] * s0[1] * bfhi(z.x)); w.y = cvt_pk_bf16(o[2] * s0[2] * bflo(z.y), o[3] * s0[3] * bfhi(z.y));
        w.z = cvt_pk_bf16(o[4] * s1[0] * bflo(z.z), o[5] * s1[1] * bfhi(z.z)); w.w = cvt_pk_bf16(o[6] * s1[2] * bflo(z.w), o[7] * s1[3] * bfhi(z.w));
        st16(Y + tok * DM + 512 + g * 64 + c0, w);
    }
    __syncthreads();
}

constexpr float SB_DEAD = -104.f * 1.4426950408889634f;
template <bool DIAG> __device__ __forceinline__ f32x4 sb_tile(const f32x4 z, int sbase, int tq, int fq, float& L) {
    float lf[4], ls[4];
#pragma unroll
    for (int r = 0; r < 4; ++r) { const float zz = z[r], l1p = __builtin_amdgcn_logf(1.f + __builtin_amdgcn_exp2f(-fabsf(zz)));
        const float lfv = -(fmaxf(zz, 0.f) + l1p), lsv = fminf(zz, 0.f) - l1p;
        if (DIAG) { const bool valid = (sbase + r) < tq; lf[r] = valid ? lfv : 0.f; ls[r] = valid ? lsv : -1.0e30f; } else { lf[r] = lfv; ls[r] = lsv; } }
    const float suf2 = lf[3], suf1 = suf2 + lf[2], suf0 = suf1 + lf[1], T = suf0 + lf[0];
    const float T16 = __shfl_down(T, 16), T32 = __shfl_down(T, 32), T48 = __shfl_down(T, 48);
    const float E = (fq < 3 ? T16 : 0.f) + (fq < 2 ? T32 : 0.f) + (fq < 1 ? T48 : 0.f);
    float Tt = T + __shfl_xor(T, 16); Tt += __shfl_xor(Tt, 32);
    const float base = L + E;
    f32x4 pv; pv[0] = __builtin_amdgcn_exp2f(ls[0] + base + suf0); pv[1] = __builtin_amdgcn_exp2f(ls[1] + base + suf1); pv[2] = __builtin_amdgcn_exp2f(ls[2] + base + suf2); pv[3] = __builtin_amdgcn_exp2f(ls[3] + base);
    L += Tt; return pv;
}
__device__ __forceinline__ void sb_phase(const Params& p, LAS unsigned char* lds, unsigned char* ws_in, int u_first, int u_end) {
    size_t wz_ = 0; asm volatile("" : "+s"(wz_)); unsigned char* ws = ws_in + wz_;
    int tid_ = threadIdx.x; asm volatile("" : "+v"(tid_)); const int tid = tid_, lane = tid & 63, wid = tid >> 6, fr = lane & 15, fq = lane >> 4;
    const bf16_t* PROJ = (const bf16_t*)(ws + WS_PROJ); bf16_t* Y = (bf16_t*)(ws + WS_Y);
    LAS bf16_t* Ks = (LAS bf16_t*)lds; LAS bf16_t* Vt = (LAS bf16_t*)(lds + 18432); LAS int* flags = (LAS int*)(lds + 36864);
    for (int u = u_first; u < u_end; u += gridDim.x) {
        const int b = u >> 8, hd = (u >> 6) & 3, qb = u & 63;
        const int tq = qb * 128 + 16 * wid + fr; const size_t tokq = (size_t)(b * SEQ + tq);
        bf16x8 qf[2];
#pragma unroll
        for (int ks = 0; ks < 2; ++ks) qf[ks] = *(const bf16x8*)(PROJ + tokq * NPA + C_SQ + hd * 64 + ks * 32 + fq * 8);
        f32x4 acc[4];
#pragma unroll
        for (int i = 0; i < 4; ++i) acc[i] = (f32x4){0.f, 0.f, 0.f, 0.f};
        float Lrun = 0.f;
        u32x4 kreg[2], vreg[2];
#pragma unroll
        for (int q = 0; q < 2; ++q) { const int row = tid & 127, d0 = ((tid >> 7) + 4 * q) * 8; const size_t tk = (size_t)(b * SEQ + qb * 128 + row);
            kreg[q] = *(const u32x4*)(PROJ + tk * NPA + C_SK + hd * 64 + d0); vreg[q] = *(const u32x4*)(PROJ + tk * NPA + C_SV + hd * 64 + d0); }
        for (int kb = qb; kb >= 0; --kb) {
            __syncthreads();
#pragma unroll
            for (int q = 0; q < 2; ++q) { const int row = tid & 127, d0 = ((tid >> 7) + 4 * q) * 8;
                *(LAS u32x4*)(Ks + row * 72 + d0) = kreg[q];
                const unsigned wv[4] = {vreg[q].x, vreg[q].y, vreg[q].z, vreg[q].w};
#pragma unroll
                for (int e = 0; e < 4; ++e) { Vt[(d0 + 2 * e) * LP + row] = (bf16_t)(wv[e] & 0xffffu); Vt[(d0 + 2 * e + 1) * LP + row] = (bf16_t)(wv[e] >> 16); } }
            if (kb > 0) {
#pragma unroll
                for (int q = 0; q < 2; ++q) { const int row = tid & 127, d0 = ((tid >> 7) + 4 * q) * 8; const size_t tk = (size_t)(b * SEQ + (kb - 1) * 128 + row);
                    kreg[q] = *(const u32x4*)(PROJ + tk * NPA + C_SK + hd * 64 + d0); vreg[q] = *(const u32x4*)(PROJ + tk * NPA + C_SV + hd * 64 + d0); } }
            if (tid < 8) flags[tid] = 0;
            __syncthreads();
            const bool walive = __ballot(Lrun >= SB_DEAD) != 0ull;
            if (walive) {
                const int sp_hi = (kb == qb) ? (wid >> 1) : 3;
                for (int sp = sp_hi; sp >= 0; --sp) {
                    if (__ballot(Lrun >= SB_DEAD) == 0ull) break;
                    f32x4 pvv[2];
#pragma unroll
                    for (int h2 = 1; h2 >= 0; --h2) { const int tile = 2 * sp + h2;
                        f32x4 z = (f32x4){0.f, 0.f, 0.f, 0.f};
#pragma unroll
                        for (int ks = 0; ks < 2; ++ks) z = mfma16(ldfrag((const LAS unsigned char*)(Ks + (16 * tile + fr) * 72 + ks * 32 + fq * 8)), qf[ks], z);
                        const int sbase = kb * 128 + 16 * tile + 4 * fq;
                        pvv[h2] = (kb == qb) ? sb_tile<true>(z, sbase, tq, fq, Lrun) : sb_tile<false>(z, sbase, tq, fq, Lrun); }
                    const float pv[8] = {pvv[0][0], pvv[0][1], pvv[0][2], pvv[0][3], pvv[1][0], pvv[1][1], pvv[1][2], pvv[1][3]};
                    u32x4 pw; pw.x = cvt_pk_bf16(pv[0], pv[1]); pw.y = cvt_pk_bf16(pv[2], pv[3]); pw.z = cvt_pk_bf16(pv[4], pv[5]); pw.w = cvt_pk_bf16(pv[6], pv[7]);
                    const bf16x8 pf = __builtin_bit_cast(bf16x8, pw);
#pragma unroll
                    for (int i = 0; i < 4; ++i) { const LAS unsigned char* vr = (const LAS unsigned char*)(Vt + (16 * i + fr) * LP + 32 * sp + 4 * fq);
                        acc[i] = mfma16(ldfrag2(vr, vr + 32), pf, acc[i]); }
                }
            }
            const bool still = __ballot(Lrun >= SB_DEAD) != 0ull;
            if (lane == 0 && still) flags[wid] = 1;
            __syncthreads();
            int any = 0;
#pragma unroll
            for (int i = 0; i < 8; ++i) any |= flags[i];
            if (!any) break;
        }
#pragma unroll
        for (int i = 0; i < 4; ++i) { const int dc = hd * 64 + 16 * i + 4 * fq; const u32x2 z = *(const u32x2*)(PROJ + tokq * NPA + C_SZ + dc);
            u32x2 w; w.x = cvt_pk_bf16(acc[i][0] * bflo(z.x), acc[i][1] * bfhi(z.x)); w.y = cvt_pk_bf16(acc[i][2] * bflo(z.y), acc[i][3] * bfhi(z.y));
            st8(Y + tokq * DM + 768 + dc, w); }
    }
    __syncthreads();
}

__device__ __forceinline__ void final_norm(const Params& p) {
    int tid_ = threadIdx.x; asm volatile("" : "+v"(tid_)); const int tid = tid_, lane = tid & 63, wid = tid >> 6;
    const int stride = gridDim.x * 8; int row = blockIdx.x * 8 + wid;
    f32x4 g[4];
#pragma unroll
    for (int j = 0; j < 4; ++j) g[j] = *(const f32x4*)(p.final_g + j * 256 + lane * 4);
    f32x4 xn[4];
    if (row < NTOK) {
#pragma unroll
        for (int j = 0; j < 4; ++j) xn[j] = *(const f32x4*)(p.out + (size_t)row * DM + j * 256 + lane * 4); }
    for (; row < NTOK; row += stride) {
        float* xr = p.out + (size_t)row * DM; f32x4 xv[4]; float ss = 0.f;
#pragma unroll
        for (int j = 0; j < 4; ++j) { xv[j] = xn[j]; ss += xv[j][0] * xv[j][0] + xv[j][1] * xv[j][1] + xv[j][2] * xv[j][2] + xv[j][3] * xv[j][3]; }
        if (row + stride < NTOK) {
#pragma unroll
            for (int j = 0; j < 4; ++j) xn[j] = *(const f32x4*)(p.out + (size_t)(row + stride) * DM + j * 256 + lane * 4); }
        ss = wave_sum(ss); const float rstd = rsqrtf(ss * (1.f / 1024.f) + EPSF);
#pragma unroll
        for (int j = 0; j < 4; ++j) *(f32x4*)(xr + j * 256 + lane * 4) = xv[j] * rstd * g[j];
    }
}

#define XB_TMO      128
#define XB_XCNT(j)  (256  + 64 * (j))
#define XB_XSUB(j)  (1280 + 64 * (j))
#define XB_XGEN(j)  (2304 + 64 * (j))
#define XB_TOP      3328
#define XB_TOPGEN   3392
#define XCD_BAR_WORDS 3456
#define XB_SPIN_CAP (1u << 18)

__device__ __forceinline__ unsigned xb_ld(unsigned* p)              { return __hip_atomic_load(p, __ATOMIC_RELAXED, __HIP_MEMORY_SCOPE_AGENT); }
__device__ __forceinline__ unsigned xb_add(unsigned* p, unsigned v) { return __hip_atomic_fetch_add(p, v, __ATOMIC_RELAXED, __HIP_MEMORY_SCOPE_AGENT); }
__device__ __forceinline__ unsigned xb_xcc_id() { return (unsigned)__builtin_amdgcn_s_getreg((3 << 11) | 20) & 0xFu; }
#define XB_SPIN(cond, bar) do { unsigned _sp = 0; while (cond) { __builtin_amdgcn_s_sleep(1); \
    if ((++_sp & 255u) == 0u) { if (xb_ld(&(bar)[XB_TMO])) break; if (_sp > XB_SPIN_CAP) { atomicAdd(&(bar)[XB_TMO], 1u); break; } } } } while (0)

struct XcdBarrier {
    unsigned* bar; unsigned x;
    volatile LAS unsigned* st;
};

__device__ __forceinline__ XcdBarrier xcd_barrier_post(unsigned* bar, volatile LAS unsigned* st) {
    XcdBarrier b; b.bar = bar; b.x = xb_xcc_id(); b.st = st;
    if (threadIdx.x == 0) (void)xb_add(&bar[XB_XCNT(b.x)], 1u);
    return b;
}
__device__ __forceinline__ void xcd_barrier_complete(unsigned* bar, unsigned x, unsigned& nloc, unsigned& nx) {
    const unsigned G = gridDim.x * gridDim.y * gridDim.z;
    unsigned sum, cnt, mine, sp = 0u;
    for (;;) {
        sum = 0u; cnt = 0u; mine = 0u;
#pragma unroll
        for (unsigned j = 0; j < 16; ++j) { const unsigned c = xb_ld(&bar[XB_XCNT(j)]); sum += c; cnt += (c > 0u) ? 1u : 0u; mine = (j == x) ? c : mine; }
        if (sum == G) break;
        __builtin_amdgcn_s_sleep(1);
        if ((++sp & 255u) == 0u) { if (xb_ld(&bar[XB_TMO])) break; if (sp > XB_SPIN_CAP) { atomicAdd(&bar[XB_TMO], 1u); break; } }
    }
    nloc = mine > 0u ? mine : 1u; nx = cnt > 0u ? cnt : 1u;
}

__device__ __forceinline__ void xcd_barrier(const XcdBarrier& b) {
    asm volatile("s_waitcnt vmcnt(0)" ::: "memory");
    __syncthreads();
    if (threadIdx.x == 0) {
        unsigned* bar = b.bar;
        __builtin_amdgcn_s_waitcnt(0);
        unsigned nloc = b.st[0], nx = b.st[1];
        if (nloc == 0u) { xcd_barrier_complete(bar, b.x, nloc, nx); b.st[0] = nloc; b.st[1] = nx; }
        const unsigned old = xb_add(&bar[XB_XSUB(b.x)], 1u);
        const unsigned gen = old / nloc;
        if (old + 1u == (gen + 1u) * nloc) {
            __builtin_amdgcn_fence(__ATOMIC_RELEASE, "agent");
            asm volatile("s_waitcnt vmcnt(0)" ::: "memory");
            const unsigned og = xb_add(&bar[XB_TOP], 1u);
            const unsigned tg = og / nx;
            if (og + 1u == (tg + 1u) * nx) xb_add(&bar[XB_TOPGEN], 1u);
            else XB_SPIN(xb_ld(&bar[XB_TOPGEN]) == tg, bar);
            __builtin_amdgcn_fence(__ATOMIC_ACQUIRE, "agent");
            xb_add(&bar[XB_XGEN(b.x)], 1u);
            asm volatile("s_waitcnt vmcnt(0)" ::: "memory");
        } else {
            XB_SPIN(xb_ld(&bar[XB_XGEN(b.x)]) == gen, bar);
            __builtin_amdgcn_fence(__ATOMIC_ACQUIRE, "agent");
            asm volatile("s_waitcnt vmcnt(0)" ::: "memory");
        }
    }
    __syncthreads();
}

constexpr int N_PHASES = 16;
__global__ void __launch_bounds__(512, 2) mk_fwd(Params p) {
    extern __shared__ __attribute__((aligned(16))) unsigned char lds_raw[];
    LAS unsigned char* lds = (LAS unsigned char*)lds_raw;
    cg::grid_group grid = cg::this_grid();
#define GSYNC_CG() do { asm volatile("s_waitcnt vmcnt(0) lgkmcnt(0)" ::: "memory"); __syncthreads(); \
        if (threadIdx.x < 64) { __builtin_amdgcn_fence(__ATOMIC_RELEASE, "agent"); asm volatile("s_waitcnt vmcnt(0)" ::: "memory"); } \
        grid.sync(); \
        if (threadIdx.x < 64) { __builtin_amdgcn_fence(__ATOMIC_ACQUIRE, "agent"); asm volatile("s_waitcnt vmcnt(0)" ::: "memory"); } \
        __syncthreads(); } while (0)
    const bool one_launch = (p.ph_hi - p.ph_lo == N_PHASES);
    volatile LAS unsigned* xst = (volatile LAS unsigned*)(lds + LDS_BYTES - 64);
    if (threadIdx.x == 0) { xst[0] = 0u; xst[1] = 0u; }
    __syncthreads();
    XcdBarrier xbar; xbar.bar = (unsigned*)(p.ws + WS_SMALL + SM_XBAR); xbar.x = 0; xbar.st = xst;
    if (one_launch) xbar = xcd_barrier_post((unsigned*)(p.ws + WS_SMALL + SM_XBAR), xst);
    if (one_launch) grid.sync();
#define GSYNC() do { if (one_launch) xcd_barrier(xbar); else GSYNC_CG(); } while (0)
#pragma unroll 1
    for (int ph = p.ph_lo; ph < p.ph_hi; ++ph) {
        if (ph == 0) { phase_mod(p, (float*)(p.ws + WS_SMALL + SM_MODP)); }
        else if (ph == N_PHASES - 1) { if (gridDim.x != 256) final_norm(p); }
        else {
        int l = (ph - 1) / 7, k = (ph - 1) % 7; asm volatile("" : "+s"(l), "+s"(k));
        const float* xin = (l == 0) ? p.x : p.out;
        int G = gridDim.x, bx = blockIdx.x; asm volatile("" : "+s"(G), "+s"(bx));
        size_t wz_ = 0; asm volatile("" : "+s"(wz_)); unsigned char* ws = p.ws + wz_;
        if (k == 0) { phase_prep(p, l, xin, lds, ws); }
        else if (k == 1) {
        {
            pg8::Gemm g{(const bf16_t*)(ws + WS_H), (const bf16_t*)(ws + WS_WIN), NTOK, NPA, DM, DM, DM}; pg8::StaticOrder S; S.init(NTOK, NPA, G, bx);
            EpiProj E{(bf16_t*)(ws + WS_PROJ), NPA, 0}; NoHook HK; f32x4 acc[2][2][4][2];
            pg8::gemm_phase<EpiProj, pg8::StaticOrder, NoHook, true, true>(lds, g, S, E, HK, acc);
        }
        }
        else if (k == 2) { mlstm_m1(p, l, lds, ws); pool_phase(p, l, lds, ws); }
        else if (k == 3) {
            if (G == 256) {
                int tx_ = threadIdx.x; asm volatile("" : "+v"(tx_)); const int idx = bx * 512 + tx_;
                float dcv[64]; scan_load(dcv, ws, idx);
                sb_phase(p, lds, ws, bx, 256);
                scan_finish(dcv, l, ws, idx);
                mlstm_scan_n(l, ws);
                sb_phase(p, lds, ws, 256 + bx, 512);
            } else { mlstm_scan(l, ws); mlstm_scan_n(l, ws); sb_phase(p, lds, ws, bx, 512); }
        }
        else if (k == 4) { mlstm_m3(p, l, lds, ws); }
        else if (k == 5) {
        {
            pg8::StaticOrder S; S.init(NTOK, DM, G, bx); pg8::Unit u; NoHook HK; f32x4 acc[2][2][4][2];
            const bf16_t* Gp = (const bf16_t*)(ws + WS_G); const bf16_t* Yp = (const bf16_t*)(ws + WS_Y); const bf16_t* Wb = (const bf16_t*)(ws + WS_WBR);
            for (int i = 0; S.next(i, u); ++i) {
                { pg8::Gemm g{(const bf16_t*)(ws + WS_H), (const bf16_t*)(ws + WS_WIN) + (size_t)NPA * 1024, NTOK, NG, DM, DM, DM}; GateOrder GO{u.pm, u.pn};
                  EpiProj E{(bf16_t*)(ws + WS_G), NG, 1};
                  pg8::gemm_phase<EpiProj, GateOrder, NoHook, true, true>(lds, g, GO, E, HK, acc); }
                __syncthreads();
                OneUnit OU{u.pm, u.pn}; EpiNone EN;
                { pg8::Gemm g{Yp, Wb, NTOK, DM, 512, DM, DM};
                  pg8::gemm_phase<EpiNone, OneUnit, NoHook, false, true, true>(lds, g, OU, EN, HK, acc); }
                gate_rescale(acc, Gp, p.gate_b + l * NG, u.pm, u.pn, 0); __syncthreads();
                { pg8::Gemm g{Yp + 512, Wb + 512, NTOK, DM, 256, DM, DM};
                  pg8::gemm_phase<EpiNone, OneUnit, NoHook, false, true, false>(lds, g, OU, EN, HK, acc); }
                gate_rescale(acc, Gp, p.gate_b + l * NG, u.pm, u.pn, 1024); __syncthreads();
                { pg8::Gemm g{Yp + 768, Wb + 768, NTOK, DM, 256, DM, DM}; EpiMerge E{(bf16_t*)(ws + WS_MERGED), Gp, p.gate_b + l * NG};
                  pg8::gemm_phase<EpiMerge, OneUnit, NoHook, false, true, false>(lds, g, OU, E, HK, acc); }
                __syncthreads();
            }
        }
        }
        else {
        {
            pg8::Gemm g{(const bf16_t*)(ws + WS_MERGED), (const bf16_t*)(ws + WS_WOUT), NTOK, DM, DM, DM, DM}; pg8::StaticOrder S; S.init(NTOK, DM, G, bx); pg8::Unit u;
            NoHook HK; f32x4 acc[2][2][4][2];
            if (l == 1 && G == 256) {
                EpiOutNorm E{xin, p.out, (const float*)(ws + WS_SMALL + SM_GATEV) + l * 2048, p.final_g, (unsigned long long*)(ws + WS_SMALL + SM_XEX), (unsigned*)(ws + WS_SMALL + SM_XBAR + 16384)};
                for (int i = 0; S.next(i, u); ++i) { OneUnit OU{u.pm, u.pn};
                    pg8::gemm_phase<EpiOutNorm, OneUnit, NoHook, false, true>(lds, g, OU, E, HK, acc); __syncthreads(); }
            } else {
                EpiOut E{xin, p.out, (const float*)(ws + WS_SMALL + SM_GATEV) + l * 2048};
                for (int i = 0; S.next(i, u); ++i) { OneUnit OU{u.pm, u.pn};
                    pg8::gemm_phase<EpiOut, OneUnit, NoHook, false, true>(lds, g, OU, E, HK, acc); __syncthreads(); }
            }
        }
        }
        }
        if (ph + 1 < p.ph_hi && !(gridDim.x == 256 && ph == N_PHASES - 2)) GSYNC();
    }
}

extern "C" void kernel_launch(void* const* d_in, const int* in_sizes, int n_in, void* d_out, int out_size, void* d_ws, size_t ws_size, hipStream_t stream) {
    static int grid_blocks = 0;
    if (grid_blocks == 0) {
        int dev = 0, cus = 0, per_cu = 0;
        if (n_in != 18 || out_size != NTOK * DM || ws_size < WS_SMALL + SM_END) { fprintf(stderr, "kernel_launch: unexpected shapes (n_in %d out %d ws %zu)\n", n_in, out_size, ws_size); grid_blocks = -1; return; }
        hipGetDevice(&dev); hipDeviceGetAttribute(&cus, hipDeviceAttributeMultiprocessorCount, dev);
        if (hipFuncSetAttribute((const void*)mk_fwd, hipFuncAttributeMaxDynamicSharedMemorySize, LDS_BYTES) != hipSuccess) { fprintf(stderr, "kernel_launch: hipFuncSetAttribute failed\n"); }
        if (hipOccupancyMaxActiveBlocksPerMultiprocessor(&per_cu, (const void*)mk_fwd, 512, LDS_BYTES) != hipSuccess || per_cu < 1) { fprintf(stderr, "kernel_launch: occupancy query gave %d\n", per_cu); per_cu = 1; }
        (void)hipGetLastError();
        grid_blocks = cus * per_cu;
    }
    if (grid_blocks < 0) return;
    Params p{};
    const float** f = (const float**)&p;
    for (int i = 0; i < 18; ++i) f[i] = (const float*)d_in[i];
    p.out = (float*)d_out; p.ws = (unsigned char*)d_ws;
#ifndef MK_PHASES_PER_LAUNCH
#define MK_PHASES_PER_LAUNCH N_PHASES
#endif
    (void)hipMemsetAsync((unsigned char*)d_ws + WS_SMALL + SM_XBAR, 0, XBAR_BYTES, stream);
    for (int lo = 0; lo < N_PHASES; lo += MK_PHASES_PER_LAUNCH) {
        p.ph_lo = lo; p.ph_hi = lo + MK_PHASES_PER_LAUNCH < N_PHASES ? lo + MK_PHASES_PER_LAUNCH : N_PHASES;
        void* args[] = {&p};
        hipError_t e = hipLaunchCooperativeKernel((const void*)mk_fwd, dim3(grid_blocks), dim3(512), args, LDS_BYTES, stream);
        if (e != hipSuccess) { fprintf(stderr, "cooperative launch failed: %s (grid %d)\n", hipGetErrorString(e), grid_blocks); break; }
    }
}
```

```cpp
#include <hip/hip_runtime.h>
#include <hip/hip_cooperative_groups.h>
#include <cstdio>
#include <cstdint>
#include <cstddef>
namespace cg = cooperative_groups;
namespace pg8 {
#define PG8_LAS __attribute__((address_space(3)))
typedef unsigned short bf16_t;
typedef short bf16x8 __attribute__((ext_vector_type(8)));
typedef float f32x4 __attribute__((ext_vector_type(4)));
typedef unsigned u32x4 __attribute__((ext_vector_type(4)));
constexpr int BM = 256, BK = 64, HALF = 128, HTB = HALF * BK * 2  , STAGE_BYTES = 8 * HTB, NXCD = 8, WGM = 8;

__host__ __device__ __forceinline__ int lds_byte(int r, int c) { const int st = (r >> 4) * 2 + (c >> 5), rr = r & 15, cc = c & 31, ob = rr * 64 + cc * 2; return st * 1024 + (ob ^ (((ob >> 9) & 1) << 5)); }
__host__ __device__ __forceinline__ void stage_rc(int b, int& R, int& C) { const int st = b / 1024, sb = b % 1024, swz = sb ^ (((sb >> 9) & 1) << 5); R = (st >> 1) * 16 + swz / 64; C = (st & 1) * 32 + (swz % 64) / 2; }
__host__ __device__ __forceinline__ int perm32(int rho) { const int n = rho >> 4, i = rho & 15; return 8 * (i >> 2) + 4 * n + (i & 3); }

struct Unit { int pm, pn; };
struct Gemm { const bf16_t* A; const bf16_t* Bt; int M, N, K, lda, ldb; };

struct StaticOrder {
    int nM, nN, nwg, G, c;
    __host__ __device__ void init(int M, int N, int G_, int c_) { nM = M / BM; nN = N / BM; nwg = nM * nN; G = G_; c = c_; }
    __host__ __device__ bool next(int i, Unit& u) const {
        const long L = (long)i * G + c; if (L >= nwg) return false;
        int wgid = (int)L; { const int q = nwg / NXCD, r = nwg % NXCD, xcd = wgid % NXCD, off = wgid / NXCD; wgid = (xcd < r ? xcd * (q + 1) : r * (q + 1) + (xcd - r) * q) + off; }
        const int nig = WGM * nN, gid = wgid / nig, fm = gid * WGM, gsz = (nM - fm) < WGM ? (nM - fm) : WGM;
        u.pm = fm + ((wgid % nig) % gsz); u.pn = (wgid % nig) / gsz; return true;
    }
    __device__ __forceinline__ void a_ready(const Unit&) const {}
    __device__ __forceinline__ void done(const Unit&) const {}
};

__device__ __forceinline__ unsigned cvt_pk_bf16(float lo, float hi) { unsigned r; asm volatile("v_cvt_pk_bf16_f32 %0, %1, %2" : "=v"(r) : "v"(lo), "v"(hi)); return r; }
template <class Epi, class Sched, class Hook, bool ALIGN_EPI = false, bool SP2 = false, bool ZERO_ACC = true>
__device__ __forceinline__ void gemm_phase(PG8_LAS unsigned char* lds, const Gemm g, const Sched& S, const Epi& E, const Hook& HK, f32x4 (&acc)[2][2][4][2]) {
    int tid_ = threadIdx.x; asm volatile("" : "+v"(tid_));
    const int tid = tid_, wid = __builtin_amdgcn_readfirstlane(tid >> 6), lane = tid & 63, wr = wid >> 2, wc = wid & 3, fr = lane & 15, fq = lane >> 4;
    const int K = g.K, nt = K / BK;
    unsigned voffA[2], voffB[2];
#pragma unroll
    for (int i = 0; i < 2; ++i) { int R, C; stage_rc(tid * 16 + i * 8192, R, C); const int Rb = Epi::PERM ? ((R & ~31) + perm32(R & 31)) : R;
        voffA[i] = (unsigned)(R * g.lda + C) * 2u; voffB[i] = (unsigned)(Rb * g.ldb + C) * 2u; }
    const size_t kstep = (size_t)(BK * 2);
    const size_t hstepA = (size_t)HALF * g.lda * 2, hstepB = (size_t)HALF * g.ldb * 2;
    const size_t tstepA = 2 * hstepA, tstepB = 2 * hstepB;
    const unsigned ldsw = (unsigned)wid * 1024u;
    const int aoff = lds_byte(wr * 64 + fr, fq * 8), boff = lds_byte(wc * 32 + fr, fq * 8);
#define PG8_SA(b, h) (((b) * 2 + (h)) * HTB)
#define PG8_SB(b, h) ((4 + (b) * 2 + (h)) * HTB)
#define PG8_STAGE(bufoff, gbase, voff) do { _Pragma("unroll") for (int _i = 0; _i < 2; ++_i) \
        __builtin_amdgcn_global_load_lds((const unsigned*)((const char*)(gbase) + (voff)[_i]), (PG8_LAS unsigned*)(lds + (bufoff) + ldsw + _i * 8192), 16, 0, 0); } while (0)
#define PG8_LDA(dst, b, h) do { _Pragma("unroll") for (int m = 0; m < 4; ++m) _Pragma("unroll") for (int k = 0; k < 2; ++k) dst[m][k] = *(const PG8_LAS bf16x8*)(lds + PG8_SA(b, h) + aoff + m * 2048 + k * 1024); } while (0)
#define PG8_LDB(dst, b, h) do { _Pragma("unroll") for (int n = 0; n < 2; ++n) _Pragma("unroll") for (int k = 0; k < 2; ++k) dst[n][k] = *(const PG8_LAS bf16x8*)(lds + PG8_SB(b, h) + boff + n * 2048 + k * 1024); } while (0)
#define PG8_MMA(ai, bj, At, Bt) do { __builtin_amdgcn_s_setprio(1); _Pragma("unroll") for (int m = 0; m < 4; ++m) _Pragma("unroll") for (int n = 0; n < 2; ++n) _Pragma("unroll") for (int k = 0; k < 2; ++k) \
        acc[ai][bj][m][n] = __builtin_amdgcn_mfma_f32_16x16x32_bf16(Bt[n][k], At[m][k], acc[ai][bj][m][n], 0, 0, 0); __builtin_amdgcn_s_setprio(0); } while (0)
#define PG8_WAIT_V(n) asm volatile("s_waitcnt vmcnt(" #n ")" ::: "memory")
#define PG8_WAIT_L(n) asm volatile("s_waitcnt lgkmcnt(" #n ")" ::: "memory")
#define PG8_BAR __builtin_amdgcn_s_barrier()
#define PG8_SCHED __builtin_amdgcn_sched_barrier(0)
    Unit cur, nxt; int ui = 0;
    if (!S.next(0, cur)) return;
    if constexpr (ZERO_ACC) {
#pragma unroll
    for (int a = 0; a < 2; ++a)
#pragma unroll
        for (int b = 0; b < 2; ++b)
#pragma unroll
            for (int m = 0; m < 4; ++m)
#pragma unroll
                for (int n = 0; n < 2; ++n) acc[a][b][m][n] = (f32x4){0.f, 0.f, 0.f, 0.f};
    }
    bf16x8 At[4][2], B0[2][2], B1[2][2];
    const char* cA = (const char*)g.A + (size_t)cur.pm * tstepA; const char* cB = (const char*)g.Bt + (size_t)cur.pn * tstepB;
    S.a_ready(cur);
    if constexpr (SP2) {
        PG8_STAGE(PG8_SB(0, 0), cB, voffB); PG8_STAGE(PG8_SB(0, 1), cB + hstepB, voffB); PG8_STAGE(PG8_SA(0, 0), cA, voffA); PG8_STAGE(PG8_SA(0, 1), cA + hstepA, voffA);
        if (wr == 1) PG8_BAR;
        PG8_WAIT_V(2); PG8_BAR;
        PG8_STAGE(PG8_SB(1, 0), cB + kstep, voffB); PG8_STAGE(PG8_SA(1, 0), cA + kstep, voffA); PG8_STAGE(PG8_SB(1, 1), cB + hstepB + kstep, voffB);
        PG8_WAIT_V(6); PG8_BAR;
    } else {
        PG8_STAGE(PG8_SB(0, 0), cB, voffB); PG8_STAGE(PG8_SA(0, 0), cA, voffA); PG8_STAGE(PG8_SB(0, 1), cB + hstepB, voffB); PG8_STAGE(PG8_SA(0, 1), cA + hstepA, voffA);
        if (wr == 1) PG8_BAR;
        PG8_WAIT_V(4); PG8_BAR;
        PG8_STAGE(PG8_SB(1, 0), cB + kstep, voffB); PG8_STAGE(PG8_SA(1, 0), cA + kstep, voffA); PG8_STAGE(PG8_SB(1, 1), cB + hstepB + kstep, voffB);
        PG8_WAIT_V(6); PG8_BAR;
    }
    for (;;) {
        const bool has_next = S.next(ui + 1, nxt);
        const char* nA = has_next ? (const char*)g.A + (size_t)nxt.pm * tstepA : cA; const char* nB = has_next ? (const char*)g.Bt + (size_t)nxt.pn * tstepB : cB;
#pragma nounroll
        for (int t = 0; t < nt; t += 2) {
            const bool last = (t == nt - 2);
            if constexpr (Hook::ON) { if (t == Hook::T1 || t == Hook::T2) HK(acc, cur, t, wr, wc, fr, fq); }
            const char* a1 = cA + (size_t)(t + 1) * kstep;
            const char* a2 = last ? nA : cA + (size_t)(t + 2) * kstep; const char* b2 = last ? nB : cB + (size_t)(t + 2) * kstep;
            const char* a3 = a2 + kstep; const char* b3 = b2 + kstep;
            if (last && has_next) S.a_ready(nxt);
            if constexpr (SP2) {
            PG8_LDB(B0, 0, 0); PG8_LDB(B1, 0, 1); PG8_SCHED; PG8_LDA(At, 0, 0); PG8_STAGE(PG8_SA(1, 1), a1 + hstepA, voffA);
            PG8_WAIT_V(8); PG8_WAIT_L(0); PG8_BAR; PG8_MMA(0, 0, At, B0); PG8_MMA(0, 1, At, B1); PG8_BAR; PG8_SCHED;
            PG8_LDA(At, 0, 1); PG8_STAGE(PG8_SB(0, 0), b2, voffB); PG8_STAGE(PG8_SB(0, 1), b2 + hstepB, voffB); PG8_STAGE(PG8_SA(0, 0), a2, voffA);
            PG8_WAIT_V(8); PG8_WAIT_L(0); PG8_BAR; PG8_MMA(1, 0, At, B0); PG8_MMA(1, 1, At, B1); PG8_BAR; PG8_SCHED;
            PG8_LDB(B0, 1, 0); PG8_LDB(B1, 1, 1); PG8_SCHED; PG8_LDA(At, 1, 0); PG8_STAGE(PG8_SA(0, 1), a2 + hstepA, voffA);
            PG8_WAIT_V(8); PG8_WAIT_L(0); PG8_BAR; PG8_MMA(0, 0, At, B0); PG8_MMA(0, 1, At, B1); PG8_BAR; PG8_SCHED;
            PG8_LDA(At, 1, 1); PG8_STAGE(PG8_SB(1, 0), b3, voffB); PG8_STAGE(PG8_SB(1, 1), b3 + hstepB, voffB); PG8_STAGE(PG8_SA(1, 0), a3, voffA);
            PG8_WAIT_V(8); PG8_WAIT_L(0); PG8_BAR; PG8_MMA(1, 0, At, B0); PG8_MMA(1, 1, At, B1); PG8_BAR; PG8_SCHED;
            } else {
            PG8_LDB(B0, 0, 0); PG8_SCHED; PG8_LDA(At, 0, 0); PG8_STAGE(PG8_SA(1, 1), a1 + hstepA, voffA);
            PG8_WAIT_L(8); PG8_BAR; PG8_WAIT_L(0); PG8_MMA(0, 0, At, B0); PG8_BAR; PG8_SCHED;
            PG8_LDB(B1, 0, 1); PG8_STAGE(PG8_SB(0, 0), b2, voffB);
            PG8_BAR; PG8_WAIT_L(0); PG8_MMA(0, 1, At, B1); PG8_BAR;
            PG8_LDA(At, 0, 1); PG8_STAGE(PG8_SA(0, 0), a2, voffA);
            PG8_BAR; PG8_WAIT_L(0); PG8_MMA(1, 0, At, B0); PG8_BAR; PG8_SCHED;
            PG8_STAGE(PG8_SB(0, 1), b2 + hstepB, voffB);
            PG8_WAIT_V(6); PG8_BAR; PG8_MMA(1, 1, At, B1); PG8_BAR;
            PG8_LDB(B0, 1, 0); PG8_SCHED; PG8_LDA(At, 1, 0); PG8_STAGE(PG8_SA(0, 1), a2 + hstepA, voffA);
            PG8_WAIT_L(8); PG8_BAR; PG8_WAIT_L(0); PG8_MMA(0, 0, At, B0); PG8_BAR; PG8_SCHED;
            PG8_LDB(B1, 1, 1); PG8_STAGE(PG8_SB(1, 0), b3, voffB);
            PG8_BAR; PG8_WAIT_L(0); PG8_MMA(0, 1, At, B1); PG8_BAR;
            PG8_LDA(At, 1, 1); PG8_STAGE(PG8_SA(1, 0), a3, voffA);
            PG8_BAR; PG8_WAIT_L(0); PG8_MMA(1, 0, At, B0); PG8_BAR; PG8_SCHED;
            PG8_STAGE(PG8_SB(1, 1), b3 + hstepB, voffB);
            PG8_WAIT_V(6); PG8_BAR; PG8_MMA(1, 1, At, B1); PG8_BAR;
            }
        }
        if constexpr (ALIGN_EPI) { if (wr == 0) PG8_BAR; }
        if constexpr (!Epi::AFTER_DRAIN) { E(acc, cur, wr, wc, fr, fq); S.done(cur); }
        if (!has_next) break;
#pragma unroll
        for (int a = 0; a < 2; ++a)
#pragma unroll
            for (int b = 0; b < 2; ++b)
#pragma unroll
                for (int m = 0; m < 4; ++m)
#pragma unroll
                    for (int n = 0; n < 2; ++n) acc[a][b][m][n] = (f32x4){0.f, 0.f, 0.f, 0.f};
        cur = nxt; cA = nA; cB = nB; ++ui;
        if constexpr (ALIGN_EPI) { if (wr == 1) PG8_BAR; }
    }
    PG8_WAIT_V(0);
    if constexpr (!ALIGN_EPI) { if (wr == 0) PG8_BAR; }
    PG8_BAR;
    if constexpr (Epi::AFTER_DRAIN) { E.fused(acc, cur, wr, wc, fr, fq, lds, wid, lane); S.done(cur); }
#undef PG8_SA
#undef PG8_SB
#undef PG8_STAGE
#undef PG8_LDA
#undef PG8_LDB
#undef PG8_MMA
#undef PG8_WAIT_V
#undef PG8_WAIT_L
#undef PG8_BAR
#undef PG8_SCHED
}
}
#define LAS __attribute__((address_space(3)))
typedef unsigned short bf16_t;
typedef short bf16x8 __attribute__((ext_vector_type(8)));
typedef float f32x4 __attribute__((ext_vector_type(4)));
typedef unsigned u32x4 __attribute__((ext_vector_type(4)));
typedef unsigned u32x2 __attribute__((ext_vector_type(2)));
using pg8::cvt_pk_bf16;

constexpr int NTOK = 16384, DM = 1024, SEQ = 8192, NIN = 7176;
constexpr int NPA = 4096;
constexpr int NG = 3072;
constexpr float EPSF = 1e-6f;
constexpr int C_MQ = 0, C_MK = 512, C_MV = 1024, C_MO = 1536, C_MZ = 2048, C_PU = 2560, C_PZ = 2816, C_SQ = 3072, C_SK = 3328, C_SV = 3584, C_SZ = 3840;
constexpr size_t MiB = 1u << 20;
constexpr size_t WS_WIN = 0, WS_WBR = 14 * MiB, WS_WOUT = 16 * MiB, WS_H = 18 * MiB, WS_Y = 50 * MiB, WS_PROJ = 82 * MiB, WS_G = 82 * MiB, WS_MERGED = 178 * MiB,
                 WS_DC = 210 * MiB, WS_SMALL = 242 * MiB;
constexpr size_t SM_MODP = 0;
constexpr size_t SM_GATEV = SM_MODP + 2 * 16 * 2 * 3072 * 4;
constexpr size_t SM_IF = SM_GATEV + 2 * 2 * 1024 * 4;
constexpr size_t SM_DN = SM_IF + 2 * (size_t)NTOK * 8 * 4;
constexpr size_t SM_BEND = SM_DN + 2 * 512 * 128 * 4;
constexpr size_t SM_AMAX = SM_BEND + 4;
constexpr size_t SM_MPREV = SM_BEND + 2 * 512 * 128;
constexpr size_t SM_CPB = (SM_MPREV + 2 * 512 * 4 + 255) & ~(size_t)255;
constexpr size_t SM_XBAR = SM_CPB + (size_t)256 * 32768;
constexpr size_t XBAR_BYTES = 32768;
constexpr size_t SM_XEX = SM_XBAR + XBAR_BYTES;
constexpr size_t SM_END = SM_XEX + (size_t)NTOK * 4 * 8;
static_assert(WS_SMALL + SM_END <= 256 * MiB, "workspace map");
__device__ __forceinline__ bf16_t* cprev_slot(unsigned char* ws, int u) { return (bf16_t*)(u < 256 ? ws + WS_WIN + (size_t)u * 32768 : ws + WS_SMALL + SM_CPB + (size_t)(u - 256) * 32768); }
constexpr int LDS_BYTES = 147456;

struct Params {
    const float *x, *c, *norm_g, *w_ada, *b_ada, *w_in, *m_gate_b, *conv_w, *conv_b, *m_norm_g, *pool_w, *pool_scale, *w_br_m, *w_br_p, *w_br_s, *gate_b, *w_out, *final_g;
    float* out; unsigned char* ws; int ph_lo, ph_hi;
};

__device__ __forceinline__ float bf2f(unsigned short h) { return __uint_as_float(((unsigned)h) << 16); }
__device__ __forceinline__ float bflo(unsigned w) { return __uint_as_float(w << 16); }
__device__ __forceinline__ float bfhi(unsigned w) { return __uint_as_float(w & 0xffff0000u); }
__device__ __forceinline__ unsigned short f2bf(float f) { return (unsigned short)(cvt_pk_bf16(f, 0.f) & 0xffffu); }
__device__ __forceinline__ float fsigmoid(float x) { return __builtin_amdgcn_rcpf(1.f + __expf(-x)); }
__device__ __forceinline__ float fsilu(float x) { return x * fsigmoid(x); }
__device__ __forceinline__ float logsig(float x) { return fminf(x, 0.f) - log1pf(__expf(-fabsf(x))); }
__device__ __forceinline__ float wave_sum(float v) {
#pragma unroll
    for (int m = 32; m >= 1; m >>= 1) v += __shfl_xor(v, m);
    return v;
}
__device__ __forceinline__ f32x4 mfma16(bf16x8 a, bf16x8 b, f32x4 c) { return __builtin_amdgcn_mfma_f32_16x16x32_bf16(a, b, c, 0, 0, 0); }
__device__ __forceinline__ bf16x8 ldfrag(const LAS unsigned char* p) { return *(const LAS bf16x8*)p; }
__device__ __forceinline__ bf16x8 ldfrag2(const LAS unsigned char* pa, const LAS unsigned char* pb) {
    const u32x2 a = *(const LAS u32x2*)pa, b = *(const LAS u32x2*)pb; const u32x4 c = {a.x, a.y, b.x, b.y}; return __builtin_bit_cast(bf16x8, c);
}

#ifndef MK_WT
#define MK_WT 0
#endif
#if MK_WT
__device__ __forceinline__ void st16(void* p, u32x4 v) { asm volatile("global_store_dwordx4 %0, %1, off sc0 sc1\n\ts_nop 1" :: "v"(p), "v"(v) : "memory"); }
__device__ __forceinline__ void st16f(void* p, f32x4 v) { asm volatile("global_store_dwordx4 %0, %1, off sc0 sc1\n\ts_nop 1" :: "v"(p), "v"(v) : "memory"); }
__device__ __forceinline__ void st8(void* p, u32x2 v) { asm volatile("global_store_dwordx2 %0, %1, off sc0 sc1\n\ts_nop 1" :: "v"(p), "v"(v) : "memory"); }
__device__ __forceinline__ void st4(void* p, unsigned v) { asm volatile("global_store_dword %0, %1, off sc0 sc1\n\ts_nop 1" :: "v"(p), "v"(v) : "memory"); }
__device__ __forceinline__ void st4f(void* p, float v) { asm volatile("global_store_dword %0, %1, off sc0 sc1\n\ts_nop 1" :: "v"(p), "v"(v) : "memory"); }
#else
__device__ __forceinline__ void st16(void* p, u32x4 v) { *(u32x4*)p = v; }
__device__ __forceinline__ void st16f(void* p, f32x4 v) { *(f32x4*)p = v; }
__device__ __forceinline__ void st8(void* p, u32x2 v) { *(u32x2*)p = v; }
__device__ __forceinline__ void st4(void* p, unsigned v) { *(unsigned*)p = v; }
__device__ __forceinline__ void st4f(void* p, float v) { *(float*)p = v; }
#endif

struct NoHook { static constexpr bool ON = false; static constexpr int T1 = -1, T2 = -1;
    __device__ __forceinline__ void operator()(f32x4 (&)[2][2][4][2], const pg8::Unit&, int, int, int, int, int) const {} };

struct EpiProj {
    static constexpr bool PERM = true, AFTER_DRAIN = false;
    bf16_t* O; int pitch; int raw;
    __device__ __forceinline__ void operator()(const f32x4 (&acc)[2][2][4][2], const pg8::Unit& u, int wr, int wc, int fr, int fq) const {
        const int pn = u.pn; const int act = raw ? 0 : ((pn == 6 || pn == 7) ? 1 : ((pn == 8 || pn == 9 || pn == 11 || pn == 15) ? 2 : (pn == 12 ? 3 : 0)));
        const int row0 = u.pm * 256 + wr * 64 + fr, col0 = pn * 256 + wc * 32 + 8 * fq;
#pragma unroll
        for (int ai = 0; ai < 2; ++ai)
#pragma unroll
            for (int m = 0; m < 4; ++m) { bf16_t* rowp = O + (size_t)(row0 + ai * 128 + m * 16) * pitch + col0;
#pragma unroll
                for (int bj = 0; bj < 2; ++bj) { float v[8];
#pragma unroll
                    for (int e = 0; e < 4; ++e) { v[e] = acc[ai][bj][m][0][e]; v[4 + e] = acc[ai][bj][m][1][e]; }
                    if (act == 1) {
#pragma unroll
                        for (int e = 0; e < 8; ++e) v[e] = fsigmoid(v[e]);
                    } else if (act == 2) {
#pragma unroll
                        for (int e = 0; e < 8; ++e) v[e] = fsilu(v[e]);
                    } else if (act == 3) {
#pragma unroll
                        for (int e = 0; e < 8; ++e) v[e] *= 0.18033688011112042f;
                    }
                    u32x4 w; w.x = cvt_pk_bf16(v[0], v[1]); w.y = cvt_pk_bf16(v[2], v[3]); w.z = cvt_pk_bf16(v[4], v[5]); w.w = cvt_pk_bf16(v[6], v[7]);
                    st16(rowp + bj * 128, w); } }
    }
};

__device__ __forceinline__ void gate_rescale(f32x4 (&acc)[2][2][4][2], const bf16_t* G, const float* gbias, int pm, int pn, int goff) {
    int tx_ = threadIdx.x; asm volatile("" : "+v"(tx_)); const int wid = tx_ >> 6, lane = tx_ & 63, wr = wid >> 2, wc = wid & 3, fr = lane & 15, fq = lane >> 4;
    const int row0 = pm * 256 + wr * 64 + fr, col0 = pn * 256 + wc * 32 + 8 * fq;
    __builtin_amdgcn_sched_barrier(0);
#pragma unroll
    for (int bj = 0; bj < 2; ++bj) {
        const f32x4 ba0 = *(const f32x4*)(gbias + goff + col0 + bj * 128), ba1 = *(const f32x4*)(gbias + goff + col0 + bj * 128 + 4);
        const f32x4 bb0 = *(const f32x4*)(gbias + goff + 1024 + col0 + bj * 128), bb1 = *(const f32x4*)(gbias + goff + 1024 + col0 + bj * 128 + 4);
#pragma unroll
        for (int ai = 0; ai < 2; ++ai)
#pragma unroll
            for (int m = 0; m < 4; ++m) { const bf16_t* rowp = G + (size_t)(row0 + ai * 128 + m * 16) * NG + goff + col0 + bj * 128;
                const u32x4 a = __builtin_nontemporal_load((const u32x4*)rowp), b = *(const u32x4*)(rowp + 1024);
                const unsigned aw[4] = {a.x, a.y, a.z, a.w}, bw[4] = {b.x, b.y, b.z, b.w};
                f32x4 r0, r1;
#pragma unroll
                for (int e = 0; e < 2; ++e) {
                    r0[2 * e]     = (1.f + __expf(-(bflo(bw[e]) + bb0[2 * e])))         * __builtin_amdgcn_rcpf(1.f + __expf(-(bflo(aw[e]) + ba0[2 * e])));
                    r0[2 * e + 1] = (1.f + __expf(-(bfhi(bw[e]) + bb0[2 * e + 1])))     * __builtin_amdgcn_rcpf(1.f + __expf(-(bfhi(aw[e]) + ba0[2 * e + 1])));
                    r1[2 * e]     = (1.f + __expf(-(bflo(bw[2 + e]) + bb1[2 * e])))     * __builtin_amdgcn_rcpf(1.f + __expf(-(bflo(aw[2 + e]) + ba1[2 * e])));
                    r1[2 * e + 1] = (1.f + __expf(-(bfhi(bw[2 + e]) + bb1[2 * e + 1]))) * __builtin_amdgcn_rcpf(1.f + __expf(-(bfhi(aw[2 + e]) + ba1[2 * e + 1]))); }
                acc[ai][bj][m][0] *= r0; acc[ai][bj][m][1] *= r1;
                asm volatile("" : "+v"(acc[ai][bj][m][0]), "+v"(acc[ai][bj][m][1]) :: "memory");
                __builtin_amdgcn_sched_barrier(0); }
    }
    asm volatile("s_waitcnt vmcnt(0)" ::: "memory"); __builtin_amdgcn_sched_barrier(0);
}
struct EpiNone { static constexpr bool PERM = true, AFTER_DRAIN = true;
    __device__ __forceinline__ void fused(const f32x4 (&)[2][2][4][2], const pg8::Unit&, int, int, int, int, LAS unsigned char*, int, int) const {} };
struct EpiMerge {
    static constexpr bool PERM = true, AFTER_DRAIN = true;
    bf16_t* O; const bf16_t* G; const float* gbias;
    __device__ __forceinline__ void fused(const f32x4 (&acc)[2][2][4][2], const pg8::Unit& u, int wr, int wc, int fr, int fq, LAS unsigned char*, int, int) const {
        const int row0 = u.pm * 256 + wr * 64 + fr, col0 = u.pn * 256 + wc * 32 + 8 * fq;
#pragma unroll
        for (int ai = 0; ai < 2; ++ai)
#pragma unroll
            for (int m = 0; m < 4; ++m) { const size_t row = (size_t)(row0 + ai * 128 + m * 16);
#pragma unroll
                for (int bj = 0; bj < 2; ++bj) { const u32x4 g = __builtin_nontemporal_load((const u32x4*)(G + row * NG + 2048 + col0 + bj * 128));
                    const f32x4 b0 = *(const f32x4*)(gbias + 2048 + col0 + bj * 128), b1 = *(const f32x4*)(gbias + 2048 + col0 + bj * 128 + 4);
                    const f32x4 a0 = acc[ai][bj][m][0], a1 = acc[ai][bj][m][1];
                    u32x4 w; w.x = cvt_pk_bf16(a0[0] * fsigmoid(bflo(g.x) + b0[0]), a0[1] * fsigmoid(bfhi(g.x) + b0[1])); w.y = cvt_pk_bf16(a0[2] * fsigmoid(bflo(g.y) + b0[2]), a0[3] * fsigmoid(bfhi(g.y) + b0[3]));
                    w.z = cvt_pk_bf16(a1[0] * fsigmoid(bflo(g.z) + b1[0]), a1[1] * fsigmoid(bfhi(g.z) + b1[1])); w.w = cvt_pk_bf16(a1[2] * fsigmoid(bflo(g.w) + b1[2]), a1[3] * fsigmoid(bfhi(g.w) + b1[3]));
                    st16(O + row * DM + col0 + bj * 128, w); } }
    }
};
struct EpiOut {
    static constexpr bool PERM = true, AFTER_DRAIN = true;
    const float* xin; float* xout; const float* gate;
    __device__ __forceinline__ void fused(const f32x4 (&acc)[2][2][4][2], const pg8::Unit& u, int wr, int wc, int fr, int fq, LAS unsigned char*, int, int) const {
        const int row0 = u.pm * 256 + wr * 64 + fr, col0 = u.pn * 256 + wc * 32 + 8 * fq; const float* gb = gate + ((u.pm * 256) / SEQ) * 1024;
#pragma unroll
        for (int bj = 0; bj < 2; ++bj) {
            const f32x4 g0 = *(const f32x4*)(gb + col0 + bj * 128), g1 = *(const f32x4*)(gb + col0 + bj * 128 + 4);
#pragma unroll
            for (int ai = 0; ai < 2; ++ai)
#pragma unroll
                for (int m = 0; m < 4; ++m) { const size_t off = (size_t)(row0 + ai * 128 + m * 16) * DM + col0 + bj * 128;
                    const f32x4 x0 = __builtin_nontemporal_load((const f32x4*)(xin + off)), x1 = __builtin_nontemporal_load((const f32x4*)(xin + off + 4));
                    st16f(xout + off, x0 + g0 * acc[ai][bj][m][0]); st16f(xout + off + 4, x1 + g1 * acc[ai][bj][m][1]); }
        }
    }
};
struct EpiOutNorm {
    static constexpr bool PERM = true, AFTER_DRAIN = true;
    const float* xin; float* out; const float* gate; const float* fg; unsigned long long* xbuf; unsigned* cnt;
    __device__ __forceinline__ void fused(f32x4 (&acc)[2][2][4][2], const pg8::Unit& u, int wr, int wc, int fr, int fq, LAS unsigned char* lds, int wid, int lane) const {
        const int row0 = u.pm * 256 + wr * 64 + fr, col0 = u.pn * 256 + wc * 32 + 8 * fq; const float* gb = gate + ((u.pm * 256) / SEQ) * 1024;
        LAS float* P = (LAS float*)lds; LAS float* S = (LAS float*)(lds + 8192);
#pragma unroll
        for (int bj = 0; bj < 2; ++bj) {
            const f32x4 g0 = *(const f32x4*)(gb + col0 + bj * 128), g1 = *(const f32x4*)(gb + col0 + bj * 128 + 4);
#pragma unroll
            for (int ai = 0; ai < 2; ++ai)
#pragma unroll
                for (int m = 0; m < 4; ++m) { const size_t off = (size_t)(row0 + ai * 128 + m * 16) * DM + col0 + bj * 128;
                    acc[ai][bj][m][0] = __builtin_nontemporal_load((const f32x4*)(xin + off)) + g0 * acc[ai][bj][m][0]; acc[ai][bj][m][1] = __builtin_nontemporal_load((const f32x4*)(xin + off + 4)) + g1 * acc[ai][bj][m][1];
                    asm volatile("" : "+v"(acc[ai][bj][m][0]), "+v"(acc[ai][bj][m][1]) :: "memory"); }
        }
#pragma unroll
        for (int ai = 0; ai < 2; ++ai)
#pragma unroll
            for (int m = 0; m < 4; ++m) { float sq = 0.f;
#pragma unroll
                for (int bj = 0; bj < 2; ++bj)
#pragma unroll
                    for (int n = 0; n < 2; ++n) { const f32x4 v = acc[ai][bj][m][n]; sq += (v[0] * v[0] + v[1] * v[1]) + (v[2] * v[2] + v[3] * v[3]); }
                sq += __shfl_xor(sq, 16); sq += __shfl_xor(sq, 32);
                if (fq == 0) P[(ai * 128 + wr * 64 + m * 16 + fr) * 4 + wc] = sq; }
        __syncthreads();
        const int row = wid * 32 + (lane & 31);
        if (lane < 32) { const float t = (P[row * 4 + 0] + P[row * 4 + 1]) + (P[row * 4 + 2] + P[row * 4 + 3]);
            __hip_atomic_store(xbuf + ((size_t)(u.pm * 256 + row) * 4 + u.pn), (unsigned long long)__float_as_uint(t), __ATOMIC_RELAXED, __HIP_MEMORY_SCOPE_AGENT); }
        asm volatile("s_waitcnt vmcnt(0)" ::: "memory");
        if (lane == 0) __hip_atomic_fetch_add(cnt + 64 * u.pm, 1u, __ATOMIC_RELAXED, __HIP_MEMORY_SCOPE_AGENT);
        if (wid == 0) {
            for (unsigned spins = 0; spins < (1u << 22); ++spins) { if ((unsigned)__builtin_amdgcn_readfirstlane(__hip_atomic_load(cnt + 64 * u.pm, __ATOMIC_RELAXED, __HIP_MEMORY_SCOPE_AGENT)) >= 32u) break; __builtin_amdgcn_s_sleep(2); }
            __builtin_amdgcn_fence(__ATOMIC_ACQUIRE, "agent");
        }
        asm volatile("s_waitcnt vmcnt(0) lgkmcnt(0)" ::: "memory");
        __syncthreads();
        if (lane < 32) { const unsigned long long* slot = xbuf + (size_t)(u.pm * 256 + row) * 4; float t = 0.f;
#pragma unroll
            for (int q = 0; q < 4; ++q) t += __uint_as_float((unsigned)__hip_atomic_load(slot + q, __ATOMIC_RELAXED, __HIP_MEMORY_SCOPE_AGENT));
            S[row] = rsqrtf(t * (1.f / 1024.f) + EPSF); }
        __syncthreads();
#pragma unroll
        for (int bj = 0; bj < 2; ++bj) {
            const f32x4 f0 = *(const f32x4*)(fg + col0 + bj * 128), f1 = *(const f32x4*)(fg + col0 + bj * 128 + 4);
#pragma unroll
            for (int ai = 0; ai < 2; ++ai)
#pragma unroll
                for (int m = 0; m < 4; ++m) { const size_t off = (size_t)(row0 + ai * 128 + m * 16) * DM + col0 + bj * 128; const float r = S[ai * 128 + wr * 64 + m * 16 + fr];
                    *(f32x4*)(out + off) = acc[ai][bj][m][0] * r * f0; *(f32x4*)(out + off + 4) = acc[ai][bj][m][1] * r * f1; }
        }
    }
};
struct GateOrder { int pm, pn;
    __device__ __forceinline__ bool next(int i, pg8::Unit& u) const { if (i >= 3) return false; u.pm = pm; u.pn = pn + 4 * i; return true; }
    __device__ __forceinline__ void a_ready(const pg8::Unit&) const {}
    __device__ __forceinline__ void done(const pg8::Unit&) const {} };
struct OneUnit { int pm, pn;
    __device__ __forceinline__ bool next(int i, pg8::Unit& u) const { if (i >= 1) return false; u.pm = pm; u.pn = pn; return true; }
    __device__ __forceinline__ void a_ready(const pg8::Unit&) const {}
    __device__ __forceinline__ void done(const pg8::Unit&) const {} };

__device__ __forceinline__ void phase_mod(const Params& p, float* MODP) {
    for (int u = blockIdx.x; u < 192; u += gridDim.x) {
        const int l = u / 96, r = u % 96, ks = r / 6, jb = r % 6; int tx_ = threadIdx.x; asm volatile("" : "+v"(tx_)); const int j = jb * 512 + tx_;
        const float* w = p.w_ada + ((size_t)l * 1024 + ks * 64) * 3072 + j; const float* c0 = p.c + ks * 64; const float* c1 = p.c + 1024 + ks * 64;
        float a0 = 0.f, a1 = 0.f;
#pragma unroll 8
        for (int k = 0; k < 64; ++k) { const float wv = w[(size_t)k * 3072]; a0 += c0[k] * wv; a1 += c1[k] * wv; }
        st4f(MODP + ((l * 16 + ks) * 2 + 0) * 3072 + j, a0); st4f(MODP + ((l * 16 + ks) * 2 + 1) * 3072 + j, a1);
    }
}

struct TItem { const float* src; int ld; bf16_t* dst; };
__device__ __forceinline__ TItem transpose_item(const Params& p, int l, int it, bf16_t* WinT, bf16_t* WbrT, bf16_t* WoutT) {
    TItem t;
    if (it < 1792) { const int nt = it >> 4, kt = it & 15, n0 = nt * 64, c0 = n0 < 1536 ? n0 : n0 + 8;
        t.src = p.w_in + (size_t)l * 1024 * NIN + (size_t)kt * 64 * NIN + c0; t.ld = NIN; t.dst = WinT + (size_t)n0 * 1024 + kt * 64;
    } else if (it < 2048) { const int j = it - 1792, nt = j >> 4, kt = j & 15, k0 = kt * 64;
        const float* src = k0 < 512 ? p.w_br_m + (size_t)l * 512 * 1024 + (size_t)k0 * 1024 : (k0 < 768 ? p.w_br_p + (size_t)l * 256 * 1024 + (size_t)(k0 - 512) * 1024 : p.w_br_s + (size_t)l * 256 * 1024 + (size_t)(k0 - 768) * 1024);
        t.src = src + nt * 64; t.ld = 1024; t.dst = WbrT + (size_t)nt * 64 * 1024 + k0;
    } else { const int j = it - 2048, nt = j >> 4, kt = j & 15;
        t.src = p.w_out + (size_t)l * 1024 * 1024 + (size_t)kt * 64 * 1024 + nt * 64; t.ld = 1024; t.dst = WoutT + (size_t)nt * 64 * 1024 + kt * 64; }
    return t;
}
__device__ __forceinline__ void phase_prep(const Params& p, int l, const float* xin, LAS unsigned char* lds, unsigned char* ws_in) {
    size_t wz_ = 0; asm volatile("" : "+s"(wz_)); unsigned char* ws = ws_in + wz_;
    int tid_ = threadIdx.x; asm volatile("" : "+v"(tid_)); const int tid = tid_, lane = tid & 63, wid = tid >> 6;
    bf16_t* WinT = (bf16_t*)(ws + WS_WIN); bf16_t* WbrT = (bf16_t*)(ws + WS_WBR); bf16_t* WoutT = (bf16_t*)(ws + WS_WOUT);
    LAS float* tl = (LAS float*)lds;
    { float tv[8]; int it = blockIdx.x;
      if (it < 2304) { const TItem t0 = transpose_item(p, l, it, WinT, WbrT, WoutT);
#pragma unroll
          for (int i = 0; i < 8; ++i) tv[i] = __builtin_nontemporal_load(t0.src + (size_t)(i * 8 + (tid >> 6)) * t0.ld + (tid & 63)); }
      for (; it < 2304; it += gridDim.x) {
          const TItem t = transpose_item(p, l, it, WinT, WbrT, WoutT);
#pragma unroll
          for (int i = 0; i < 8; ++i) tl[(i * 8 + (tid >> 6)) * 65 + (tid & 63)] = tv[i];
          __syncthreads();
          if (it + (int)gridDim.x < 2304) { const TItem tn = transpose_item(p, l, it + gridDim.x, WinT, WbrT, WoutT);
#pragma unroll
              for (int i = 0; i < 8; ++i) tv[i] = __builtin_nontemporal_load(tn.src + (size_t)(i * 8 + (tid >> 6)) * tn.ld + (tid & 63)); }
#pragma unroll
          for (int i = 0; i < 4; ++i) { const int nn = i * 16 + (tid >> 5), kk = (tid & 31) * 2; st4(t.dst + (size_t)nn * 1024 + kk, cvt_pk_bf16(tl[kk * 65 + nn], tl[(kk + 1) * 65 + nn])); }
          __syncthreads();
      } }
    const float* MODP = (const float*)(ws + WS_SMALL + SM_MODP) + (size_t)l * 16 * 2 * 3072;
    float* GATEV = (float*)(ws + WS_SMALL + SM_GATEV) + l * 2048; float* IFG = (float*)(ws + WS_SMALL + SM_IF + (size_t)l * NTOK * 32);
    bf16_t* H = (bf16_t*)(ws + WS_H);
    LAS float* A = (LAS float*)(lds + 16896); LAS float* Sh = A + 1024; LAS float* Wif = Sh + 1024;
    for (int rb = blockIdx.x; rb < 256; rb += gridDim.x) {
        const int b = (rb * 64) / SEQ;
        __syncthreads();
#pragma unroll
        for (int q = 0; q < 2; ++q) { const int k = tid + q * 512; float sh = p.b_ada[l * 3072 + k], sc = p.b_ada[l * 3072 + 1024 + k];
            for (int ks = 0; ks < 16; ++ks) { sh += MODP[(ks * 2 + b) * 3072 + k]; sc += MODP[(ks * 2 + b) * 3072 + 1024 + k]; }
            A[k] = p.norm_g[l * 1024 + k] * (1.f + sc); Sh[k] = sh; }
        if (rb < 4) { const int e = rb * 512 + tid, bb = e >> 10, j = e & 1023; float g = p.b_ada[l * 3072 + 2048 + j];
            for (int ks = 0; ks < 16; ++ks) g += MODP[(ks * 2 + bb) * 3072 + 2048 + j];
            st4f(GATEV + bb * 1024 + j, g); }
#pragma unroll
        for (int q = 0; q < 16; ++q) { const int e = tid + q * 512, k = e >> 3, g = e & 7; Wif[g * 1024 + k] = p.w_in[(size_t)l * 1024 * NIN + (size_t)k * NIN + 1536 + g]; }
        __syncthreads();
        f32x4 xn[4];
        { const float* xr0 = xin + (size_t)(rb * 64 + wid * 8) * DM;
#pragma unroll
          for (int j = 0; j < 4; ++j) xn[j] = __builtin_nontemporal_load((const f32x4*)(xr0 + (j >> 1) * 512 + lane * 8 + (j & 1) * 4)); }
        for (int i = 0; i < 8; ++i) {
            const int row = rb * 64 + wid * 8 + i;
            f32x4 xv[4]; float ss = 0.f;
#pragma unroll
            for (int j = 0; j < 4; ++j) { xv[j] = xn[j]; ss += xv[j][0] * xv[j][0] + xv[j][1] * xv[j][1] + xv[j][2] * xv[j][2] + xv[j][3] * xv[j][3]; }
            if (i < 7) { const float* xr1 = xin + (size_t)(row + 1) * DM;
#pragma unroll
                for (int j = 0; j < 4; ++j) xn[j] = __builtin_nontemporal_load((const f32x4*)(xr1 + (j >> 1) * 512 + lane * 8 + (j & 1) * 4)); }
            ss = wave_sum(ss); const float rstd = rsqrtf(ss * (1.f / 1024.f) + EPSF);
            float gp[8];
#pragma unroll
            for (int g = 0; g < 8; ++g) gp[g] = 0.f;
            f32x4 hv[4];
#pragma unroll
            for (int j = 0; j < 4; ++j) { const int k = (j >> 1) * 512 + lane * 8 + (j & 1) * 4; const f32x4 a = *(const LAS f32x4*)(A + k), sft = *(const LAS f32x4*)(Sh + k);
                hv[j] = xv[j] * rstd * a + sft;
#pragma unroll
                for (int g = 0; g < 8; ++g) { const f32x4 wv = *(const LAS f32x4*)(Wif + g * 1024 + k); gp[g] += hv[j][0] * wv[0] + hv[j][1] * wv[1] + hv[j][2] * wv[2] + hv[j][3] * wv[3]; } }
#pragma unroll
            for (int j = 0; j < 2; ++j) { u32x4 w; w.x = cvt_pk_bf16(hv[2 * j][0], hv[2 * j][1]); w.y = cvt_pk_bf16(hv[2 * j][2], hv[2 * j][3]); w.z = cvt_pk_bf16(hv[2 * j + 1][0], hv[2 * j + 1][1]); w.w = cvt_pk_bf16(hv[2 * j + 1][2], hv[2 * j + 1][3]);
                st16(H + (size_t)row * DM + j * 512 + lane * 8, w); }
#pragma unroll
            for (int g = 0; g < 8; ++g) gp[g] = wave_sum(gp[g]);
            float outv = gp[0];
#pragma unroll
            for (int g = 1; g < 8; ++g) outv = (lane == g) ? gp[g] : outv;
            if (lane < 8) st4f(IFG + (size_t)row * 8 + lane, outv + p.m_gate_b[l * 8 + lane]);
        }
    }
    __syncthreads();
}

constexpr int LP = 136;
constexpr int OFF_Q = 0, OFF_K = 34816, OFF_V = 69632, OFF_C = 104448, OFF_AR = 139264;
template <int MODE> __device__ __forceinline__ void mlstm_gates(const float* IFG, int tok0, int hd, float mprev, LAS float* ar, int tid) {
    if (tid < 64) { const int l = tid;
        const float i0 = IFG[(size_t)(tok0 + 2 * l) * 8 + hd], i1 = IFG[(size_t)(tok0 + 2 * l + 1) * 8 + hd];
        const float f0 = logsig(IFG[(size_t)(tok0 + 2 * l) * 8 + 4 + hd]), f1 = logsig(IFG[(size_t)(tok0 + 2 * l + 1) * 8 + 4 + hd]);
        float sc = f0 + f1;
#pragma unroll
        for (int d = 1; d < 64; d <<= 1) { const float t = __shfl_up(sc, d); if (l >= d) sc += t; }
        const float c1 = sc, c0 = sc - f1;
        ar[2 * l] = i0; ar[2 * l + 1] = i1; ar[128 + 2 * l] = c0; ar[128 + 2 * l + 1] = c1;
        if (MODE == 1) { const float bend = __shfl(c1, 63); const float a0 = bend - c0 + i0, a1 = bend - c1 + i1; float am = fmaxf(a0, a1);
#pragma unroll
            for (int m = 32; m >= 1; m >>= 1) am = fmaxf(am, __shfl_xor(am, m));
            ar[3 * 128 + 2 * l] = __expf(a0 - am); ar[3 * 128 + 2 * l + 1] = __expf(a1 - am);
            if (l == 0) { ar[7 * 128] = bend; ar[7 * 128 + 1] = am; } }
        if (MODE == 3) { const float g0 = i0 - c0, g1 = i1 - c1; float pm = fmaxf(g0, g1);
#pragma unroll
            for (int d = 1; d < 64; d <<= 1) { const float t = __shfl_up(pm, d); if (l >= d) pm = fmaxf(pm, t); }
            float pprev = __shfl_up(pm, 1); if (l == 0) pprev = -3.0e38f;
            const float pm0 = fmaxf(pprev, g0), pm1 = pm;
            const float mt0 = c0 + fmaxf(mprev, pm0), mt1 = c1 + fmaxf(mprev, pm1);
            ar[2 * 128 + 2 * l] = g0; ar[2 * 128 + 2 * l + 1] = g1;
            ar[3 * 128 + 2 * l] = __expf(c0 + mprev - mt0); ar[3 * 128 + 2 * l + 1] = __expf(c1 + mprev - mt1);
            ar[4 * 128 + 2 * l] = c0 - mt0; ar[4 * 128 + 2 * l + 1] = c1 - mt1;
            ar[5 * 128 + 2 * l] = __expf(-mt0); ar[5 * 128 + 2 * l + 1] = __expf(-mt1); }
    }
}
template <bool TR> __device__ __forceinline__ void stage_conv(const bf16_t* PROJ, int colbase, const float* cw, const float* cb, int ch0, int tok0, int pos0, float scale, LAS bf16_t* dst, int tid) {
    const int d0 = (tid & 15) * 8, s0 = (tid >> 4) * 4;
    float x[7][8];
    const bf16_t* src = PROJ + (size_t)tok0 * NPA + colbase + d0;
#pragma unroll
    for (int r = 0; r < 7; ++r) { const int sr = s0 - 3 + r; u32x4 v = {0u, 0u, 0u, 0u}; if (pos0 + sr >= 0) v = *(const u32x4*)(src + (ptrdiff_t)sr * NPA);
        x[r][0] = bflo(v.x); x[r][1] = bfhi(v.x); x[r][2] = bflo(v.y); x[r][3] = bfhi(v.y); x[r][4] = bflo(v.z); x[r][5] = bfhi(v.z); x[r][6] = bflo(v.w); x[r][7] = bfhi(v.w); }
    float o[4][8];
    { const f32x4 b0 = *(const f32x4*)(cb + ch0 + d0), b1 = *(const f32x4*)(cb + ch0 + d0 + 4);
#pragma unroll
      for (int i = 0; i < 4; ++i) { o[i][0] = b0[0]; o[i][1] = b0[1]; o[i][2] = b0[2]; o[i][3] = b0[3]; o[i][4] = b1[0]; o[i][5] = b1[1]; o[i][6] = b1[2]; o[i][7] = b1[3]; } }
#pragma unroll
    for (int j = 0; j < 4; ++j) { const f32x4 w0 = *(const f32x4*)(cw + j * 1024 + ch0 + d0), w1 = *(const f32x4*)(cw + j * 1024 + ch0 + d0 + 4);
#pragma unroll
        for (int i = 0; i < 4; ++i) { o[i][0] += w0[0] * x[i + j][0]; o[i][1] += w0[1] * x[i + j][1]; o[i][2] += w0[2] * x[i + j][2]; o[i][3] += w0[3] * x[i + j][3];
                                      o[i][4] += w1[0] * x[i + j][4]; o[i][5] += w1[1] * x[i + j][5]; o[i][6] += w1[2] * x[i + j][6]; o[i][7] += w1[3] * x[i + j][7]; } }
#pragma unroll
    for (int i = 0; i < 4; ++i)
#pragma unroll
        for (int c = 0; c < 8; ++c) o[i][c] = fsilu(o[i][c]) * scale;
    if (TR) {
#pragma unroll
        for (int c = 0; c < 8; ++c) { u32x2 w; w.x = cvt_pk_bf16(o[0][c], o[1][c]); w.y = cvt_pk_bf16(o[2][c], o[3][c]); *(LAS u32x2*)(dst + (d0 + c) * LP + s0) = w; }
    } else {
#pragma unroll
        for (int i = 0; i < 4; ++i) { u32x4 w; w.x = cvt_pk_bf16(o[i][0], o[i][1]); w.y = cvt_pk_bf16(o[i][2], o[i][3]); w.z = cvt_pk_bf16(o[i][4], o[i][5]); w.w = cvt_pk_bf16(o[i][6], o[i][7]); *(LAS u32x4*)(dst + (s0 + i) * LP + d0) = w; }
    }
}
template <bool SCALE> __device__ __forceinline__ void stage_vt(const bf16_t* PROJ, int tok0, int hd, const LAS float* wa, LAS bf16_t* dst, int tid) {
#pragma unroll
    for (int q = 0; q < 4; ++q) { const int s = tid & 127, d0 = ((tid >> 7) + 4 * q) * 8;
        const u32x4 v = *(const u32x4*)(PROJ + (size_t)(tok0 + s) * NPA + C_MV + hd * 128 + d0); const float sc = SCALE ? wa[s] : 1.f;
        const unsigned wv[4] = {v.x, v.y, v.z, v.w};
#pragma unroll
        for (int e = 0; e < 4; ++e) { const float lo = bflo(wv[e]) * sc, hi = bfhi(wv[e]) * sc;
            dst[(d0 + 2 * e) * LP + s] = SCALE ? f2bf(lo) : (bf16_t)(wv[e] & 0xffffu); dst[(d0 + 2 * e + 1) * LP + s] = SCALE ? f2bf(hi) : (bf16_t)(wv[e] >> 16); } }
}

__device__ __forceinline__ void mlstm_m1(const Params& p, int l, LAS unsigned char* lds, unsigned char* ws_in) {
    size_t wz_ = 0; asm volatile("" : "+s"(wz_)); unsigned char* ws = ws_in + wz_;
    int tid_ = threadIdx.x; asm volatile("" : "+v"(tid_)); const int tid = tid_, lane = tid & 63, wid = tid >> 6, fr = lane & 15, fq = lane >> 4;
    const bf16_t* PROJ = (const bf16_t*)(ws + WS_PROJ); const float* IFG = (const float*)(ws + WS_SMALL + SM_IF + (size_t)l * NTOK * 32);
    float* DC = (float*)(ws + WS_DC); float* DN = (float*)(ws + WS_SMALL + SM_DN + (size_t)l * 262144); float* BEND = (float*)(ws + WS_SMALL + SM_BEND + (size_t)l * 65536); float* AMAX = (float*)(ws + WS_SMALL + SM_AMAX + (size_t)l * 65536);
    LAS float* ar = (LAS float*)(lds + OFF_AR); LAS bf16_t* Vt = (LAS bf16_t*)(lds + OFF_V); LAS bf16_t* Kt = (LAS bf16_t*)(lds + OFF_K);
    for (int u = blockIdx.x; u < 512; u += gridDim.x) {
        const int b = u >> 8, hd = (u >> 6) & 3, c = u & 63, tok0 = b * SEQ + c * 128, pos0 = c * 128;
        __syncthreads();
        mlstm_gates<1>(IFG, tok0, hd, 0.f, ar, tid);
        __syncthreads();
        const float bend = ar[7 * 128], amax = ar[7 * 128 + 1];
        stage_vt<true>(PROJ, tok0, hd, ar + 3 * 128, Vt, tid);
        stage_conv<true>(PROJ, C_MK + hd * 128, p.conv_w + (size_t)l * 4096, p.conv_b + l * 1024, 512 + hd * 128, tok0, pos0, 0.08838834764831845f, Kt, tid);
        __syncthreads();
        f32x4 acc[8];
#pragma unroll
        for (int j = 0; j < 8; ++j) acc[j] = (f32x4){0.f, 0.f, 0.f, 0.f};
#pragma unroll
        for (int ks = 0; ks < 4; ++ks) { const bf16x8 a = ldfrag((const LAS unsigned char*)(Vt + (16 * wid + fr) * LP + ks * 32 + fq * 8));
#pragma unroll
            for (int j = 0; j < 8; ++j) acc[j] = mfma16(ldfrag((const LAS unsigned char*)(Kt + (16 * j + fr) * LP + ks * 32 + fq * 8)), a, acc[j]); }
        bf16_t* dcu = (bf16_t*)(DC + (size_t)u * 16384);
#pragma unroll
        for (int j = 0; j < 8; ++j) { u32x2 w; w.x = cvt_pk_bf16(acc[j][0], acc[j][1]); w.y = cvt_pk_bf16(acc[j][2], acc[j][3]); st8(dcu + (16 * wid + fr) * 128 + 16 * j + 4 * fq, w); }
        if (tid < 128) { float sn = 0.f;
#pragma unroll 4
            for (int jj = 0; jj < 16; ++jj) { const u32x4 kv = *(const LAS u32x4*)(Kt + tid * LP + jj * 8); const f32x4 w0 = *(const LAS f32x4*)(ar + 3 * 128 + jj * 8), w1 = *(const LAS f32x4*)(ar + 3 * 128 + jj * 8 + 4);
                sn += w0[0] * bflo(kv.x) + w0[1] * bfhi(kv.x) + w0[2] * bflo(kv.y) + w0[3] * bfhi(kv.y) + w1[0] * bflo(kv.z) + w1[1] * bfhi(kv.z) + w1[2] * bflo(kv.w) + w1[3] * bfhi(kv.w); }
            st4f(DN + u * 128 + tid, sn); }
        if (tid == 0) { st4f(BEND + u * 32, bend); st4f(AMAX + u * 32, amax); }
    }
    __syncthreads();
}

__device__ __forceinline__ void scan_load(float (&dcv)[64], unsigned char* ws, int idx) {
    const int bh = idx >> 14, e = idx & 16383; const bf16_t* base = (const bf16_t*)(ws + WS_DC) + (size_t)bh * 64 * 32768 + e;
#pragma unroll
    for (int c = 0; c < 64; ++c) dcv[c] = bf2f(base[(size_t)c * 32768]);
}
__device__ __forceinline__ void scan_finish(const float (&dcv)[64], int l, unsigned char* ws, int idx) {
    const float* BEND = (const float*)(ws + WS_SMALL + SM_BEND + (size_t)l * 65536); const float* AMAX = (const float*)(ws + WS_SMALL + SM_AMAX + (size_t)l * 65536);
    float* MPREV = (float*)(ws + WS_SMALL + SM_MPREV + (size_t)l * 2048);
    const int bh = idx >> 14, e = idx & 16383;
    float m = 0.f, cst = 0.f;
#pragma unroll
    for (int c = 0; c < 64; ++c) { const float be = BEND[(bh * 64 + c) * 32], am = AMAX[(bh * 64 + c) * 32]; const float mn = fmaxf(be + m, am), dec = __expf(be + m - mn), inw = __expf(am - mn);
        cprev_slot(ws, bh * 64 + c)[e] = f2bf(cst); cst = dec * cst + inw * dcv[c]; if (e == 0) st4f(MPREV + bh * 64 + c, m); m = mn; }
}
__device__ __forceinline__ void mlstm_scan(int l, unsigned char* ws_in) {
    size_t wz_ = 0; asm volatile("" : "+s"(wz_)); unsigned char* ws = ws_in + wz_;
    int tx_ = threadIdx.x; asm volatile("" : "+v"(tx_));
    for (int idx = blockIdx.x * 512 + tx_; idx < 8 * 16384; idx += gridDim.x * 512) { float dcv[64]; scan_load(dcv, ws, idx); scan_finish(dcv, l, ws, idx); }
}
__device__ __forceinline__ void mlstm_scan_n(int l, unsigned char* ws_in) {
    size_t wz_ = 0; asm volatile("" : "+s"(wz_)); unsigned char* ws = ws_in + wz_;
    float* DN = (float*)(ws + WS_SMALL + SM_DN + (size_t)l * 262144); const float* BEND = (const float*)(ws + WS_SMALL + SM_BEND + (size_t)l * 65536); const float* AMAX = (const float*)(ws + WS_SMALL + SM_AMAX + (size_t)l * 65536);
    int tx_ = threadIdx.x; asm volatile("" : "+v"(tx_));
    for (int idx = (tx_ < 64 && gridDim.x >= 16) ? (int)blockIdx.x * 64 + tx_ : (gridDim.x >= 16 ? 8 * 128 : (int)blockIdx.x * 512 + tx_); idx < 8 * 128; idx += (gridDim.x >= 16 ? 8 * 128 : gridDim.x * 512)) {
        const int bh = idx >> 7, e = idx & 127;
        float* base = DN + (size_t)bh * 64 * 128 + e;
        float dcv[64];
#pragma unroll
        for (int c = 0; c < 64; ++c) dcv[c] = base[c * 128];
        float m = 0.f, cst = 0.f;
#pragma unroll
        for (int c = 0; c < 64; ++c) { const float be = BEND[(bh * 64 + c) * 32], am = AMAX[(bh * 64 + c) * 32]; const float mn = fmaxf(be + m, am), dec = __expf(be + m - mn), inw = __expf(am - mn);
            st4f(base + c * 128, cst); cst = dec * cst + inw * dcv[c]; m = mn; }
    }
}

__device__ __forceinline__ void mlstm_m3(const Params& p, int l, LAS unsigned char* lds, unsigned char* ws_in) {
    size_t wz_ = 0; asm volatile("" : "+s"(wz_)); unsigned char* ws = ws_in + wz_;
    int tid_ = threadIdx.x; asm volatile("" : "+v"(tid_)); const int tid = tid_, lane = tid & 63, wid = tid >> 6, fr = lane & 15, fq = lane >> 4;
    const bf16_t* PROJ = (const bf16_t*)(ws + WS_PROJ); const float* IFG = (const float*)(ws + WS_SMALL + SM_IF + (size_t)l * NTOK * 32);
    const float* DC = (const float*)(ws + WS_DC); const float* DN = (const float*)(ws + WS_SMALL + SM_DN + (size_t)l * 262144); const float* MPREV = (const float*)(ws + WS_SMALL + SM_MPREV + (size_t)l * 2048);
    bf16_t* Y = (bf16_t*)(ws + WS_Y);
    LAS float* ar = (LAS float*)(lds + OFF_AR);
    LAS bf16_t* Qc = (LAS bf16_t*)(lds + OFF_Q); LAS bf16_t* Kc = (LAS bf16_t*)(lds + OFF_K); LAS bf16_t* Vt = (LAS bf16_t*)(lds + OFF_V); LAS bf16_t* Cp = (LAS bf16_t*)(lds + OFF_C);
    for (int u = blockIdx.x; u < 512; u += gridDim.x) {
        const int b = u >> 8, hd = (u >> 6) & 3, c = u & 63, tok0 = b * SEQ + c * 128, pos0 = c * 128;
        __syncthreads();
        const float mprev = MPREV[u];
        mlstm_gates<3>(IFG, tok0, hd, mprev, ar, tid);
        if (tid >= 64 && tid < 192) ar[6 * 128 + tid - 64] = DN[u * 128 + tid - 64];
        stage_conv<false>(PROJ, C_MQ + hd * 128, p.conv_w + (size_t)l * 4096, p.conv_b + l * 1024, hd * 128, tok0, pos0, 1.f, Qc, tid);
        stage_conv<false>(PROJ, C_MK + hd * 128, p.conv_w + (size_t)l * 4096, p.conv_b + l * 1024, 512 + hd * 128, tok0, pos0, 0.08838834764831845f, Kc, tid);
        stage_vt<false>(PROJ, tok0, hd, nullptr, Vt, tid);
        { const bf16_t* cpu = cprev_slot(ws, u);
#pragma unroll
          for (int q = 0; q < 4; ++q) { const int e = (q * 512 + tid) * 8, v = e >> 7, k = e & 127; *(LAS u32x4*)(Cp + v * LP + k) = *(const u32x4*)(cpu + e); } }
        __syncthreads();
        const int tl = 16 * wid + fr;
        bf16x8 qf[4];
#pragma unroll
        for (int ks = 0; ks < 4; ++ks) qf[ks] = ldfrag((const LAS unsigned char*)(Qc + tl * LP + ks * 32 + fq * 8));
        f32x4 acc[8];
#pragma unroll
        for (int vi = 0; vi < 8; ++vi) { acc[vi] = (f32x4){0.f, 0.f, 0.f, 0.f};
#pragma unroll
            for (int ks = 0; ks < 4; ++ks) acc[vi] = mfma16(ldfrag((const LAS unsigned char*)(Cp + (16 * vi + fr) * LP + ks * 32 + fq * 8)), qf[ks], acc[vi]); }
        float deni = 0.f;
#pragma unroll
        for (int kk = 0; kk < 4; ++kk) { const u32x4 qv = *(const LAS u32x4*)(Qc + tl * LP + fq * 32 + kk * 8); const f32x4 n0 = *(const LAS f32x4*)(ar + 6 * 128 + fq * 32 + kk * 8), n1 = *(const LAS f32x4*)(ar + 6 * 128 + fq * 32 + kk * 8 + 4);
            deni += n0[0] * bflo(qv.x) + n0[1] * bfhi(qv.x) + n0[2] * bflo(qv.y) + n0[3] * bfhi(qv.y) + n1[0] * bflo(qv.z) + n1[1] * bfhi(qv.z) + n1[2] * bflo(qv.w) + n1[3] * bfhi(qv.w); }
        deni += __shfl_xor(deni, 16); deni += __shfl_xor(deni, 32);
        const float wi = ar[3 * 128 + tl], et = ar[4 * 128 + tl], emt = ar[5 * 128 + tl];
#pragma unroll
        for (int vi = 0; vi < 8; ++vi) acc[vi] *= wi;
        float den = 0.f;
        for (int sp = 0; sp <= (wid >> 1); ++sp) {
            float pv[8];
#pragma unroll
            for (int h2 = 0; h2 < 2; ++h2) { const int tile = 2 * sp + h2; f32x4 sa = (f32x4){0.f, 0.f, 0.f, 0.f};
#pragma unroll
                for (int ks = 0; ks < 4; ++ks) sa = mfma16(ldfrag((const LAS unsigned char*)(Kc + (16 * tile + fr) * LP + ks * 32 + fq * 8)), qf[ks], sa);
                const f32x4 gk = *(const LAS f32x4*)(ar + 2 * 128 + 16 * tile + 4 * fq);
#pragma unroll
                for (int r = 0; r < 4; ++r) { const int sl = 16 * tile + 4 * fq + r; const float wgt = (sl <= tl) ? __expf(et + gk[r]) : 0.f; const float pp = wgt * sa[r]; den += pp; pv[h2 * 4 + r] = pp; } }
            u32x4 pw; pw.x = cvt_pk_bf16(pv[0], pv[1]); pw.y = cvt_pk_bf16(pv[2], pv[3]); pw.z = cvt_pk_bf16(pv[4], pv[5]); pw.w = cvt_pk_bf16(pv[6], pv[7]);
            const bf16x8 pf = __builtin_bit_cast(bf16x8, pw);
#pragma unroll
            for (int vi = 0; vi < 8; ++vi) { const LAS unsigned char* vr = (const LAS unsigned char*)(Vt + (16 * vi + fr) * LP + 32 * sp + 4 * fq);
                acc[vi] = mfma16(ldfrag2(vr, vr + 32), pf, acc[vi]); }
        }
        den += __shfl_xor(den, 16); den += __shfl_xor(den, 32);
        const float dtot = wi * deni + den; const float hinv = 1.f / fmaxf(fabsf(dtot), emt);
        const size_t tokr = (size_t)(tok0 + tl);
        float ssq = 0.f;
#pragma unroll
        for (int vi = 0; vi < 8; ++vi) { const u32x2 o = *(const u32x2*)(PROJ + tokr * NPA + C_MO + hd * 128 + 16 * vi + 4 * fq);
            acc[vi][0] *= hinv * bflo(o.x); acc[vi][1] *= hinv * bfhi(o.x); acc[vi][2] *= hinv * bflo(o.y); acc[vi][3] *= hinv * bfhi(o.y);
            ssq += acc[vi][0] * acc[vi][0] + acc[vi][1] * acc[vi][1] + acc[vi][2] * acc[vi][2] + acc[vi][3] * acc[vi][3]; }
        ssq += __shfl_xor(ssq, 16); ssq += __shfl_xor(ssq, 32);
        const float rinv = rsqrtf(ssq * (1.f / 128.f) + EPSF);
#pragma unroll
        for (int vi = 0; vi < 8; ++vi) { const int vc = hd * 128 + 16 * vi + 4 * fq; const u32x2 z = *(const u32x2*)(PROJ + tokr * NPA + C_MZ + vc); const f32x4 g = *(const f32x4*)(p.m_norm_g + l * 512 + vc);
            u32x2 w; w.x = cvt_pk_bf16(acc[vi][0] * rinv * g[0] * bflo(z.x), acc[vi][1] * rinv * g[1] * bfhi(z.x)); w.y = cvt_pk_bf16(acc[vi][2] * rinv * g[2] * bflo(z.y), acc[vi][3] * rinv * g[3] * bfhi(z.y));
            st8(Y + tokr * DM + vc, w); }
    }
    __syncthreads();
}

__device__ __forceinline__ void pool_phase(const Params& p, int l, LAS unsigned char* lds, unsigned char* ws_in) {
    size_t wz_ = 0; asm volatile("" : "+s"(wz_)); unsigned char* ws = ws_in + wz_;
    int tid_ = threadIdx.x; asm volatile("" : "+v"(tid_)); const int tid = tid_; const bf16_t* PROJ = (const bf16_t*)(ws + WS_PROJ); bf16_t* Y = (bf16_t*)(ws + WS_Y);
    LAS float* U = (LAS float*)lds; LAS float* Wp = (LAS float*)(lds + 20480); LAS float* Pm = (LAS float*)(lds + 36864);
    for (int pu = blockIdx.x; pu < 1024; pu += gridDim.x) {
        const int tt = pu >> 2, g = pu & 3, tok0 = tt * 64, b = tok0 / SEQ, p0 = tok0 % SEQ, W = 2 << g;
        __syncthreads();
        for (int ch = tid; ch < 79 * 8; ch += 512) { const int row = ch >> 3, cc = (ch & 7) * 8, pos = p0 - 15 + row;
            u32x4 v = {0u, 0u, 0u, 0u}; if (pos >= 0) v = *(const u32x4*)(PROJ + (size_t)(b * SEQ + pos) * NPA + C_PU + g * 64 + cc);
            *(LAS f32x4*)(U + row * 64 + cc) = (f32x4){bflo(v.x), bfhi(v.x), bflo(v.y), bfhi(v.y)}; *(LAS f32x4*)(U + row * 64 + cc + 4) = (f32x4){bflo(v.z), bfhi(v.z), bflo(v.w), bfhi(v.w)}; }
#pragma unroll
        for (int q = 0; q < 8; ++q) Wp[q * 512 + tid] = p.pool_w[(size_t)l * 16384 + g * 4096 + q * 512 + tid];
        __syncthreads();
        const int t = tid >> 3, c0 = (tid & 7) * 8; const int cnt = min(W, p0 + t + 1); const float rc = 1.f / (float)cnt;
        { f32x4 s0 = (f32x4){0.f, 0.f, 0.f, 0.f}, s1 = s0;
          for (int j = 0; j < W; ++j) { s0 += *(const LAS f32x4*)(U + (15 + t - j) * 64 + c0); s1 += *(const LAS f32x4*)(U + (15 + t - j) * 64 + c0 + 4); }
          const f32x4 u0 = *(const LAS f32x4*)(U + (15 + t) * 64 + c0), u1 = *(const LAS f32x4*)(U + (15 + t) * 64 + c0 + 4);
#pragma unroll
          for (int e = 0; e < 4; ++e) { Pm[t * 65 + c0 + e] = s0[e] * rc - u0[e]; Pm[t * 65 + c0 + 4 + e] = s1[e] * rc - u1[e]; } }
        __syncthreads();
        float o[8];
#pragma unroll
        for (int e = 0; e < 8; ++e) o[e] = 0.f;
        for (int cc = 0; cc < 64; ++cc) { const float pv = Pm[t * 65 + cc]; const f32x4 w0 = *(const LAS f32x4*)(Wp + cc * 64 + c0), w1 = *(const LAS f32x4*)(Wp + cc * 64 + c0 + 4);
#pragma unroll
            for (int e = 0; e < 4; ++e) { o[e] += pv * w0[e]; o[4 + e] += pv * w1[e]; } }
        const size_t tok = (size_t)(tok0 + t); const u32x4 z = *(const u32x4*)(PROJ + tok * NPA + C_PZ + g * 64 + c0);
        const f32x4 s0 = *(const f32x4*)(p.pool_scale + l * 256 + g * 64 + c0), s1 = *(const f32x4*)(p.pool_scale + l * 256 + g * 64 + c0 + 4);
        u32x4 w; w.x = cvt_pk_bf16(o[0] * s0[0] * bflo(z.x), o[1] * s0[1] * bfhi(z.x)); w.y = cvt_pk_bf16(o[2] * s0[2] * bflo(z.y), o[3] * s0[3] * bfhi(z.y));
        w.z = cvt_pk_bf16(o[4] * s1[0] * bflo(z.z), o[5] * s1[1] * bfhi(z.z)); w.w = cvt_pk_bf16(o[6] * s1[2] * bflo(z.w), o[7] * s1[3] * bfhi(z.w));
        st16(Y + tok * DM + 512 + g * 64 + c0, w);
    }
    __syncthreads();
}

constexpr float SB_DEAD = -104.f * 1.4426950408889634f;
template <bool DIAG> __device__ __forceinline__ f32x4 sb_tile(const f32x4 z, int sbase, int tq, int fq, float& L) {
    float lf[4], ls[4];
#pragma unroll
    for (int r = 0; r < 4; ++r) { const float zz = z[r], l1p = __builtin_amdgcn_logf(1.f + __builtin_amdgcn_exp2f(-fabsf(zz)));
        const float lfv = -(fmaxf(zz, 0.f) + l1p), lsv = fminf(zz, 0.f) - l1p;
        if (DIAG) { const bool valid = (sbase + r) < tq; lf[r] = valid ? lfv : 0.f; ls[r] = valid ? lsv : -1.0e30f; } else { lf[r] = lfv; ls[r] = lsv; } }
    const float suf2 = lf[3], suf1 = suf2 + lf[2], suf0 = suf1 + lf[1], T = suf0 + lf[0];
    const float T16 = __shfl_down(T, 16), T32 = __shfl_down(T, 32), T48 = __shfl_down(T, 48);
    const float E = (fq < 3 ? T16 : 0.f) + (fq < 2 ? T32 : 0.f) + (fq < 1 ? T48 : 0.f);
    float Tt = T + __shfl_xor(T, 16); Tt += __shfl_xor(Tt, 32);
    const float base = L + E;
    f32x4 pv; pv[0] = __builtin_amdgcn_exp2f(ls[0] + base + suf0); pv[1] = __builtin_amdgcn_exp2f(ls[1] + base + suf1); pv[2] = __builtin_amdgcn_exp2f(ls[2] + base + suf2); pv[3] = __builtin_amdgcn_exp2f(ls[3] + base);
    L += Tt; return pv;
}
__device__ __forceinline__ void sb_phase(const Params& p, LAS unsigned char* lds, unsigned char* ws_in, int u_first, int u_end) {
    size_t wz_ = 0; asm volatile("" : "+s"(wz_)); unsigned char* ws = ws_in + wz_;
    int tid_ = threadIdx.x; asm volatile("" : "+v"(tid_)); const int tid = tid_, lane = tid & 63, wid = tid >> 6, fr = lane & 15, fq = lane >> 4;
    const bf16_t* PROJ = (const bf16_t*)(ws + WS_PROJ); bf16_t* Y = (bf16_t*)(ws + WS_Y);
    LAS bf16_t* Ks = (LAS bf16_t*)lds; LAS bf16_t* Vt = (LAS bf16_t*)(lds + 18432); LAS int* flags = (LAS int*)(lds + 36864);
    for (int u = u_first; u < u_end; u += gridDim.x) {
        const int b = u >> 8, hd = (u >> 6) & 3, qb = u & 63;
        const int tq = qb * 128 + 16 * wid + fr; const size_t tokq = (size_t)(b * SEQ + tq);
        bf16x8 qf[2];
#pragma unroll
        for (int ks = 0; ks < 2; ++ks) qf[ks] = *(const bf16x8*)(PROJ + tokq * NPA + C_SQ + hd * 64 + ks * 32 + fq * 8);
        f32x4 acc[4];
#pragma unroll
        for (int i = 0; i < 4; ++i) acc[i] = (f32x4){0.f, 0.f, 0.f, 0.f};
        float Lrun = 0.f;
        u32x4 kreg[2], vreg[2];
#pragma unroll
        for (int q = 0; q < 2; ++q) { const int row = tid & 127, d0 = ((tid >> 7) + 4 * q) * 8; const size_t tk = (size_t)(b * SEQ + qb * 128 + row);
            kreg[q] = *(const u32x4*)(PROJ + tk * NPA + C_SK + hd * 64 + d0); vreg[q] = *(const u32x4*)(PROJ + tk * NPA + C_SV + hd * 64 + d0); }
        for (int kb = qb; kb >= 0; --kb) {
            __syncthreads();
#pragma unroll
            for (int q = 0; q < 2; ++q) { const int row = tid & 127, d0 = ((tid >> 7) + 4 * q) * 8;
                *(LAS u32x4*)(Ks + row * 72 + d0) = kreg[q];
                const unsigned wv[4] = {vreg[q].x, vreg[q].y, vreg[q].z, vreg[q].w};
#pragma unroll
                for (int e = 0; e < 4; ++e) { Vt[(d0 + 2 * e) * LP + row] = (bf16_t)(wv[e] & 0xffffu); Vt[(d0 + 2 * e + 1) * LP + row] = (bf16_t)(wv[e] >> 16); } }
            if (kb > 0) {
#pragma unroll
                for (int q = 0; q < 2; ++q) { const int row = tid & 127, d0 = ((tid >> 7) + 4 * q) * 8; const size_t tk = (size_t)(b * SEQ + (kb - 1) * 128 + row);
                    kreg[q] = *(const u32x4*)(PROJ + tk * NPA + C_SK + hd * 64 + d0); vreg[q] = *(const u32x4*)(PROJ + tk * NPA + C_SV + hd * 64 + d0); } }
            if (tid < 8) flags[tid] = 0;
            __syncthreads();
            const bool walive = __ballot(Lrun >= SB_DEAD) != 0ull;
            if (walive) {
                const int sp_hi = (kb == qb) ? (wid >> 1) : 3;
                for (int sp = sp_hi; sp >= 0; --sp) {
                    if (__ballot(Lrun >= SB_DEAD) == 0ull) break;
                    f32x4 pvv[2];
#pragma unroll
                    for (int h2 = 1; h2 >= 0; --h2) { const int tile = 2 * sp + h2;
                        f32x4 z = (f32x4){0.f, 0.f, 0.f, 0.f};
#pragma unroll
                        for (int ks = 0; ks < 2; ++ks) z = mfma16(ldfrag((const LAS unsigned char*)(Ks + (16 * tile + fr) * 72 + ks * 32 + fq * 8)), qf[ks], z);
                        const int sbase = kb * 128 + 16 * tile + 4 * fq;
                        pvv[h2] = (kb == qb) ? sb_tile<true>(z, sbase, tq, fq, Lrun) : sb_tile<false>(z, sbase, tq, fq, Lrun); }
                    const float pv[8] = {pvv[0][0], pvv[0][1], pvv[0][2], pvv[0][3], pvv[1][0], pvv[1][1], pvv[1][2], pvv[1][3]};
                    u32x4 pw; pw.x = cvt_pk_bf16(pv[0], pv[1]); pw.y = cvt_pk_bf16(pv[2], pv[3]); pw.z = cvt_pk_bf16(pv[4], pv[5]); pw.w = cvt_pk_bf16(pv[6], pv[7]);
                    const bf16x8 pf = __builtin_bit_cast(bf16x8, pw);
#pragma unroll
                    for (int i = 0; i < 4; ++i) { const LAS unsigned char* vr = (const LAS unsigned char*)(Vt + (16 * i + fr) * LP + 32 * sp + 4 * fq);
                        acc[i] = mfma16(ldfrag2(vr, vr + 32), pf, acc[i]); }
                }
            }
            const bool still = __ballot(Lrun >= SB_DEAD) != 0ull;
            if (lane == 0 && still) flags[wid] = 1;
            __syncthreads();
            int any = 0;
#pragma unroll
            for (int i = 0; i < 8; ++i) any |= flags[i];
            if (!any) break;
        }
#pragma unroll
        for (int i = 0; i < 4; ++i) { const int dc = hd * 64 + 16 * i + 4 * fq; const u32x2 z = *(const u32x2*)(PROJ + tokq * NPA + C_SZ + dc);
            u32x2 w; w.x = cvt_pk_bf16(acc[i][0] * bflo(z.x), acc[i][1] * bfhi(z.x)); w.y = cvt_pk_bf16(acc[i][2] * bflo(z.y), acc[i][3] * bfhi(z.y));
            st8(Y + tokq * DM + 768 + dc, w); }
    }
    __syncthreads();
}

__device__ __forceinline__ void final_norm(const Params& p) {
    int tid_ = threadIdx.x; asm volatile("" : "+v"(tid_)); const int tid = tid_, lane = tid & 63, wid = tid >> 6;
    const int stride = gridDim.x * 8; int row = blockIdx.x * 8 + wid;
    f32x4 g[4];
#pragma unroll
    for (int j = 0; j < 4; ++j) g[j] = *(const f32x4*)(p.final_g + j * 256 + lane * 4);
    f32x4 xn[4];
    if (row < NTOK) {
#pragma unroll
        for (int j = 0; j < 4; ++j) xn[j] = *(const f32x4*)(p.out + (size_t)row * DM + j * 256 + lane * 4); }
    for (; row < NTOK; row += stride) {
        float* xr = p.out + (size_t)row * DM; f32x4 xv[4]; float ss = 0.f;
#pragma unroll
        for (int j = 0; j < 4; ++j) { xv[j] = xn[j]; ss += xv[j][0] * xv[j][0] + xv[j][1] * xv[j][1] + xv[j][2] * xv[j][2] + xv[j][3] * xv[j][3]; }
        if (row + stride < NTOK) {
#pragma unroll
            for (int j = 0; j < 4; ++j) xn[j] = *(const f32x4*)(p.out + (size_t)(row + stride) * DM + j * 256 + lane * 4); }
        ss = wave_sum(ss); const float rstd = rsqrtf(ss * (1.f / 1024.f) + EPSF);
#pragma unroll
        for (int j = 0; j < 4; ++j) *(f32x4*)(xr + j * 256 + lane * 4) = xv[j] * rstd * g[j];
    }
}

#define XB_TMO      128
#define XB_XCNT(j)  (256  + 64 * (j))
#define XB_XSUB(j)  (1280 + 64 * (j))
#define XB_XGEN(j)  (2304 + 64 * (j))
#define XB_TOP      3328
#define XB_TOPGEN   3392
#define XCD_BAR_WORDS 3456
#define XB_SPIN_CAP (1u << 18)

__device__ __forceinline__ unsigned xb_ld(unsigned* p)              { return __hip_atomic_load(p, __ATOMIC_RELAXED, __HIP_MEMORY_SCOPE_AGENT); }
__device__ __forceinline__ unsigned xb_add(unsigned* p, unsigned v) { return __hip_atomic_fetch_add(p, v, __ATOMIC_RELAXED, __HIP_MEMORY_SCOPE_AGENT); }
__device__ __forceinline__ unsigned xb_xcc_id() { return (unsigned)__builtin_amdgcn_s_getreg((3 << 11) | 20) & 0xFu; }
#define XB_SPIN(cond, bar) do { unsigned _sp = 0; while (cond) { __builtin_amdgcn_s_sleep(1); \
    if ((++_sp & 255u) == 0u) { if (xb_ld(&(bar)[XB_TMO])) break; if (_sp > XB_SPIN_CAP) { atomicAdd(&(bar)[XB_TMO], 1u); break; } } } } while (0)

struct XcdBarrier {
    unsigned* bar; unsigned x;
    volatile LAS unsigned* st;
};

__device__ __forceinline__ XcdBarrier xcd_barrier_post(unsigned* bar, volatile LAS unsigned* st) {
    XcdBarrier b; b.bar = bar; b.x = xb_xcc_id(); b.st = st;
    if (threadIdx.x == 0) (void)xb_add(&bar[XB_XCNT(b.x)], 1u);
    return b;
}
__device__ __forceinline__ void xcd_barrier_complete(unsigned* bar, unsigned x, unsigned& nloc, unsigned& nx) {
    const unsigned G = gridDim.x * gridDim.y * gridDim.z;
    unsigned sum, cnt, mine, sp = 0u;
    for (;;) {
        sum = 0u; cnt = 0u; mine = 0u;
#pragma unroll
        for (unsigned j = 0; j < 16; ++j) { const unsigned c = xb_ld(&bar[XB_XCNT(j)]); sum += c; cnt += (c > 0u) ? 1u : 0u; mine = (j == x) ? c : mine; }
        if (sum == G) break;
        __builtin_amdgcn_s_sleep(1);
        if ((++sp & 255u) == 0u) { if (xb_ld(&bar[XB_TMO])) break; if (sp > XB_SPIN_CAP) { atomicAdd(&bar[XB_TMO], 1u); break; } }
    }
    nloc = mine > 0u ? mine : 1u; nx = cnt > 0u ? cnt : 1u;
}

__device__ __forceinline__ void xcd_barrier(const XcdBarrier& b) {
    asm volatile("s_waitcnt vmcnt(0)" ::: "memory");
    __syncthreads();
    if (threadIdx.x == 0) {
        unsigned* bar = b.bar;
        __builtin_amdgcn_s_waitcnt(0);
        unsigned nloc = b.st[0], nx = b.st[1];
        if (nloc == 0u) { xcd_barrier_complete(bar, b.x, nloc, nx); b.st[0] = nloc; b.st[1] = nx; }
        const unsigned old = xb_add(&bar[XB_XSUB(b.x)], 1u);
        const unsigned gen = old / nloc;
        if (old + 1u == (gen + 1u) * nloc) {
            __builtin_amdgcn_fence(__ATOMIC_RELEASE, "agent");
            asm volatile("s_waitcnt vmcnt(0)" ::: "memory");
            const unsigned og = xb_add(&bar[XB_TOP], 1u);
            const unsigned tg = og / nx;
            if (og + 1u == (tg + 1u) * nx) xb_add(&bar[XB_TOPGEN], 1u);
            else XB_SPIN(xb_ld(&bar[XB_TOPGEN]) == tg, bar);
            __builtin_amdgcn_fence(__ATOMIC_ACQUIRE, "agent");
            xb_add(&bar[XB_XGEN(b.x)], 1u);
            asm volatile("s_waitcnt vmcnt(0)" ::: "memory");
        } else {
            XB_SPIN(xb_ld(&bar[XB_XGEN(b.x)]) == gen, bar);
            __builtin_amdgcn_fence(__ATOMIC_ACQUIRE, "agent");
            asm volatile("s_waitcnt vmcnt(0)" ::: "memory");
        }
    }
    __syncthreads();
}

constexpr int N_PHASES = 16;
__global__ void __launch_bounds__(512, 2) mk_fwd(Params p) {
    extern __shared__ __attribute__((aligned(16))) unsigned char lds_raw[];
    LAS unsigned char* lds = (LAS unsigned char*)lds_raw;
    cg::grid_group grid = cg::this_grid();
#define GSYNC_CG() do { asm volatile("s_waitcnt vmcnt(0) lgkmcnt(0)" ::: "memory"); __syncthreads(); \
        if (threadIdx.x < 64) { __builtin_amdgcn_fence(__ATOMIC_RELEASE, "agent"); asm volatile("s_waitcnt vmcnt(0)" ::: "memory"); } \
        grid.sync(); \
        if (threadIdx.x < 64) { __builtin_amdgcn_fence(__ATOMIC_ACQUIRE, "agent"); asm volatile("s_waitcnt vmcnt(0)" ::: "memory"); } \
        __syncthreads(); } while (0)
    const bool one_launch = (p.ph_hi - p.ph_lo == N_PHASES);
    volatile LAS unsigned* xst = (volatile LAS unsigned*)(lds + LDS_BYTES - 64);
    if (threadIdx.x == 0) { xst[0] = 0u; xst[1] = 0u; }
    __syncthreads();
    XcdBarrier xbar; xbar.bar = (unsigned*)(p.ws + WS_SMALL + SM_XBAR); xbar.x = 0; xbar.st = xst;
    if (one_launch) xbar = xcd_barrier_post((unsigned*)(p.ws + WS_SMALL + SM_XBAR), xst);
    if (one_launch) grid.sync();
#define GSYNC() do { if (one_launch) xcd_barrier(xbar); else GSYNC_CG(); } while (0)
#pragma unroll 1
    for (int ph = p.ph_lo; ph < p.ph_hi; ++ph) {
        if (ph == 0) { phase_mod(p, (float*)(p.ws + WS_SMALL + SM_MODP)); }
        else if (ph == N_PHASES - 1) { if (gridDim.x != 256) final_norm(p); }
        else {
        int l = (ph - 1) / 7, k = (ph - 1) % 7; asm volatile("" : "+s"(l), "+s"(k));
        const float* xin = (l == 0) ? p.x : p.out;
        int G = gridDim.x, bx = blockIdx.x; asm volatile("" : "+s"(G), "+s"(bx));
        size_t wz_ = 0; asm volatile("" : "+s"(wz_)); unsigned char* ws = p.ws + wz_;
        if (k == 0) { phase_prep(p, l, xin, lds, ws); }
        else if (k == 1) {
        {
            pg8::Gemm g{(const bf16_t*)(ws + WS_H), (const bf16_t*)(ws + WS_WIN), NTOK, NPA, DM, DM, DM}; pg8::StaticOrder S; S.init(NTOK, NPA, G, bx);
            EpiProj E{(bf16_t*)(ws + WS_PROJ), NPA, 0}; NoHook HK; f32x4 acc[2][2][4][2];
            pg8::gemm_phase<EpiProj, pg8::StaticOrder, NoHook, true, true>(lds, g, S, E, HK, acc);
        }
        }
        else if (k == 2) { mlstm_m1(p, l, lds, ws); pool_phase(p, l, lds, ws); }
        else if (k == 3) {
            if (G == 256) {
                int tx_ = threadIdx.x; asm volatile("" : "+v"(tx_)); const int idx = bx * 512 + tx_;
                float dcv[64]; scan_load(dcv, ws, idx);
                sb_phase(p, lds, ws, bx, 256);
                scan_finish(dcv, l, ws, idx);
                mlstm_scan_n(l, ws);
                sb_phase(p, lds, ws, 256 + bx, 512);
            } else { mlstm_scan(l, ws); mlstm_scan_n(l, ws); sb_phase(p, lds, ws, bx, 512); }
        }
        else if (k == 4) { mlstm_m3(p, l, lds, ws); }
        else if (k == 5) {
        {
            pg8::StaticOrder S; S.init(NTOK, DM, G, bx); pg8::Unit u; NoHook HK; f32x4 acc[2][2][4][2];
            const bf16_t* Gp = (const bf16_t*)(ws + WS_G); const bf16_t* Yp = (const bf16_t*)(ws + WS_Y); const bf16_t* Wb = (const bf16_t*)(ws + WS_WBR);
            for (int i = 0; S.next(i, u); ++i) {
                { pg8::Gemm g{(const bf16_t*)(ws + WS_H), (const bf16_t*)(ws + WS_WIN) + (size_t)NPA * 1024, NTOK, NG, DM, DM, DM}; GateOrder GO{u.pm, u.pn};
                  EpiProj E{(bf16_t*)(ws + WS_G), NG, 1};
                  pg8::gemm_phase<EpiProj, GateOrder, NoHook, true, true>(lds, g, GO, E, HK, acc); }
                __syncthreads();
                OneUnit OU{u.pm, u.pn}; EpiNone EN;
                { pg8::Gemm g{Yp, Wb, NTOK, DM, 512, DM, DM};
                  pg8::gemm_phase<EpiNone, OneUnit, NoHook, false, true, true>(lds, g, OU, EN, HK, acc); }
                gate_rescale(acc, Gp, p.gate_b + l * NG, u.pm, u.pn, 0); __syncthreads();
                { pg8::Gemm g{Yp + 512, Wb + 512, NTOK, DM, 256, DM, DM};
                  pg8::gemm_phase<EpiNone, OneUnit, NoHook, false, true, false>(lds, g, OU, EN, HK, acc); }
                gate_rescale(acc, Gp, p.gate_b + l * NG, u.pm, u.pn, 1024); __syncthreads();
                { pg8::Gemm g{Yp + 768, Wb + 768, NTOK, DM, 256, DM, DM}; EpiMerge E{(bf16_t*)(ws + WS_MERGED), Gp, p.gate_b + l * NG};
                  pg8::gemm_phase<EpiMerge, OneUnit, NoHook, false, true, false>(lds, g, OU, E, HK, acc); }
                __syncthreads();
            }
        }
        }
        else {
        {
            pg8::Gemm g{(const bf16_t*)(ws + WS_MERGED), (const bf16_t*)(ws + WS_WOUT), NTOK, DM, DM, DM, DM}; pg8::StaticOrder S; S.init(NTOK, DM, G, bx); pg8::Unit u;
            NoHook HK; f32x4 acc[2][2][4][2];
            if (l == 1 && G == 256) {
                EpiOutNorm E{xin, p.out, (const float*)(ws + WS_SMALL + SM_GATEV) + l * 2048, p.final_g, (unsigned long long*)(ws + WS_SMALL + SM_XEX), (unsigned*)(ws + WS_SMALL + SM_XBAR + 16384)};
                for (int i = 0; S.next(i, u); ++i) { OneUnit OU{u.pm, u.pn};
                    pg8::gemm_phase<EpiOutNorm, OneUnit, NoHook, false, true>(lds, g, OU, E, HK, acc); __syncthreads(); }
            } else {
                EpiOut E{xin, p.out, (const float*)(ws + WS_SMALL + SM_GATEV) + l * 2048};
                for (int i = 0; S.next(i, u); ++i) { OneUnit OU{u.pm, u.pn};
                    pg8::gemm_phase<EpiOut, OneUnit, NoHook, false, true>(lds, g, OU, E, HK, acc); __syncthreads(); }
            }
        }
        }
        }
        if (ph + 1 < p.ph_hi && !(gridDim.x == 256 && ph == N_PHASES - 2)) GSYNC();
    }
}

extern "C" void kernel_launch(void* const* d_in, const int* in_sizes, int n_in, void* d_out, int out_size, void* d_ws, size_t ws_size, hipStream_t stream) {
    static int grid_blocks = 0;
    if (grid_blocks == 0) {
        int dev = 0, cus = 0, per_cu = 0;
        if (n_in != 18 || out_size != NTOK * DM || ws_size < WS_SMALL + SM_END) { fprintf(stderr, "kernel_launch: unexpected shapes (n_in %d out %d ws %zu)\n", n_in, out_size, ws_size); grid_blocks = -1; return; }
        hipGetDevice(&dev); hipDeviceGetAttribute(&cus, hipDeviceAttributeMultiprocessorCount, dev);
        if (hipFuncSetAttribute((const void*)mk_fwd, hipFuncAttributeMaxDynamicSharedMemorySize, LDS_BYTES) != hipSuccess) { fprintf(stderr, "kernel_launch: hipFuncSetAttribute failed\n"); }
        if (hipOccupancyMaxActiveBlocksPerMultiprocessor(&per_cu, (const void*)mk_fwd, 512, LDS_BYTES) != hipSuccess || per_cu < 1) { fprintf(stderr, "kernel_launch: occupancy query gave %d\n", per_cu); per_cu = 1; }
        (void)hipGetLastError();
        grid_blocks = cus * per_cu;
    }
    if (grid_blocks < 0) return;
    Params p{};
    const float** f = (const float**)&p;
    for (int i = 0; i < 18; ++i) f[i] = (const float*)d_in[i];
    p.out = (float*)d_out; p.ws = (unsigned char*)d_ws;
#ifndef MK_PHASES_PER_LAUNCH
#define MK_PHASES_PER_LAUNCH N_PHASES
#endif
    (void)hipMemsetAsync((unsigned char*)d_ws + WS_SMALL + SM_XBAR, 0, XBAR_BYTES, stream);
    for (int lo = 0; lo < N_PHASES; lo += MK_PHASES_PER_LAUNCH) {
        p.ph_lo = lo; p.ph_hi = lo + MK_PHASES_PER_LAUNCH < N_PHASES ? lo + MK_PHASES_PER_LAUNCH : N_PHASES;
        void* args[] = {&p};
        hipError_t e = hipLaunchCooperativeKernel((const void*)mk_fwd, dim3(grid_blocks), dim3(512), args, LDS_BYTES, stream);
        if (e != hipSuccess) { fprintf(stderr, "cooperative launch failed: %s (grid %d)\n", hipGetErrorString(e), grid_blocks); break; }
    }
}
```
